# Optimizing an MI355X kernel written in HIP

```python
import math
import jax
import jax.numpy as jnp
from jax import lax
import numpy as np

D_MODEL = 1024
BATCH = 32
SEQ = 256
DEPTH = 4
DEC_BATCH = 2
DEC_SEQ = 1024
PAST_LEN = 256

GRID_W = 64
D_MIX = D_MODEL
HEAD_DIM = 64
ATT_W = D_MIX // 2
N_HEADS = ATT_W // HEAD_DIM
N_KV = 2
GQA_G = N_HEADS // N_KV
KV_W = N_KV * HEAD_DIM
Q_BLOCK = 128
ROPE_BASE = 10000.0
LRU_W = D_MIX // 4
LRU_BLOCKS = 4
LRU_BS = LRU_W // LRU_BLOCKS
LRU_C = 8.0
LRU_CONV = 4
HY_W = D_MIX // 4
HY_CONV = 3
HY_BANDS = 16
HY_FEAT = 2 * HY_BANDS + 1
HY_FILT_HID = 64
HY_DECAY_FAST = 0.3
HY_DECAY_SLOW = 1.5
HY_DECAY_TARGET = 1e-2
D_FF = -(-8 * D_MODEL // (3 * 256)) * 256
EPS = 1e-6
OFF_K = ATT_W
OFF_V = OFF_K + KV_W
OFF_LX = OFF_V + KV_W
OFF_LG = OFF_LX + LRU_W
OFF_HY = OFF_LG + LRU_W
D_IN = OFF_HY + 3 * HY_W

kernel_name = 'hybrid_dit_attn_rglru_hyena_step'


def rmsnorm(x, w):
    xf = x.astype(jnp.float32)
    y = xf * lax.rsqrt(jnp.mean(xf * xf, axis=-1, keepdims=True) + EPS)
    return (y * w.astype(jnp.float32)).astype(x.dtype)


def adaln_mod(cond, w_mod, b_mod):
    m = jax.nn.silu(cond) @ w_mod + b_mod
    return tuple(t[:, None, :] for t in jnp.split(m, 6, axis=-1))


def dwconv_centred(x, w, pad_left):
    K = w.shape[0]
    L = x.shape[1]
    xp = jnp.pad(x, ((0, 0), (pad_left, K - 1 - pad_left), (0, 0)))
    return sum(w[k] * xp[:, k:k + L] for k in range(K))


def axial_rope(x):
    L = x.shape[1]
    rows = L // GRID_W
    row = jnp.repeat(jnp.arange(rows, dtype=jnp.float32), GRID_W)
    col = jnp.tile(jnp.arange(GRID_W, dtype=jnp.float32), rows)
    nq = HEAD_DIM // 4
    freqs = ROPE_BASE ** (-jnp.arange(nq, dtype=jnp.float32) / nq)
    xf = x.astype(jnp.float32)

    def rot(xh, pos):
        ang = pos[:, None] * freqs[None, :]
        cos = jnp.cos(ang)[None, :, None, :]
        sin = jnp.sin(ang)[None, :, None, :]
        x1, x2 = xh[..., :nq], xh[..., nq:]
        return jnp.concatenate([x1 * cos - x2 * sin, x2 * cos + x1 * sin], axis=-1)

    half = HEAD_DIM // 2
    out = jnp.concatenate([rot(xf[..., :half], row), rot(xf[..., half:], col)], axis=-1)
    return out.astype(x.dtype)


def block_attention(q, k, v):
    B, Lq = q.shape[:2]
    nb = Lq // Q_BLOCK
    qb = q.reshape(B, nb, Q_BLOCK, N_KV, GQA_G, HEAD_DIM).transpose(1, 0, 2, 3, 4, 5)
    scale = HEAD_DIM ** -0.5

    def one_block(qblk):
        s = jnp.einsum('bqkgd,bskd->bkgqs', qblk, k).astype(jnp.float32) * scale
        p = jax.nn.softmax(s, axis=-1).astype(v.dtype)
        return jnp.einsum('bkgqs,bskd->bqkgd', p, v)

    o = lax.map(one_block, qb)
    return o.transpose(1, 0, 2, 3, 4, 5).reshape(B, Lq, ATT_W)


def rglru_coeffs(xc, gate_w, gate_b, lam):
    B, L = xc.shape[:2]
    xf = xc.astype(jnp.float32)
    xb = xf.reshape(B, L, LRU_BLOCKS, LRU_BS)
    g = jnp.einsum('blni,dgnij->dgblnj', xb, gate_w.astype(jnp.float32)).reshape(2, 2, B, L, LRU_W)
    g = g + gate_b.astype(jnp.float32)[:, :, None, None, :]
    r = jax.nn.sigmoid(g[:, 0])
    i = jax.nn.sigmoid(g[:, 1])
    log_a = -LRU_C * r * jax.nn.softplus(-lam.astype(jnp.float32))[:, None, None, :]
    a = jnp.exp(log_a)
    b = jnp.sqrt(-jnp.expm1(2.0 * log_a)) * (i * xf[None])
    return a, b


def _affine_combine(e1, e2):
    a1, b1 = e1
    a2, b2 = e2
    return a1 * a2, a2 * b1 + b2


def linear_recurrence(a, b, h0):
    A, Bc = lax.associative_scan(_affine_combine, (a, b), axis=1)
    return A * h0[:, None, :] + Bc


def bidir_scan(a, b, h0f, h0b):
    hf = linear_recurrence(a[0], b[0], h0f)
    hb = jnp.flip(linear_recurrence(jnp.flip(a[1], 1), jnp.flip(b[1], 1), h0b), 1)
    return hf, hb


def hyena_filter_spectra(L, w1, b1, w2, b2, w3, b3):
    f32 = jnp.float32
    t = jnp.arange(L, dtype=f32)
    tn = t / L
    bands = jnp.linspace(1e-4, HY_BANDS - 1, HY_BANDS, dtype=f32)
    ang = (2.0 * math.pi / L) * t[:, None] * bands[None, :]
    z = jnp.concatenate([tn[:, None], jnp.cos(ang), -jnp.sin(ang)], axis=-1)
    h = jnp.sin(z @ w1.astype(f32) + b1.astype(f32))
    h = jnp.sin(h @ w2.astype(f32) + b2.astype(f32))
    hf = (h @ w3.astype(f32) + b3.astype(f32)).reshape(L, 2, 2, HY_W)
    deltas = jnp.linspace(math.log(HY_DECAY_TARGET) / HY_DECAY_SLOW,
                          math.log(HY_DECAY_TARGET) / HY_DECAY_FAST, HY_W, dtype=f32)
    hf = hf * jnp.exp(-tn[:, None] * jnp.abs(deltas)[None, :])[:, None, None, :]
    fwd, bwd = hf[:, :, 0], hf[:, :, 1]
    taps = jnp.concatenate([fwd, jnp.zeros_like(fwd[:1]), jnp.flip(bwd[1:], axis=0)], axis=0)
    return jnp.fft.rfft(taps, axis=0)


def long_conv(u, kf, skip):
    L = u.shape[1]
    uf = u.astype(jnp.float32)
    y = jnp.fft.irfft(jnp.fft.rfft(uf, n=2 * L, axis=1) * kf[None], n=2 * L, axis=1)[:, :L]
    return (y + uf * skip.astype(jnp.float32)).astype(u.dtype)


def hyena_mixer(u, lp):
    L = u.shape[1]
    uc = dwconv_centred(u, lp['hy_conv_w'], HY_CONV // 2)
    v, x1, x2 = jnp.split(uc, 3, axis=-1)
    kf = hyena_filter_spectra(L, lp['hy_filt_w1'], lp['hy_filt_b1'], lp['hy_filt_w2'],
                              lp['hy_filt_b2'], lp['hy_filt_w3'], lp['hy_filt_b3'])
    z = x1 * long_conv(v, kf[:, 0], lp['hy_skip'][0])
    return x2 * long_conv(z, kf[:, 1], lp['hy_skip'][1])


def trunk_layer(x, mod, lp, ctx):
    sh1, sc1, g1, sh2, sc2, g2 = mod
    B, L, _ = x.shape
    h = rmsnorm(x, lp['norm1_w']) * (1 + sc1) + sh1
    p = h @ lp['w_in']
    q = rmsnorm(p[..., :OFF_K].reshape(B, L, N_HEADS, HEAD_DIM), lp['q_norm_w'])
    k = rmsnorm(p[..., OFF_K:OFF_V].reshape(B, L, N_KV, HEAD_DIM), lp['k_norm_w'])
    v = p[..., OFF_V:OFF_LX].reshape(B, L, N_KV, HEAD_DIM)
    if ctx is None:
        att = block_attention(q, k, v)
        h0f = jnp.zeros((B, LRU_W), jnp.float32)
        h0b = jnp.zeros((B, LRU_W), jnp.float32)
    else:
        k_ctx, v_ctx, s_ctx = ctx
        q = axial_rope(q)
        k = axial_rope(k)
        k_all = jnp.concatenate([k_ctx.astype(k.dtype), k], axis=1)
        v_all = jnp.concatenate([v_ctx.astype(v.dtype), v], axis=1)
        att = block_attention(q, k_all, v_all)
        h0f = s_ctx[:, 0].astype(jnp.float32)
        h0b = s_ctx[:, 1].astype(jnp.float32)
    xc = dwconv_centred(p[..., OFF_LX:OFF_LG], lp['lru_conv_w'], LRU_CONV // 2) + lp['lru_conv_b']
    a, b = rglru_coeffs(xc, lp['lru_gate_w'], lp['lru_gate_b'], lp['lru_lambda'])
    hf, hb = bidir_scan(a, b, h0f, h0b)
    lru = jax.nn.gelu(p[..., OFF_LG:OFF_HY]) * (hf + hb).astype(x.dtype)
    hy = hyena_mixer(p[..., OFF_HY:], lp)
    mix = jnp.concatenate([att, lru, hy], axis=-1)
    x = x + g1 * (mix @ lp['w_out'])
    h2 = rmsnorm(x, lp['norm2_w']) * (1 + sc2) + sh2
    x = x + g2 * ((jax.nn.silu(h2 @ lp['ffn_w1']) * (h2 @ lp['ffn_w3'])) @ lp['ffn_w2'])
    if ctx is None:
        state = jnp.stack([hf[:, -1], hb[:, 0]], axis=1).astype(x.dtype)
        return x, (k, v, state)
    return x, None


def setup_inputs(seed: int = 0) -> dict:
    key = jax.random.key(seed)
    ks = jax.random.split(key, 32)

    def nrm(k, shape, s):
        return s * jax.random.normal(k, shape, jnp.float32)

    a0 = jax.random.uniform(ks[18], (DEPTH, 2, LRU_W), jnp.float32, 0.9, 0.999) ** (1.0 / LRU_C)
    return {
        'x_prompt': nrm(ks[0], (BATCH, SEQ, D_MODEL), 1.0),
        'x_sample': nrm(ks[1], (DEC_BATCH, DEC_SEQ, D_MODEL), 1.0),
        'cache_k': nrm(ks[2], (DEC_BATCH, DEPTH, PAST_LEN, N_KV, HEAD_DIM), 1.0),
        'cache_v': nrm(ks[3], (DEC_BATCH, DEPTH, PAST_LEN, N_KV, HEAD_DIM), 1.0),
        'state_lru': nrm(ks[4], (DEC_BATCH, DEPTH, 2, LRU_W), 0.5),
        'c': nrm(ks[5], (DEC_BATCH, D_MODEL), 1.0),
        'c_ctx': nrm(ks[6], (D_MODEL,), 1.0),
        'w_mod': nrm(ks[7], (DEPTH, D_MODEL, 6 * D_MODEL), 0.5 * D_MODEL ** -0.5),
        'b_mod': nrm(ks[8], (DEPTH, 6 * D_MODEL), 0.01),
        'norm1_w': 1.0 + nrm(ks[9], (DEPTH, D_MODEL), 0.05),
        'norm2_w': 1.0 + nrm(ks[10], (DEPTH, D_MODEL), 0.05),
        'w_in': nrm(ks[11], (DEPTH, D_MODEL, D_IN), D_MODEL ** -0.5),
        'q_norm_w': 1.0 + nrm(ks[12], (DEPTH, HEAD_DIM), 0.05),
        'k_norm_w': 1.0 + nrm(ks[13], (DEPTH, HEAD_DIM), 0.05),
        'lru_conv_w': nrm(ks[14], (DEPTH, LRU_CONV, LRU_W), LRU_CONV ** -0.5),
        'lru_conv_b': nrm(ks[15], (DEPTH, LRU_W), 0.01),
        'lru_gate_w': nrm(ks[16], (DEPTH, 2, 2, LRU_BLOCKS, LRU_BS, LRU_BS), LRU_BS ** -0.5),
        'lru_gate_b': nrm(ks[17], (DEPTH, 2, 2, LRU_W), 0.1),
        'lru_lambda': jnp.log(a0) - jnp.log1p(-a0),
        'hy_conv_w': nrm(ks[19], (DEPTH, HY_CONV, 3 * HY_W), HY_CONV ** -0.5),
        'hy_filt_w1': nrm(ks[20], (DEPTH, HY_FEAT, HY_FILT_HID), HY_FEAT ** -0.5),
        'hy_filt_b1': nrm(ks[21], (DEPTH, HY_FILT_HID), 0.1),
        'hy_filt_w2': nrm(ks[22], (DEPTH, HY_FILT_HID, HY_FILT_HID), HY_FILT_HID ** -0.5),
        'hy_filt_b2': nrm(ks[23], (DEPTH, HY_FILT_HID), 0.1),
        'hy_filt_w3': nrm(ks[24], (DEPTH, HY_FILT_HID, 4 * HY_W), 0.05 * HY_FILT_HID ** -0.5),
        'hy_filt_b3': nrm(ks[25], (DEPTH, 4 * HY_W), 0.01),
        'hy_skip': nrm(ks[26], (DEPTH, 2, HY_W), 1.0),
        'w_out': nrm(ks[27], (DEPTH, D_MIX, D_MODEL), D_MIX ** -0.5),
        'ffn_w1': nrm(ks[28], (DEPTH, D_MODEL, D_FF), D_MODEL ** -0.5),
        'ffn_w3': nrm(ks[29], (DEPTH, D_MODEL, D_FF), D_MODEL ** -0.5),
        'ffn_w2': nrm(ks[30], (DEPTH, D_FF, D_MODEL), D_FF ** -0.5),
    }


def reference(x_prompt, x_sample, cache_k, cache_v, state_lru, c, c_ctx, w_mod, b_mod, norm1_w,
              norm2_w, w_in, q_norm_w, k_norm_w, lru_conv_w, lru_conv_b, lru_gate_w, lru_gate_b,
              lru_lambda, hy_conv_w, hy_filt_w1, hy_filt_b1, hy_filt_w2, hy_filt_b2, hy_filt_w3,
              hy_filt_b3, hy_skip, w_out, ffn_w1, ffn_w3, ffn_w2):
    y_p = x_prompt
    y_s = x_sample
    ks_new, vs_new, ss_new = [], [], []
    for l in range(DEPTH):
        lp = {
            'norm1_w': norm1_w[l], 'norm2_w': norm2_w[l], 'w_in': w_in[l],
            'q_norm_w': q_norm_w[l], 'k_norm_w': k_norm_w[l],
            'lru_conv_w': lru_conv_w[l], 'lru_conv_b': lru_conv_b[l],
            'lru_gate_w': lru_gate_w[l], 'lru_gate_b': lru_gate_b[l], 'lru_lambda': lru_lambda[l],
            'hy_conv_w': hy_conv_w[l], 'hy_filt_w1': hy_filt_w1[l], 'hy_filt_b1': hy_filt_b1[l],
            'hy_filt_w2': hy_filt_w2[l], 'hy_filt_b2': hy_filt_b2[l], 'hy_filt_w3': hy_filt_w3[l],
            'hy_filt_b3': hy_filt_b3[l], 'hy_skip': hy_skip[l], 'w_out': w_out[l],
            'ffn_w1': ffn_w1[l], 'ffn_w3': ffn_w3[l], 'ffn_w2': ffn_w2[l],
        }
        mod_ctx = adaln_mod(c_ctx[None, :], w_mod[l], b_mod[l])
        y_p, (k_l, v_l, s_l) = trunk_layer(y_p, mod_ctx, lp, None)
        ks_new.append(k_l)
        vs_new.append(v_l)
        ss_new.append(s_l)
        mod_lat = adaln_mod(c, w_mod[l], b_mod[l])
        y_s, _ = trunk_layer(y_s, mod_lat, lp, (cache_k[:, l], cache_v[:, l], state_lru[:, l]))
    new_k = jnp.stack(ks_new, axis=1)
    new_v = jnp.stack(vs_new, axis=1)
    new_state_lru = jnp.stack(ss_new, axis=1)
    return (y_p, y_s, new_k, new_v, new_state_lru)
```

```cpp
#include <hip/hip_runtime.h>
#include <hip/hip_cooperative_groups.h>
#include <stdint.h>
#include <cstdio>
namespace cg = cooperative_groups;

typedef __attribute__((ext_vector_type(8))) short bf16x8;
typedef __attribute__((ext_vector_type(16))) float f32x16;
typedef unsigned short bf16_t;
#define DI __device__ __forceinline__
#define MFMA32(a, b, c) __builtin_amdgcn_mfma_f32_32x32x16_bf16((a), (b), (c), 0, 0, 0)

#define NTOK 10240
#define NPROMPT 8192
#define DM 1024
#define DFF 2816
#define OUT_NK 10485760
#define OUT_NV 14680064
#define OUT_ST 18874368

constexpr size_t OFF_WTIN   = 0;
constexpr size_t OFF_WTOUT  = OFF_WTIN + 16777216;
constexpr size_t OFF_WT13   = OFF_WTOUT + 8388608;
constexpr size_t OFF_WT2    = OFF_WT13 + 46137344;
constexpr size_t OFF_MOD    = OFF_WT2 + 23068672;
constexpr size_t OFF_TAP256 = OFF_MOD + 294912;
constexpr size_t OFF_TAP1024 = OFF_TAP256 + 4194304;
constexpr size_t OFF_KCAT   = OFF_TAP1024 + 16777216;
constexpr size_t OFF_VTL    = OFF_KCAT + 2621440;
constexpr size_t OFF_HBF    = OFF_VTL + 2621440;
constexpr size_t OFF_QBF    = OFF_HBF + 20971520;
constexpr size_t OFF_KBF    = OFF_QBF + 10485760;
constexpr size_t OFF_VTP    = OFF_KBF + 2097152;
constexpr size_t OFF_PBUF   = OFF_VTP + 2097152;
constexpr size_t OFF_MIX    = OFF_PBUF + 52428800;
constexpr size_t OFF_UBF    = OFF_MIX + 20971520;
constexpr size_t OFF_ZBUF   = OFF_UBF + 57671680;
constexpr size_t OFF_CTR    = OFF_ZBUF + 10485760;
constexpr size_t WS_TOTAL   = OFF_CTR + 256;

struct Params {
  const float* in[31];
  float* out;
  char* ws;
};

#define LDS_BYTES 73728
#define LROW 144
#define LTILE (128 * 144)
#define LBUF (2 * LTILE)

DI bf16_t f2bf(float x) { unsigned u = __float_as_uint(x); u += 0x7fffu + ((u >> 16) & 1u); return (bf16_t)(u >> 16); }
DI unsigned pack2(float a, float b) { return (unsigned)f2bf(a) | ((unsigned)f2bf(b) << 16); }
DI int otid() { int t = threadIdx.x; asm volatile("" : "+v"(t)); return t; }
DI void sync_g() { asm volatile("s_waitcnt vmcnt(0)" ::: "memory"); __syncthreads(); }
DI void gsync(unsigned* bar, unsigned& epoch) {
  asm volatile("s_waitcnt vmcnt(0)" ::: "memory");
  __syncthreads();
  if (threadIdx.x == 0) {
    __builtin_amdgcn_fence(__ATOMIC_RELEASE, "agent");
    asm volatile("s_waitcnt vmcnt(0)" ::: "memory");
    epoch++;
    __hip_atomic_fetch_add(bar, 1u, __ATOMIC_RELAXED, __HIP_MEMORY_SCOPE_AGENT);
    const unsigned target = epoch * gridDim.x;
    while (__hip_atomic_load(bar, __ATOMIC_RELAXED, __HIP_MEMORY_SCOPE_AGENT) < target) __builtin_amdgcn_s_sleep(1);
    __builtin_amdgcn_fence(__ATOMIC_ACQUIRE, "agent");
    asm volatile("s_waitcnt vmcnt(0)" ::: "memory");
  }
  __syncthreads();
}
DI float sigmoidf_(float x) { return 1.f / (1.f + __expf(-x)); }

DI void p0_transpose(const float* __restrict__ src, int K, int N, int kt, int nt, bf16_t* __restrict__ dst, int mode, float* T) {
  const int tid = otid();
  const int k0 = kt * 64, n0 = nt * 64;
#pragma unroll
  for (int i = 0; i < 4; ++i) {
    int row = (tid >> 4) + 16 * i, c4 = (tid & 15) * 4;
    float4 v = *(const float4*)(src + (size_t)(k0 + row) * N + n0 + c4);
    T[row * 65 + c4 + 0] = v.x; T[row * 65 + c4 + 1] = v.y; T[row * 65 + c4 + 2] = v.z; T[row * 65 + c4 + 3] = v.w;
  }
  __syncthreads();
  {
    int n = tid >> 2, kq = tid & 3;
    int nrow;
    if (mode == 0) nrow = n0 + n;
    else nrow = nt * 128 + (n >> 5) * 64 + (mode - 1) * 32 + (n & 31);
    unsigned pk[8];
#pragma unroll
    for (int j = 0; j < 8; ++j) pk[j] = pack2(T[(kq * 16 + 2 * j) * 65 + n], T[(kq * 16 + 2 * j + 1) * 65 + n]);
    uint4* d = (uint4*)(dst + (size_t)nrow * K + k0 + kq * 16);
    d[0] = make_uint4(pk[0], pk[1], pk[2], pk[3]);
    d[1] = make_uint4(pk[4], pk[5], pk[6], pk[7]);
  }
  __syncthreads();
}

DI void p0_mod(const Params& p, int l, int cc, float* lds) {
  const int tid = otid();
  float* s = lds;
  float* red = lds + 3072;
  for (int idx = tid; idx < 3072; idx += 256) {
    int ci = idx >> 10, k = idx & 1023;
    float v = (ci == 0) ? p.in[6][k] : p.in[5][(ci - 1) * 1024 + k];
    s[idx] = v / (1.f + expf(-v));
  }
  __syncthreads();
  const int col = tid & 63, kg = tid >> 6;
  const float* W = p.in[7] + (size_t)l * 1024 * 6144 + cc * 64 + col;
  float a0 = 0.f, a1 = 0.f, a2 = 0.f;
#pragma unroll 8
  for (int k = kg * 256; k < kg * 256 + 256; ++k) {
    float w = W[(size_t)k * 6144];
    a0 += s[k] * w; a1 += s[1024 + k] * w; a2 += s[2048 + k] * w;
  }
  red[(kg * 3 + 0) * 64 + col] = a0; red[(kg * 3 + 1) * 64 + col] = a1; red[(kg * 3 + 2) * 64 + col] = a2;
  __syncthreads();
  if (tid < 192) {
    int ci = tid >> 6, c = tid & 63;
    float v = red[(0 * 3 + ci) * 64 + c] + red[(1 * 3 + ci) * 64 + c] + red[(2 * 3 + ci) * 64 + c] + red[(3 * 3 + ci) * 64 + c];
    v += p.in[8][l * 6144 + cc * 64 + c];
    float* mod = (float*)(p.ws + OFF_MOD);
    mod[(l * 3 + ci) * 6144 + cc * 64 + c] = v;
  }
  __syncthreads();
}

DI void p0_taps(const Params& p, int l, int g, float* lds) {
  const int tid = otid();
  float* zf = lds;
  float* h1 = lds + 320;
  float* h2 = lds + 832;
  const int tt0 = g * 8;
  const int L = (tt0 < 256) ? 256 : 1024;
  const int tbase = (tt0 < 256) ? tt0 : tt0 - 256;
  const float invL = 1.f / (float)L;
  for (int idx = tid; idx < 264; idx += 256) {
    int ti = idx / 33, f = idx % 33;
    float t = (float)(tbase + ti);
    float v;
    if (f == 0) v = t * invL;
    else {
      int bi = (f - 1) & 15;
      float band = 1e-4f + (float)bi * ((15.f - 1e-4f) / 15.f);
      float ph = t * band * invL;
      ph -= floorf(ph);
      float ang = 6.283185307179586f * ph;
      v = (f <= 16) ? cosf(ang) : -sinf(ang);
    }
    zf[ti * 40 + f] = v;
  }
  __syncthreads();
  const float* w1 = p.in[20] + l * 33 * 64;
  const float* b1 = p.in[21] + l * 64;
  const float* w2 = p.in[22] + l * 64 * 64;
  const float* b2 = p.in[23] + l * 64;
  const float* w3 = p.in[24] + (size_t)l * 64 * 1024;
  const float* b3 = p.in[25] + l * 1024;
  for (int idx = tid; idx < 512; idx += 256) {
    int ti = idx >> 6, j = idx & 63;
    float a = b1[j];
    for (int f = 0; f < 33; ++f) a += zf[ti * 40 + f] * w1[f * 64 + j];
    h1[ti * 64 + j] = sinf(a);
  }
  __syncthreads();
  for (int idx = tid; idx < 512; idx += 256) {
    int ti = idx >> 6, j = idx & 63;
    float a = b2[j];
    for (int f = 0; f < 64; ++f) a += h1[ti * 64 + f] * w2[f * 64 + j];
    h2[ti * 64 + j] = sinf(a);
  }
  __syncthreads();
  float acc[4][8];
#pragma unroll
  for (int q = 0; q < 4; ++q)
#pragma unroll
    for (int ti = 0; ti < 8; ++ti) acc[q][ti] = 0.f;
  for (int i = 0; i < 64; ++i) {
    float w[4];
#pragma unroll
    for (int q = 0; q < 4; ++q) w[q] = w3[i * 1024 + q * 256 + tid];
#pragma unroll
    for (int ti = 0; ti < 8; ++ti) {
      float hv = h2[ti * 64 + i];
#pragma unroll
      for (int q = 0; q < 4; ++q) acc[q][ti] += hv * w[q];
    }
  }
  const int ch = tid;
  const float d0 = -3.0701134573253945f, d1 = -15.350567286626973f;
  const float delta = d0 + (float)ch * ((d1 - d0) / 255.f);
  float* tapbase = (L == 256) ? (float*)(p.ws + OFF_TAP256) + (size_t)l * 2 * 512 * 256
                              : (float*)(p.ws + OFF_TAP1024) + (size_t)l * 2 * 2048 * 256;
#pragma unroll
  for (int q = 0; q < 4; ++q) {
    const int order = q >> 1, side = q & 1;
    const float bb = b3[q * 256 + ch];
#pragma unroll
    for (int ti = 0; ti < 8; ++ti) {
      int t = tbase + ti;
      float tn = (float)t * invL;
      float val = (acc[q][ti] + bb) * expf(tn * delta);
      int x;
      if (side == 0) x = L + t;
      else { if (t == 0) { x = 0; val = 0.f; } else x = L - t; }
      tapbase[((size_t)order * 2 * L + x) * 256 + ch] = val;
    }
  }
  __syncthreads();
}

DI void p0_cache(const Params& p, int it) {
  const int tid = otid();
  bf16_t* kcat = (bf16_t*)(p.ws + OFF_KCAT);
  bf16_t* vtl = (bf16_t*)(p.ws + OFF_VTL);
  for (int e = tid; e < 4096; e += 256) {
    int rr = it * 32 + (e >> 7), c = e & 127;
    int s = rr & 255, bl = rr >> 8, l = bl & 3, b = bl >> 2;
    float kv = p.in[2][(size_t)rr * 128 + c];
    float vv = p.in[3][(size_t)rr * 128 + c];
    kcat[((size_t)(l * 2 + b) * 1280 + s) * 128 + c] = f2bf(kv);
    int kvh = c >> 6, d = c & 63;
    vtl[((size_t)((l * 2 + b) * 2 + kvh) * 64 + d) * 1280 + s] = f2bf(vv);
  }
}

DI void phase0(const Params& p, char* lds) {
  const int NMOD = 384, NTAP = 640, NCACHE = 64, NTR = 11520;
  const int total = NMOD + NTAP + NCACHE + NTR;
  for (int it = blockIdx.x; it < total; it += gridDim.x) {
    int r = it;
    if (r < NMOD) { p0_mod(p, r / 96, r % 96, (float*)lds); continue; }
    r -= NMOD;
    if (r < NTAP) { p0_taps(p, r / 160, r % 160, (float*)lds); continue; }
    r -= NTAP;
    if (r < NCACHE) { p0_cache(p, r); continue; }
    r -= NCACHE;
    int l = r / 2880; r %= 2880;
    if (r < 512) p0_transpose(p.in[11] + (size_t)l * 1024 * 2048, 1024, 2048, r / 32, r % 32, (bf16_t*)(p.ws + OFF_WTIN) + (size_t)l * 2048 * 1024, 0, (float*)lds);
    else if (r < 768) { r -= 512; p0_transpose(p.in[27] + (size_t)l * 1024 * 1024, 1024, 1024, r / 16, r % 16, (bf16_t*)(p.ws + OFF_WTOUT) + (size_t)l * 1024 * 1024, 0, (float*)lds); }
    else if (r < 1472) { r -= 768; p0_transpose(p.in[28] + (size_t)l * 1024 * 2816, 1024, 2816, r / 44, r % 44, (bf16_t*)(p.ws + OFF_WT13) + (size_t)l * 5632 * 1024, 1, (float*)lds); }
    else if (r < 2176) { r -= 1472; p0_transpose(p.in[29] + (size_t)l * 1024 * 2816, 1024, 2816, r / 44, r % 44, (bf16_t*)(p.ws + OFF_WT13) + (size_t)l * 5632 * 1024, 2, (float*)lds); }
    else { r -= 2176; p0_transpose(p.in[30] + (size_t)l * 2816 * 1024, 2816, 1024, r / 16, r % 16, (bf16_t*)(p.ws + OFF_WT2) + (size_t)l * 1024 * 2816, 0, (float*)lds); }
  }
}

DI void norm_phase(const Params& p, int l, int which) {
  float* xbuf = p.out;
  bf16_t* hbf = (bf16_t*)(p.ws + OFF_HBF);
  const float* mod = (const float*)(p.ws + OFF_MOD);
  const float* nw = p.in[which ? 10 : 9] + l * 1024;
  const int tid_ = otid(); const int wave = tid_ >> 6, lane = tid_ & 63;
  const bool first = (l == 0 && which == 0);
  for (int row = blockIdx.x * 4 + wave; row < NTOK; row += gridDim.x * 4) {
    const float* src;
    if (first) src = (row < NPROMPT) ? p.in[0] + (size_t)row * 1024 : p.in[1] + (size_t)(row - NPROMPT) * 1024;
    else src = xbuf + (size_t)row * 1024;
    float4 v[4];
    float ss = 0.f;
#pragma unroll
    for (int i = 0; i < 4; ++i) {
      v[i] = *(const float4*)(src + i * 256 + lane * 4);
      ss += v[i].x * v[i].x + v[i].y * v[i].y + v[i].z * v[i].z + v[i].w * v[i].w;
    }
#pragma unroll
    for (int o = 32; o >= 1; o >>= 1) ss += __shfl_xor(ss, o);
    const float rstd = rsqrtf(ss * (1.f / 1024.f) + 1e-6f);
    const int ci = (row < NPROMPT) ? 0 : 1 + ((row - NPROMPT) >> 10);
    const float* sh = mod + ((l * 3 + ci) * 6 + (which ? 3 : 0)) * 1024;
    const float* sc = sh + 1024;
#pragma unroll
    for (int i = 0; i < 4; ++i) {
      int col = i * 256 + lane * 4;
      float4 w4 = *(const float4*)(nw + col), s4 = *(const float4*)(sc + col), h4 = *(const float4*)(sh + col);
      float y0 = v[i].x * rstd * w4.x * (1.f + s4.x) + h4.x;
      float y1 = v[i].y * rstd * w4.y * (1.f + s4.y) + h4.y;
      float y2 = v[i].z * rstd * w4.z * (1.f + s4.z) + h4.z;
      float y3 = v[i].w * rstd * w4.w * (1.f + s4.w) + h4.w;
      *(uint2*)(hbf + (size_t)row * 1024 + col) = make_uint2(pack2(y0, y1), pack2(y2, y3));
      if (first) *(float4*)(xbuf + (size_t)row * 1024 + col) = v[i];
    }
  }
}

enum { EPI_IN = 0, EPI_RES = 1, EPI_FFN = 2 };

DI void epi_in(const Params& p, int l, int m0, int nt, const f32x16 (&acc)[2][2], char* lds) {
  const int tid = otid(), lane = tid & 63, wave = tid >> 6;
  const int wm = wave >> 1, wn = wave & 1, r = lane & 31, h = lane >> 5;
  float* Ct = (float*)lds;
#pragma unroll
  for (int i = 0; i < 2; ++i)
#pragma unroll
    for (int j = 0; j < 2; ++j)
#pragma unroll
      for (int reg = 0; reg < 16; ++reg) {
        int row = wm * 64 + i * 32 + (reg & 3) + 8 * (reg >> 2) + 4 * h;
        int col = wn * 64 + j * 32 + r;
        Ct[row * 132 + col] = acc[i][j][reg];
      }
  __syncthreads();
  const bool lat = (m0 >= NPROMPT);
  if (nt < 5) {
    const int row = tid >> 1, hh = tid & 1;
    float* src = Ct + row * 132 + hh * 64;
    float ss = 0.f;
#pragma unroll
    for (int d = 0; d < 64; d += 4) {
      float4 t = *(const float4*)(src + d);
      ss += t.x * t.x + t.y * t.y + t.z * t.z + t.w * t.w;
    }
    const float rstd = rsqrtf(ss * (1.f / 64.f) + 1e-6f);
    const float* nw = (nt < 4 ? p.in[12] : p.in[13]) + l * 64;
    const float osc = (nt < 4) ? 0.125f : 1.f;
    const int m = m0 + row;
    int pos = 0;
    if (lat) {
      pos = (m - NPROMPT) & 1023;
      const float pr = (float)(pos >> 6), pc = (float)(pos & 63);
#pragma unroll 1
      for (int d = 0; d < 16; ++d) {
        const float f = exp2f(-(float)d * 0.8304820237218406f);
        const float ar = pr * f, ac = pc * f;
        const float sr = sinf(ar), cr = cosf(ar), sc_ = sinf(ac), cc_ = cosf(ac);
        float x1 = src[d] * rstd * nw[d], x2 = src[d + 16] * rstd * nw[d + 16];
        src[d] = (x1 * cr - x2 * sr) * osc; src[d + 16] = (x2 * cr + x1 * sr) * osc;
        x1 = src[32 + d] * rstd * nw[32 + d]; x2 = src[48 + d] * rstd * nw[48 + d];
        src[32 + d] = (x1 * cc_ - x2 * sc_) * osc; src[48 + d] = (x2 * cc_ + x1 * sc_) * osc;
      }
    } else {
#pragma unroll
      for (int d = 0; d < 64; d += 4) {
        float4 t = *(const float4*)(src + d);
        float4 w = *(const float4*)(nw + d);
        t.x *= rstd * w.x * osc; t.y *= rstd * w.y * osc; t.z *= rstd * w.z * osc; t.w *= rstd * w.w * osc;
        *(float4*)(src + d) = t;
      }
    }
    bf16_t* dst;
    if (nt < 4) {
      dst = (bf16_t*)(p.ws + OFF_QBF) + (size_t)m * 512 + (nt * 2 + hh) * 64;
    } else if (!lat) {
      const int b = m >> 8, s = m & 255;
      float* nk = p.out + OUT_NK + ((size_t)((b * 4 + l) * 256 + s)) * 128 + hh * 64;
#pragma unroll
      for (int d = 0; d < 64; d += 4) *(float4*)(nk + d) = *(const float4*)(src + d);
      dst = (bf16_t*)(p.ws + OFF_KBF) + (size_t)m * 128 + hh * 64;
    } else {
      const int b2 = (m - NPROMPT) >> 10;
      dst = (bf16_t*)(p.ws + OFF_KCAT) + ((size_t)(l * 2 + b2) * 1280 + 256 + pos) * 128 + hh * 64;
    }
#pragma unroll
    for (int d = 0; d < 64; d += 8) {
      float4 t0 = *(const float4*)(src + d), t1 = *(const float4*)(src + d + 4);
      *(uint4*)(dst + d) = make_uint4(pack2(t0.x, t0.y), pack2(t0.z, t0.w), pack2(t1.x, t1.y), pack2(t1.z, t1.w));
    }
  } else if (nt == 5) {
    if (!lat) {
      const int row = tid >> 1, hf = tid & 1;
      const int m = m0 + row, b = m >> 8, s = m & 255;
      float* nv = p.out + OUT_NV + ((size_t)((b * 4 + l) * 256 + s)) * 128 + hf * 64;
      const float* src = Ct + row * 132 + hf * 64;
#pragma unroll
      for (int d = 0; d < 64; d += 4) *(float4*)(nv + d) = *(const float4*)(src + d);
    }
    {
      const int col = tid & 127, rh = tid >> 7;
      const int kvh = col >> 6, d = col & 63;
      bf16_t* dst;
      if (!lat) {
        const int b = m0 >> 8, s0 = m0 & 255;
        dst = (bf16_t*)(p.ws + OFF_VTP) + ((size_t)((b * 2 + kvh) * 64 + d)) * 256 + s0 + rh * 64;
      } else {
        const int b2 = (m0 - NPROMPT) >> 10, s0 = (m0 - NPROMPT) & 1023;
        dst = (bf16_t*)(p.ws + OFF_VTL) + ((size_t)(((l * 2 + b2) * 2 + kvh) * 64 + d)) * 1280 + 256 + s0 + rh * 64;
      }
      const float* src = Ct + (rh * 64) * 132 + col;
#pragma unroll
      for (int j = 0; j < 64; j += 8)
        *(uint4*)(dst + j) = make_uint4(pack2(src[(j + 0) * 132], src[(j + 1) * 132]), pack2(src[(j + 2) * 132], src[(j + 3) * 132]),
                                        pack2(src[(j + 4) * 132], src[(j + 5) * 132]), pack2(src[(j + 6) * 132], src[(j + 7) * 132]));
    }
  } else {
    const int row = tid >> 1, hf = tid & 1;
    float* dst = (float*)(p.ws + OFF_PBUF) + (size_t)(m0 + row) * 1280 + (nt * 128 - 768) + hf * 64;
    const float* src = Ct + row * 132 + hf * 64;
#pragma unroll
    for (int d = 0; d < 64; d += 4) *(float4*)(dst + d) = *(const float4*)(src + d);
  }
  __syncthreads();
}

template <int EPI>
DI void gemm_phase(const Params& p, int l, const bf16_t* __restrict__ A, int lda, const bf16_t* __restrict__ BT, int ldb, int K, int NT,
                           int modpart, char* lds) {
  const int tid = otid(), lane = tid & 63, wave = tid >> 6;
  const int wm = wave >> 1, wn = wave & 1, r = lane & 31, h = lane >> 5;
  const int ntiles = 80 * NT;
  const int KT = K / 64;
  const int woff = (tid >> 3) * LROW + (tid & 7) * 16;
  for (int t = blockIdx.x; t < ntiles; t += gridDim.x) {
    const int mt = t % 80, nt = t / 80;
    const int m0 = mt * 128, n0 = nt * 128;
    f32x16 acc[2][2];
#pragma unroll
    for (int i = 0; i < 2; ++i)
#pragma unroll
      for (int j = 0; j < 2; ++j)
#pragma unroll
        for (int e = 0; e < 16; ++e) acc[i][j][e] = 0.f;
    const bf16_t* Ag = A + (size_t)(m0 + (tid >> 3)) * lda + (tid & 7) * 8;
    const bf16_t* Bg = BT + (size_t)(n0 + (tid >> 3)) * ldb + (tid & 7) * 8;
    uint4 ra[4], rb[4];
#pragma unroll
    for (int i = 0; i < 4; ++i) {
      ra[i] = *(const uint4*)(Ag + (size_t)i * 32 * lda);
      rb[i] = *(const uint4*)(Bg + (size_t)i * 32 * ldb);
    }
#pragma unroll
    for (int i = 0; i < 4; ++i) {
      *(uint4*)(lds + woff + i * 32 * LROW) = ra[i];
      *(uint4*)(lds + LTILE + woff + i * 32 * LROW) = rb[i];
    }
    __syncthreads();
    for (int kt = 0; kt < KT; ++kt) {
      const char* cur = lds + (kt & 1) * LBUF;
      const bool more = (kt + 1 < KT);
      if (more) {
#pragma unroll
        for (int i = 0; i < 4; ++i) {
          ra[i] = *(const uint4*)(Ag + (size_t)i * 32 * lda + (kt + 1) * 64);
          rb[i] = *(const uint4*)(Bg + (size_t)i * 32 * ldb + (kt + 1) * 64);
        }
      }
#pragma unroll
      for (int st = 0; st < 4; ++st) {
        bf16x8 a0 = *(const bf16x8*)(cur + (wm * 64 + r) * LROW + st * 32 + h * 16);
        bf16x8 a1 = *(const bf16x8*)(cur + (wm * 64 + 32 + r) * LROW + st * 32 + h * 16);
        bf16x8 b0 = *(const bf16x8*)(cur + LTILE + (wn * 64 + r) * LROW + st * 32 + h * 16);
        bf16x8 b1 = *(const bf16x8*)(cur + LTILE + (wn * 64 + 32 + r) * LROW + st * 32 + h * 16);
        acc[0][0] = MFMA32(a0, b0, acc[0][0]);
        acc[0][1] = MFMA32(a0, b1, acc[0][1]);
        acc[1][0] = MFMA32(a1, b0, acc[1][0]);
        acc[1][1] = MFMA32(a1, b1, acc[1][1]);
      }
      if (more) {
        char* nxt = lds + ((kt + 1) & 1) * LBUF;
#pragma unroll
        for (int i = 0; i < 4; ++i) {
          *(uint4*)(nxt + woff + i * 32 * LROW) = ra[i];
          *(uint4*)(nxt + LTILE + woff + i * 32 * LROW) = rb[i];
        }
      }
      __syncthreads();
    }
    if (EPI == EPI_IN) {
      epi_in(p, l, m0, nt, acc, lds);
    } else if (EPI == EPI_RES) {
      const int ci = (m0 < NPROMPT) ? 0 : 1 + ((m0 - NPROMPT) >> 10);
      const float* gate = (const float*)(p.ws + OFF_MOD) + ((l * 3 + ci) * 6 + modpart) * 1024;
      float* xbuf = p.out;
#pragma unroll
      for (int j = 0; j < 2; ++j) {
        const int n = n0 + wn * 64 + j * 32 + r;
        const float g = gate[n];
#pragma unroll
        for (int i = 0; i < 2; ++i)
#pragma unroll
          for (int reg = 0; reg < 16; ++reg) {
            const int m = m0 + wm * 64 + i * 32 + (reg & 3) + 8 * (reg >> 2) + 4 * h;
            float* xp = xbuf + (size_t)m * 1024 + n;
            *xp = *xp + g * acc[i][j][reg];
          }
      }
    } else {
      bf16_t* ubf = (bf16_t*)(p.ws + OFF_UBF);
      const int n = nt * 64 + wn * 32 + r;
#pragma unroll
      for (int i = 0; i < 2; ++i)
#pragma unroll
        for (int reg = 0; reg < 16; ++reg) {
          const int m = m0 + wm * 64 + i * 32 + (reg & 3) + 8 * (reg >> 2) + 4 * h;
          const float a = acc[i][0][reg], b = acc[i][1][reg];
          ubf[(size_t)m * DFF + n] = f2bf(a * sigmoidf_(a) * b);
        }
    }
  }
}

DI void attn_wave(const bf16_t* __restrict__ q, const bf16_t* __restrict__ kp, const bf16_t* __restrict__ vt, int nkeys, bf16_t* __restrict__ o) {
  const int lane = otid() & 63, r = lane & 31, h = lane >> 5;
  bf16x8 qf[4];
#pragma unroll
  for (int st = 0; st < 4; ++st) qf[st] = *(const bf16x8*)(q + (size_t)r * 512 + st * 16 + h * 8);
  f32x16 O[2];
#pragma unroll
  for (int e = 0; e < 16; ++e) { O[0][e] = 0.f; O[1][e] = 0.f; }
  float m = -1e30f, lsum = 0.f;
  for (int k0 = 0; k0 < nkeys; k0 += 64) {
    f32x16 S[2];
#pragma unroll
    for (int sub = 0; sub < 2; ++sub) {
#pragma unroll
      for (int e = 0; e < 16; ++e) S[sub][e] = 0.f;
#pragma unroll
      for (int st = 0; st < 4; ++st) {
        bf16x8 kf = *(const bf16x8*)(kp + (size_t)(k0 + sub * 32 + r) * 128 + st * 16 + h * 8);
        S[sub] = MFMA32(kf, qf[st], S[sub]);
      }
    }
    float mx = m;
#pragma unroll
    for (int sub = 0; sub < 2; ++sub)
#pragma unroll
      for (int e = 0; e < 16; ++e) mx = fmaxf(mx, S[sub][e]);
    mx = fmaxf(mx, __shfl_xor(mx, 32));
    const float alpha = __expf(m - mx);
    m = mx;
    float ps = 0.f;
#pragma unroll
    for (int sub = 0; sub < 2; ++sub)
#pragma unroll
      for (int e = 0; e < 16; ++e) { float pv = __expf(S[sub][e] - mx); S[sub][e] = pv; ps += pv; }
    lsum = lsum * alpha + ps;
#pragma unroll
    for (int e = 0; e < 16; ++e) { O[0][e] *= alpha; O[1][e] *= alpha; }
#pragma unroll
    for (int sub = 0; sub < 2; ++sub)
#pragma unroll
      for (int s = 0; s < 2; ++s) {
        union { unsigned u[4]; bf16x8 v; } pf;
#pragma unroll
        for (int j = 0; j < 4; ++j) pf.u[j] = pack2(S[sub][8 * s + 2 * j], S[sub][8 * s + 2 * j + 1]);
        const int kb = k0 + sub * 32 + 16 * s + 4 * h;
#pragma unroll
        for (int dt = 0; dt < 2; ++dt) {
          const bf16_t* vp = vt + (size_t)(r + 32 * dt) * nkeys + kb;
          union { uint2 u[2]; bf16x8 v; } vf;
          vf.u[0] = *(const uint2*)(vp);
          vf.u[1] = *(const uint2*)(vp + 8);
          O[dt] = MFMA32(vf.v, pf.v, O[dt]);
        }
      }
  }
  lsum += __shfl_xor(lsum, 32);
  const float inv = 1.f / lsum;
#pragma unroll
  for (int dt = 0; dt < 2; ++dt)
#pragma unroll
    for (int g = 0; g < 4; ++g) {
      const int d = dt * 32 + 8 * g + 4 * h;
      *(uint2*)(o + (size_t)r * 1024 + d) = make_uint2(pack2(O[dt][4 * g] * inv, O[dt][4 * g + 1] * inv), pack2(O[dt][4 * g + 2] * inv, O[dt][4 * g + 3] * inv));
    }
}

DI float gelu_tanh(float x) { return 0.5f * x * (1.f + tanhf(0.7978845608028654f * (x + 0.044715f * x * x * x))); }

template <int DIR>
DI float lru_sweep(const Params& p, int l, int L, int tok0, int n, float h0, char* lds) {
  const int tid = otid(), lane = tid & 63, wave = tid >> 6, r = lane & 31, h = lane >> 5;
  bf16_t* Axc = (bf16_t*)lds;
  float* XC = (float*)(lds + 9216);
  float* G = (float*)(lds + 25600);
  float2* SEG = (float2*)(lds + 58368);
  float* CARRY = (float*)(lds + 60416);
  const float* pbuf = (const float*)(p.ws + OFF_PBUF);
  float* hfbuf = (float*)(p.ws + OFF_UBF);
  bf16_t* mix = (bf16_t*)(p.ws + OFF_MIX);
  const int gate = wave & 1, rt = wave >> 1;
  const float* W = p.in[16] + ((size_t)((l * 2 + DIR) * 2 + gate) * 4 + n) * 4096;
  bf16x8 wf[2][4];
  float gb[2];
#pragma unroll
  for (int ct = 0; ct < 2; ++ct) {
    const int j = r + 32 * ct;
    gb[ct] = p.in[17][((l * 2 + DIR) * 2 + gate) * 256 + n * 64 + j];
#pragma unroll
    for (int st = 0; st < 4; ++st) {
      const int i0 = 16 * st + 8 * h;
      union { unsigned u[4]; bf16x8 v; } f;
#pragma unroll
      for (int jj = 0; jj < 4; ++jj) f.u[jj] = pack2(W[(i0 + 2 * jj) * 64 + j], W[(i0 + 2 * jj + 1) * 64 + j]);
      wf[ct][st] = f.v;
    }
  }
  const int ch = tid & 63, tq = tid >> 6;
  const int gch = n * 64 + ch;
  float cw[4];
#pragma unroll
  for (int k = 0; k < 4; ++k) cw[k] = p.in[14][(l * 4 + k) * 256 + gch];
  const float cb = p.in[15][l * 256 + gch];
  const float sp = log1pf(expf(-p.in[18][(l * 2 + DIR) * 256 + gch]));
  if (tid < 64) CARRY[ch] = h0;
  const int NC = L / 64;
  for (int ci = 0; ci < NC; ++ci) {
    const int c = DIR ? NC - 1 - ci : ci;
#pragma unroll
    for (int e = 0; e < 16; ++e) {
      const int tl = tq * 16 + e, t = c * 64 + tl;
      float xv = cb;
#pragma unroll
      for (int k = 0; k < 4; ++k) {
        const int ts = t + k - 2;
        if (ts >= 0 && ts < L) xv += cw[k] * pbuf[(size_t)(tok0 + ts) * 1280 + gch];
      }
      XC[tl * 64 + ch] = xv;
      Axc[tl * 72 + ch] = f2bf(xv);
    }
    __syncthreads();
    {
      f32x16 acc[2];
#pragma unroll
      for (int e = 0; e < 16; ++e) { acc[0][e] = 0.f; acc[1][e] = 0.f; }
#pragma unroll
      for (int st = 0; st < 4; ++st) {
        bf16x8 af = *(const bf16x8*)(Axc + (rt * 32 + r) * 72 + 16 * st + 8 * h);
        acc[0] = MFMA32(af, wf[0][st], acc[0]);
        acc[1] = MFMA32(af, wf[1][st], acc[1]);
      }
#pragma unroll
      for (int ct = 0; ct < 2; ++ct)
#pragma unroll
        for (int reg = 0; reg < 16; ++reg) {
          const int tok = rt * 32 + (reg & 3) + 8 * (reg >> 2) + 4 * h;
          G[(gate * 64 + tok) * 64 + r + 32 * ct] = sigmoidf_(acc[ct][reg] + gb[ct]);
        }
    }
    __syncthreads();
    float hloc[16], acum[16];
    {
      float hl = 0.f, Ac = 1.f;
#pragma unroll
      for (int ee = 0; ee < 16; ++ee) {
        const int e = DIR ? 15 - ee : ee;
        const int tl = tq * 16 + e;
        const float xv = XC[tl * 64 + ch];
        const float rr = G[(0 * 64 + tl) * 64 + ch], ii = G[(1 * 64 + tl) * 64 + ch];
        const float la = -8.f * rr * sp;
        const float a = expf(la);
        const float b = sqrtf(-expm1f(2.f * la)) * (ii * xv);
        hl = a * hl + b; Ac *= a;
        hloc[e] = hl; acum[e] = Ac;
      }
      SEG[tq * 64 + ch] = make_float2(Ac, hl);
    }
    __syncthreads();
    {
      float hin = CARRY[(ci & 1) * 64 + ch];
      if (DIR == 0) { for (int q = 0; q < tq; ++q) { float2 sg = SEG[q * 64 + ch]; hin = sg.x * hin + sg.y; } }
      else { for (int q = 3; q > tq; --q) { float2 sg = SEG[q * 64 + ch]; hin = sg.x * hin + sg.y; } }
#pragma unroll
      for (int e = 0; e < 16; ++e) {
        const size_t tok = (size_t)tok0 + c * 64 + tq * 16 + e;
        const float hv = acum[e] * hin + hloc[e];
        if (DIR == 0) hfbuf[tok * 256 + gch] = hv;
        else {
          const float tot = hfbuf[tok * 256 + gch] + hv;
          const float g = pbuf[tok * 1280 + 256 + gch];
          mix[tok * 1024 + 512 + gch] = f2bf(gelu_tanh(g) * tot);
        }
      }
      const int lastq = DIR ? 0 : 3, laste = DIR ? 0 : 15;
      if (tq == lastq) CARRY[((ci + 1) & 1) * 64 + ch] = acum[laste] * hin + hloc[laste];
    }
  }
  __syncthreads();
  const float hfin = CARRY[(NC & 1) * 64 + ch];
  __syncthreads();
  return hfin;
}

DI void lru_item(const Params& p, int l, int bidx, int n, char* lds) {
  const int tid = otid();
  const bool lat = bidx >= 32;
  const int L = lat ? 1024 : 256;
  const int tok0 = lat ? NPROMPT + (bidx - 32) * 1024 : bidx * 256;
  const int gch = n * 64 + (tid & 63);
  const float h0f = lat ? p.in[4][(((bidx - 32) * 4 + l) * 2 + 0) * 256 + gch] : 0.f;
  const float h0b = lat ? p.in[4][(((bidx - 32) * 4 + l) * 2 + 1) * 256 + gch] : 0.f;
  const float hF = lru_sweep<0>(p, l, L, tok0, n, h0f, lds);
  const float hB = lru_sweep<1>(p, l, L, tok0, n, h0b, lds);
  if (!lat && tid < 64) {
    p.out[OUT_ST + ((size_t)(bidx * 4 + l) * 2 + 0) * 256 + gch] = hF;
    p.out[OUT_ST + ((size_t)(bidx * 4 + l) * 2 + 1) * 256 + gch] = hB;
  }
}

template <int CG, int L>
DI void hy_conv16(const float* __restrict__ Kc, const float* U, int ch, int t0, float (&acc)[16]) {
#pragma unroll
  for (int i = 0; i < 16; ++i) acc[i] = 0.f;
  for (int s0 = 0; s0 < L; s0 += 16) {
    float w[31], uu[16];
    const int xb = t0 - s0 + L - 15;
#pragma unroll
    for (int j = 0; j < 31; ++j) w[j] = Kc[(size_t)(xb + j) * 256];
#pragma unroll
    for (int ss = 0; ss < 16; ++ss) uu[ss] = U[(s0 + ss) * CG + ch];
#pragma unroll
    for (int i = 0; i < 16; ++i)
#pragma unroll
      for (int ss = 0; ss < 16; ++ss) acc[i] += w[i + 15 - ss] * uu[ss];
  }
}

DI float conv3_at(const float* __restrict__ pb, int t, int L, float w0, float w1, float w2) {
  float v = w1 * pb[(size_t)t * 1280];
  if (t > 0) v += w0 * pb[(size_t)(t - 1) * 1280];
  if (t < L - 1) v += w2 * pb[(size_t)(t + 1) * 1280];
  return v;
}

template <int CG, int L>
DI void hy_item(const Params& p, int l, int tok0, int c0, char* lds) {
  const int tid = otid();
  float* U = (float*)lds;
  float* Z = (float*)(lds + 32768);
  constexpr int TPT = L * CG / 256;
  const float* pbuf = (const float*)(p.ws + OFF_PBUF) + (size_t)tok0 * 1280 + 512;
  bf16_t* mix = (bf16_t*)(p.ws + OFF_MIX) + (size_t)tok0 * 1024 + 768;
  const float* hcw = p.in[19] + l * 3 * 768;
  const float* taps = (L == 256) ? (const float*)(p.ws + OFF_TAP256) + (size_t)l * 2 * 512 * 256
                                 : (const float*)(p.ws + OFF_TAP1024) + (size_t)l * 2 * 2048 * 256;
  for (int idx = tid; idx < L * CG; idx += 256) {
    const int ch = idx % CG, s = idx / CG;
    const int c = c0 + ch;
    U[idx] = conv3_at(pbuf + c, s, L, hcw[c], hcw[768 + c], hcw[1536 + c]);
  }
  __syncthreads();
  const int ch = tid % CG, tg = tid / CG;
  const int c = c0 + ch;
  const float skip0 = p.in[26][(l * 2 + 0) * 256 + c], skip1 = p.in[26][(l * 2 + 1) * 256 + c];
  const float a0 = hcw[256 + c], a1 = hcw[768 + 256 + c], a2 = hcw[1536 + 256 + c];
  const float b0 = hcw[512 + c], b1 = hcw[768 + 512 + c], b2 = hcw[1536 + 512 + c];
  for (int ps = 0; ps < TPT / 16; ++ps) {
    const int t0 = tg * TPT + ps * 16;
    float acc[16];
    hy_conv16<CG, L>(taps + c, U, ch, t0, acc);
#pragma unroll
    for (int i = 0; i < 16; ++i) {
      const int t = t0 + i;
      const float y1 = acc[i] + skip0 * U[t * CG + ch];
      const float x1 = conv3_at(pbuf + 256 + c, t, L, a0, a1, a2);
      Z[t * CG + ch] = x1 * y1;
    }
  }
  __syncthreads();
  for (int ps = 0; ps < TPT / 16; ++ps) {
    const int t0 = tg * TPT + ps * 16;
    float acc[16];
    hy_conv16<CG, L>(taps + (size_t)2 * L * 256 + c, Z, ch, t0, acc);
#pragma unroll
    for (int i = 0; i < 16; ++i) {
      const int t = t0 + i;
      const float y2 = acc[i] + skip1 * Z[t * CG + ch];
      const float x2 = conv3_at(pbuf + 512 + c, t, L, b0, b1, b2);
      mix[(size_t)t * 1024 + c] = f2bf(x2 * y2);
    }
  }
  __syncthreads();
}

#ifndef MIX_MASK
#define MIX_MASK 7
#endif
DI void mixer_phase(const Params& p, int l, char* lds, int* s_item) {
  const int tid = otid(), wave = tid >> 6;
  int* ctr = (int*)(p.ws + OFF_CTR);
  bf16_t* mix = (bf16_t*)(p.ws + OFF_MIX);
  const bf16_t* qbf = (const bf16_t*)(p.ws + OFF_QBF);
  for (;;) {
    if (tid == 0) *s_item = atomicAdd(&ctr[l], 1);
    __syncthreads();
    const int it = *s_item;
    __syncthreads();
    if (it >= 1096) break;
    if (it < 64) {
      if (MIX_MASK & 4) hy_item<8, 1024>(p, l, NPROMPT + (it >> 5) * 1024, (it & 31) * 8, lds);
    } else if (it < 72) {
      const int j = it - 64;
      if (MIX_MASK & 2) lru_item(p, l, 32 + (j >> 2), j & 3, lds);
    } else if (it < 200) {
      const int j = it - 72, b2 = j >> 6, head = (j >> 3) & 7, qb = j & 7, kvh = head >> 2;
      const int qtok = NPROMPT + b2 * 1024 + qb * 128 + wave * 32;
      if (MIX_MASK & 1) attn_wave(qbf + (size_t)qtok * 512 + head * 64,
                (const bf16_t*)(p.ws + OFF_KCAT) + (size_t)(l * 2 + b2) * 1280 * 128 + kvh * 64,
                (const bf16_t*)(p.ws + OFF_VTL) + (size_t)((l * 2 + b2) * 2 + kvh) * 64 * 1280, 1280,
                mix + (size_t)qtok * 1024 + head * 64);
    } else if (it < 456) {
      const int j = it - 200;
      if (MIX_MASK & 4) hy_item<32, 256>(p, l, (j >> 3) * 256, (j & 7) * 32, lds);
    } else if (it < 584) {
      const int j = it - 456;
      if (MIX_MASK & 2) lru_item(p, l, j >> 2, j & 3, lds);
    } else {
      const int j = it - 584, b = j >> 4, head = (j >> 1) & 7, qb = j & 1, kvh = head >> 2;
      const int qtok = b * 256 + qb * 128 + wave * 32;
      if (MIX_MASK & 1) attn_wave(qbf + (size_t)qtok * 512 + head * 64,
                (const bf16_t*)(p.ws + OFF_KBF) + (size_t)(b * 256) * 128 + kvh * 64,
                (const bf16_t*)(p.ws + OFF_VTP) + (size_t)(b * 2 + kvh) * 64 * 256, 256,
                mix + (size_t)qtok * 1024 + head * 64);
    }
  }
}

#ifndef PHASE_SEL
#define PHASE_SEL -1
#endif
#define PSEL(k) (PHASE_SEL < 0 || PHASE_SEL == (k))
#ifndef STOP_P
#define STOP_P -1
#endif
#ifndef STOP_L
#define STOP_L 0
#endif
#define STOPAT(k) if (STOP_P == (k) && l == STOP_L) return;
__global__ void __launch_bounds__(256, 2) fwd_megakernel(Params p) {
  cg::grid_group grid = cg::this_grid();
  __shared__ __attribute__((aligned(16))) char lds[LDS_BYTES];
  __shared__ int s_item;
  unsigned* bar = (unsigned*)(p.ws + OFF_CTR) + 32;
  unsigned epoch = 0;
  grid.sync();
  if (PSEL(0)) phase0(p, lds);
  gsync(bar, epoch);
  const bf16_t* hbf = (const bf16_t*)(p.ws + OFF_HBF);
  for (int l = 0; l < 4; ++l) {
    if (PSEL(1)) norm_phase(p, l, 0);
    gsync(bar, epoch);
    STOPAT(1)
    if (PSEL(2)) gemm_phase<EPI_IN>(p, l, hbf, 1024, (const bf16_t*)(p.ws + OFF_WTIN) + (size_t)l * 2048 * 1024, 1024, 1024, 16, 0, lds);
    gsync(bar, epoch);
    STOPAT(2)
    if (PSEL(3)) mixer_phase(p, l, lds, &s_item);
    gsync(bar, epoch);
    STOPAT(3)
    if (PSEL(4)) gemm_phase<EPI_RES>(p, l, (const bf16_t*)(p.ws + OFF_MIX), 1024, (const bf16_t*)(p.ws + OFF_WTOUT) + (size_t)l * 1024 * 1024, 1024, 1024, 8, 2, lds);
    gsync(bar, epoch);
    STOPAT(4)
    if (PSEL(1)) norm_phase(p, l, 1);
    gsync(bar, epoch);
    STOPAT(5)
    if (PSEL(5)) gemm_phase<EPI_FFN>(p, l, hbf, 1024, (const bf16_t*)(p.ws + OFF_WT13) + (size_t)l * 5632 * 1024, 1024, 1024, 44, 0, lds);
    gsync(bar, epoch);
    STOPAT(6)
    if (PSEL(4)) gemm_phase<EPI_RES>(p, l, (const bf16_t*)(p.ws + OFF_UBF), DFF, (const bf16_t*)(p.ws + OFF_WT2) + (size_t)l * 1024 * DFF, DFF, DFF, 8, 5, lds);
    gsync(bar, epoch);
    STOPAT(7)
  }
}

#ifndef MULTI_LAUNCH
#define MULTI_LAUNCH 1
#endif
__global__ void __launch_bounds__(256, 2) phase_kernel(Params p, int phase, int l) {
  __shared__ __attribute__((aligned(16))) char lds[LDS_BYTES];
  __shared__ int s_item;
  const bf16_t* hbf = (const bf16_t*)(p.ws + OFF_HBF);
  switch (phase) {
    case 0: phase0(p, lds); break;
    case 1: norm_phase(p, l, 0); break;
    case 2: gemm_phase<EPI_IN>(p, l, hbf, 1024, (const bf16_t*)(p.ws + OFF_WTIN) + (size_t)l * 2048 * 1024, 1024, 1024, 16, 0, lds); break;
    case 3: mixer_phase(p, l, lds, &s_item); break;
    case 4: gemm_phase<EPI_RES>(p, l, (const bf16_t*)(p.ws + OFF_MIX), 1024, (const bf16_t*)(p.ws + OFF_WTOUT) + (size_t)l * 1024 * 1024, 1024, 1024, 8, 2, lds); break;
    case 5: norm_phase(p, l, 1); break;
    case 6: gemm_phase<EPI_FFN>(p, l, hbf, 1024, (const bf16_t*)(p.ws + OFF_WT13) + (size_t)l * 5632 * 1024, 1024, 1024, 44, 0, lds); break;
    default: gemm_phase<EPI_RES>(p, l, (const bf16_t*)(p.ws + OFF_UBF), DFF, (const bf16_t*)(p.ws + OFF_WT2) + (size_t)l * 1024 * DFF, DFF, DFF, 8, 5, lds); break;
  }
}

extern "C" void kernel_launch(void* const* d_in, const int* in_sizes, int n_in, void* d_out, int out_size, void* d_ws, size_t ws_size,
                              hipStream_t stream) {
  static int grid_blocks = 0;
  if (!grid_blocks) {
    int dev = 0, cus = 0, per_cu = 0;
    hipGetDevice(&dev);
    hipDeviceGetAttribute(&cus, hipDeviceAttributeMultiprocessorCount, dev);
    hipOccupancyMaxActiveBlocksPerMultiprocessor(&per_cu, fwd_megakernel, 256, 0);
    if (per_cu > 2) per_cu = 2;
    if (per_cu < 1) per_cu = 1;
    grid_blocks = cus * per_cu;
  }
  Params p{};
  for (int i = 0; i < 31; ++i) p.in[i] = (const float*)d_in[i];
  p.out = (float*)d_out;
  p.ws = (char*)d_ws;
  (void)hipMemsetAsync((char*)d_ws + OFF_CTR, 0, 256, stream);
#if MULTI_LAUNCH
  hipLaunchKernelGGL(phase_kernel, dim3(512), dim3(256), 0, stream, p, 0, 0);
  for (int l = 0; l < 4; ++l)
    for (int ph = 1; ph <= 7; ++ph) hipLaunchKernelGGL(phase_kernel, dim3(512), dim3(256), 0, stream, p, ph, l);
  return;
#endif
  void* args[] = {&p};
  hipError_t e = hipLaunchCooperativeKernel((void*)fwd_megakernel, dim3(grid_blocks), dim3(256), args, 0, stream);
  if (e != hipSuccess) fprintf(stderr, "cooperative launch failed: %s (grid %d)\n", hipGetErrorString(e), grid_blocks);
}
```

```cpp
#include <hip/hip_runtime.h>
#include <hip/hip_cooperative_groups.h>
#include <stdint.h>
#include <cstdio>
namespace cg = cooperative_groups;

typedef __attribute__((ext_vector_type(8))) short bf16x8;
typedef __attribute__((ext_vector_type(16))) float f32x16;
typedef unsigned short bf16_t;
#define DI __device__ __forceinline__
#define MFMA32(a, b, c) __builtin_amdgcn_mfma_f32_32x32x16_bf16((a), (b), (c), 0, 0, 0)

#define NTOK 10240
#define NPROMPT 8192
#define DM 1024
#define DFF 2816
#define OUT_NK 10485760
#define OUT_NV 14680064
#define OUT_ST 18874368

constexpr size_t OFF_WTIN   = 0;
constexpr size_t OFF_WTOUT  = OFF_WTIN + 16777216;
constexpr size_t OFF_WT13   = OFF_WTOUT + 8388608;
constexpr size_t OFF_WT2    = OFF_WT13 + 46137344;
constexpr size_t OFF_MOD    = OFF_WT2 + 23068672;
constexpr size_t OFF_TAP256 = OFF_MOD + 294912;
constexpr size_t OFF_TAP1024 = OFF_TAP256 + 4194304;
constexpr size_t OFF_KCAT   = OFF_TAP1024 + 16777216;
constexpr size_t OFF_VTL    = OFF_KCAT + 2621440;
constexpr size_t OFF_HBF    = OFF_VTL + 2621440;
constexpr size_t OFF_QBF    = OFF_HBF + 20971520;
constexpr size_t OFF_KBF    = OFF_QBF + 10485760;
constexpr size_t OFF_VTP    = OFF_KBF + 2097152;
constexpr size_t OFF_PBUF   = OFF_VTP + 2097152;
constexpr size_t OFF_MIX    = OFF_PBUF + 52428800;
constexpr size_t OFF_UBF    = OFF_MIX + 20971520;
constexpr size_t OFF_ZBUF   = OFF_UBF + 57671680;
constexpr size_t OFF_CTR    = OFF_ZBUF + 10485760;
constexpr size_t OFF_PHY    = OFF_CTR + 16384;
constexpr size_t WS_TOTAL   = OFF_PHY + (size_t)64 * 10240 * 12 * 4;

struct Params {
  const float* in[31];
  float* out;
  char* ws;
};

#define LDS_BYTES 73728
#define LROW 144
#define LTILE (128 * 144)
#define LBUF (2 * LTILE)

DI bf16_t f2bf(float x) { unsigned u = __float_as_uint(x); u += 0x7fffu + ((u >> 16) & 1u); return (bf16_t)(u >> 16); }
DI unsigned pack2(float a, float b) { return (unsigned)f2bf(a) | ((unsigned)f2bf(b) << 16); }
DI size_t blk(int m, int k, int KTF) { return ((size_t)((m >> 7) * KTF + (k >> 6)) * 128 + (m & 127)) * 64 + (k & 63); }
DI int otid() { int t = threadIdx.x; asm volatile("" : "+v"(t)); return t; }
DI void sync_g() { asm volatile("s_waitcnt vmcnt(0)" ::: "memory"); __syncthreads(); }
#define CW_CNT(j) (64 * (1 + (j)))
#define CW_SUB(j) (64 * (17 + (j)))
#define CW_TOP (64 * 33)
#define CW_GEN (64 * 34)
#define CW_XGEN(j) (64 * (35 + (j)))
#define CTL_BYTES 16384
struct GBar { unsigned* w; unsigned x, nloc, nx, epoch; };
DI unsigned gb_ld(unsigned* p) { return __hip_atomic_load(p, __ATOMIC_RELAXED, __HIP_MEMORY_SCOPE_AGENT); }
DI unsigned gb_add(unsigned* p, unsigned v) { return __hip_atomic_fetch_add(p, v, __ATOMIC_RELAXED, __HIP_MEMORY_SCOPE_AGENT); }
DI void gsync1(GBar& g) {
  asm volatile("s_waitcnt vmcnt(0)" ::: "memory");
  __syncthreads();
  if (threadIdx.x == 0) {
    g.epoch++;
    const unsigned old = gb_add(&g.w[CW_SUB(g.x)], 1u);
    if (old + 1u == g.epoch * g.nloc) {
      __builtin_amdgcn_fence(__ATOMIC_RELEASE, "agent");
      asm volatile("s_waitcnt vmcnt(0)" ::: "memory");
      const unsigned old2 = gb_add(&g.w[CW_TOP], 1u);
      if (old2 + 1u == g.epoch * g.nx) (void)gb_add(&g.w[CW_GEN], 1u);
      while (gb_ld(&g.w[CW_GEN]) < g.epoch) __builtin_amdgcn_s_sleep(2);
      (void)gb_add(&g.w[CW_XGEN(g.x)], 1u);
    } else {
      while (gb_ld(&g.w[CW_XGEN(g.x)]) < g.epoch) __builtin_amdgcn_s_sleep(2);
    }
    __builtin_amdgcn_fence(__ATOMIC_ACQUIRE, "agent");
    asm volatile("s_waitcnt vmcnt(0)" ::: "memory");
  }
  __syncthreads();
}
DI float fast_sigmoid(float x) { return __builtin_amdgcn_rcpf(1.f + __expf(-x)); }
DI float sigmoidf_(float x) { return 1.f / (1.f + __expf(-x)); }

DI void p0_transpose(const float* __restrict__ src, int K, int N, int kt, int nt, bf16_t* __restrict__ dst, int mode) {
  const int tid = otid();
  const int n = tid & 63, c = nt * 64 + n, k0 = kt * 128 + (tid >> 6) * 32;
  float v[32];
#pragma unroll
  for (int j = 0; j < 32; ++j) v[j] = src[(size_t)(k0 + j) * N + c];
  int nrow;
  if (mode == 0) nrow = c;
  else nrow = nt * 128 + (n >> 5) * 64 + (mode - 1) * 32 + (n & 31);
  uint4* d = (uint4*)(dst + blk(nrow, k0, K >> 6));
#pragma unroll
  for (int q = 0; q < 4; ++q)
    d[q] = make_uint4(pack2(v[8 * q], v[8 * q + 1]), pack2(v[8 * q + 2], v[8 * q + 3]), pack2(v[8 * q + 4], v[8 * q + 5]), pack2(v[8 * q + 6], v[8 * q + 7]));
}

DI void p0_mod(const Params& p, int l, int cc, float* lds) {
  const int tid = otid();
  float* s = lds;
  float* red = lds + 3072;
  for (int idx = tid; idx < 3072; idx += 256) {
    int ci = idx >> 10, k = idx & 1023;
    float v = (ci == 0) ? p.in[6][k] : p.in[5][(ci - 1) * 1024 + k];
    s[idx] = v / (1.f + expf(-v));
  }
  __syncthreads();
  const int col = tid & 63, kg = tid >> 6;
  const float* W = p.in[7] + (size_t)l * 1024 * 6144 + cc * 64 + col;
  float a0 = 0.f, a1 = 0.f, a2 = 0.f;
#pragma unroll 16
  for (int k = kg * 256; k < kg * 256 + 256; ++k) {
    float w = W[(size_t)k * 6144];
    a0 += s[k] * w; a1 += s[1024 + k] * w; a2 += s[2048 + k] * w;
  }
  red[(kg * 3 + 0) * 64 + col] = a0; red[(kg * 3 + 1) * 64 + col] = a1; red[(kg * 3 + 2) * 64 + col] = a2;
  __syncthreads();
  if (tid < 192) {
    int ci = tid >> 6, c = tid & 63;
    float v = red[(0 * 3 + ci) * 64 + c] + red[(1 * 3 + ci) * 64 + c] + red[(2 * 3 + ci) * 64 + c] + red[(3 * 3 + ci) * 64 + c];
    v += p.in[8][l * 6144 + cc * 64 + c];
    float* mod = (float*)(p.ws + OFF_MOD);
    mod[(l * 3 + ci) * 6144 + cc * 64 + c] = v;
  }
  __syncthreads();
}

DI void p0_taps(const Params& p, int l, int g, float* lds) {
  const int tid = otid();
  float* zf = lds;
  float* h1 = lds + 320;
  float* h2 = lds + 832;
  const int tt0 = g * 8;
  const int L = (tt0 < 256) ? 256 : 1024;
  const int tbase = (tt0 < 256) ? tt0 : tt0 - 256;
  const float invL = 1.f / (float)L;
  for (int idx = tid; idx < 264; idx += 256) {
    int ti = idx / 33, f = idx % 33;
    float t = (float)(tbase + ti);
    float v;
    if (f == 0) v = t * invL;
    else {
      int bi = (f - 1) & 15;
      float band = 1e-4f + (float)bi * ((15.f - 1e-4f) / 15.f);
      float ph = t * band * invL;
      ph -= floorf(ph);
      float ang = 6.283185307179586f * ph;
      v = (f <= 16) ? cosf(ang) : -sinf(ang);
    }
    zf[ti * 40 + f] = v;
  }
  __syncthreads();
  const float* w1 = p.in[20] + l * 33 * 64;
  const float* b1 = p.in[21] + l * 64;
  const float* w2 = p.in[22] + l * 64 * 64;
  const float* b2 = p.in[23] + l * 64;
  const float* w3 = p.in[24] + (size_t)l * 64 * 1024;
  const float* b3 = p.in[25] + l * 1024;
  for (int idx = tid; idx < 512; idx += 256) {
    int ti = idx >> 6, j = idx & 63;
    float a = b1[j];
#pragma unroll 11
    for (int f = 0; f < 33; ++f) a += zf[ti * 40 + f] * w1[f * 64 + j];
    h1[ti * 64 + j] = sinf(a);
  }
  __syncthreads();
  for (int idx = tid; idx < 512; idx += 256) {
    int ti = idx >> 6, j = idx & 63;
    float a = b2[j];
#pragma unroll 16
    for (int f = 0; f < 64; ++f) a += h1[ti * 64 + f] * w2[f * 64 + j];
    h2[ti * 64 + j] = sinf(a);
  }
  __syncthreads();
  float acc[4][8];
#pragma unroll
  for (int q = 0; q < 4; ++q)
#pragma unroll
    for (int ti = 0; ti < 8; ++ti) acc[q][ti] = 0.f;
#pragma unroll 8
  for (int i = 0; i < 64; ++i) {
    float w[4];
#pragma unroll
    for (int q = 0; q < 4; ++q) w[q] = w3[i * 1024 + q * 256 + tid];
#pragma unroll
    for (int ti = 0; ti < 8; ++ti) {
      float hv = h2[ti * 64 + i];
#pragma unroll
      for (int q = 0; q < 4; ++q) acc[q][ti] += hv * w[q];
    }
  }
  const int ch = tid;
  const float d0 = -3.0701134573253945f, d1 = -15.350567286626973f;
  const float delta = d0 + (float)ch * ((d1 - d0) / 255.f);
  bf16_t* tapbase = (L == 256) ? (bf16_t*)(p.ws + OFF_TAP256) + (size_t)l * 2 * 256 * 512
                               : (bf16_t*)(p.ws + OFF_TAP1024) + (size_t)l * 2 * 256 * 2048;
#pragma unroll
  for (int q = 0; q < 4; ++q) {
    const int order = q >> 1, side = q & 1;
    const float bb = b3[q * 256 + ch];
#pragma unroll
    for (int ti = 0; ti < 8; ++ti) {
      int t = tbase + ti;
      float tn = (float)t * invL;
      float val = (acc[q][ti] + bb) * expf(tn * delta);
      int x;
      if (side == 0) x = L + t;
      else { if (t == 0) { x = 0; val = 0.f; } else x = L - t; }
      tapbase[((size_t)order * 256 + ch) * 2 * L + (2 * L - 1 - x)] = f2bf(val);
    }
  }
  __syncthreads();
}

DI int kf_off(int key, int d) { return ((((key >> 5) * 4 + (d >> 4)) * 64 + ((d >> 3) & 1) * 32 + (key & 31)) << 3) + (d & 7); }
DI int vf_off(int key, int d) { return (((((key >> 5) * 2 + ((key >> 4) & 1)) * 2 + (d >> 5)) * 64 + ((key >> 2) & 1) * 32 + (d & 31)) << 3) + (key & 3) + 4 * ((key >> 3) & 1); }
DI void p0_cache(const Params& p, int it) {
  const int tid = otid();
  bf16_t* kcat = (bf16_t*)(p.ws + OFF_KCAT);
  bf16_t* vtl = (bf16_t*)(p.ws + OFF_VTL);
  for (int e = tid; e < 4096; e += 256) {
    int rr = it * 32 + (e >> 7), c = e & 127;
    int s = rr & 255, bl = rr >> 8, l = bl & 3, b = bl >> 2;
    float kv = p.in[2][(size_t)rr * 128 + c];
    float vv = p.in[3][(size_t)rr * 128 + c];
    const int kvh = c >> 6, d = c & 63;
    const size_t sb = (size_t)((l * 2 + b) * 2 + kvh) * (1280 * 64);
    kcat[sb + kf_off(s, d)] = f2bf(kv);
    vtl[sb + vf_off(s, d)] = f2bf(vv);
  }
}

DI void phase0(const Params& p, char* lds, int* s_item) {
  const int NTAP = 640, NMOD = 384, NCACHE = 64, NTR = 5760;
  const int total = NTAP + NMOD + NCACHE + NTR;
  int* ctr = (int*)(p.ws + OFF_CTR) + 16;
  const int tid = otid();
  for (;;) {
    if (tid == 0) *s_item = atomicAdd(ctr, 1);
    __syncthreads();
    const int it = *s_item;
    __syncthreads();
    if (it >= total) break;
    int r = it;
    if (r < NTAP) { p0_taps(p, r / 160, r % 160, (float*)lds); continue; }
    r -= NTAP;
    if (r < NMOD) { p0_mod(p, r / 96, r % 96, (float*)lds); continue; }
    r -= NMOD;
    if (r < NCACHE) { p0_cache(p, r); continue; }
    r -= NCACHE;
    int l = r / 1440; r %= 1440;
    if (r < 256) p0_transpose(p.in[11] + (size_t)l * 1024 * 2048, 1024, 2048, r / 32, r % 32, (bf16_t*)(p.ws + OFF_WTIN) + (size_t)l * 2048 * 1024, 0);
    else if (r < 384) { r -= 256; p0_transpose(p.in[27] + (size_t)l * 1024 * 1024, 1024, 1024, r / 16, r % 16, (bf16_t*)(p.ws + OFF_WTOUT) + (size_t)l * 1024 * 1024, 0); }
    else if (r < 736) { r -= 384; p0_transpose(p.in[28] + (size_t)l * 1024 * 2816, 1024, 2816, r / 44, r % 44, (bf16_t*)(p.ws + OFF_WT13) + (size_t)l * 5632 * 1024, 1); }
    else if (r < 1088) { r -= 736; p0_transpose(p.in[29] + (size_t)l * 1024 * 2816, 1024, 2816, r / 44, r % 44, (bf16_t*)(p.ws + OFF_WT13) + (size_t)l * 5632 * 1024, 2); }
    else { r -= 1088; p0_transpose(p.in[30] + (size_t)l * 2816 * 1024, 2816, 1024, r / 16, r % 16, (bf16_t*)(p.ws + OFF_WT2) + (size_t)l * 1024 * 2816, 0); }
  }
}

DI void norm_phase(const Params& p, int l, int which) {
  float* xbuf = p.out;
  bf16_t* hbf = (bf16_t*)(p.ws + OFF_HBF);
  const float* mod = (const float*)(p.ws + OFF_MOD);
  const float* nw = p.in[which ? 10 : 9] + l * 1024;
  const int tid_ = otid(); const int wave = tid_ >> 6, lane = tid_ & 63;
  const bool first = (l == 0 && which == 0);
  constexpr int RB = 5;
  const int nwaves = gridDim.x * 4;
  for (int row0 = blockIdx.x * 4 + wave; row0 < NTOK; row0 += nwaves * RB) {
    float4 v[RB][4];
#pragma unroll
    for (int j = 0; j < RB; ++j) {
      const int row = row0 + j * nwaves;
      if (row < NTOK) {
        const float* src;
        if (first) src = (row < NPROMPT) ? p.in[0] + (size_t)row * 1024 : p.in[1] + (size_t)(row - NPROMPT) * 1024;
        else src = xbuf + (size_t)row * 1024;
#pragma unroll
        for (int i = 0; i < 4; ++i) v[j][i] = *(const float4*)(src + i * 256 + lane * 4);
      } else {
#pragma unroll
        for (int i = 0; i < 4; ++i) v[j][i] = make_float4(0.f, 0.f, 0.f, 0.f);
      }
    }
#pragma unroll
    for (int j = 0; j < RB; ++j) {
      const int row = row0 + j * nwaves;
      if (row >= NTOK) break;
      float ss = 0.f;
#pragma unroll
      for (int i = 0; i < 4; ++i) ss += v[j][i].x * v[j][i].x + v[j][i].y * v[j][i].y + v[j][i].z * v[j][i].z + v[j][i].w * v[j][i].w;
#pragma unroll
      for (int o = 32; o >= 1; o >>= 1) ss += __shfl_xor(ss, o);
      const float rstd = rsqrtf(ss * (1.f / 1024.f) + 1e-6f);
      const int ci = (row < NPROMPT) ? 0 : 1 + ((row - NPROMPT) >> 10);
      const float* sh = mod + ((l * 3 + ci) * 6 + (which ? 3 : 0)) * 1024;
      const float* sc = sh + 1024;
#pragma unroll
      for (int i = 0; i < 4; ++i) {
        const int col = i * 256 + lane * 4;
        const float4 w4 = *(const float4*)(nw + col), s4 = *(const float4*)(sc + col), h4 = *(const float4*)(sh + col);
        const float y0 = v[j][i].x * rstd * w4.x * (1.f + s4.x) + h4.x;
        const float y1 = v[j][i].y * rstd * w4.y * (1.f + s4.y) + h4.y;
        const float y2 = v[j][i].z * rstd * w4.z * (1.f + s4.z) + h4.z;
        const float y3 = v[j][i].w * rstd * w4.w * (1.f + s4.w) + h4.w;
        *(uint2*)(hbf + blk(row, col, 16)) = make_uint2(pack2(y0, y1), pack2(y2, y3));
        if (first) *(float4*)(xbuf + (size_t)row * 1024 + col) = v[j][i];
      }
    }
  }
}

enum { EPI_IN = 0, EPI_RES = 1, EPI_FFN = 2 };

DI void epi_in(const Params& p, int l, int m0, int nt, const f32x16 (&acc)[2][2], char* lds) {
  const int tid = otid(), lane = tid & 63, wave = tid >> 6;
  const int wm = wave >> 1, wn = wave & 1, r = lane & 31, h = lane >> 5;
  float* Ct = (float*)lds;
#pragma unroll
  for (int i = 0; i < 2; ++i)
#pragma unroll
    for (int j = 0; j < 2; ++j)
#pragma unroll
      for (int reg = 0; reg < 16; ++reg) {
        int row = wm * 64 + i * 32 + (reg & 3) + 8 * (reg >> 2) + 4 * h;
        int col = wn * 64 + j * 32 + r;
        Ct[row * 132 + col] = acc[i][j][reg];
      }
  __syncthreads();
  const bool lat = (m0 >= NPROMPT);
  if (nt < 5) {
    const int row = tid >> 1, hh = tid & 1;
    float* src = Ct + row * 132 + hh * 64;
    float ss = 0.f;
#pragma unroll
    for (int d = 0; d < 64; d += 4) {
      float4 t = *(const float4*)(src + d);
      ss += t.x * t.x + t.y * t.y + t.z * t.z + t.w * t.w;
    }
    const float rstd = rsqrtf(ss * (1.f / 64.f) + 1e-6f);
    const float* nw = (nt < 4 ? p.in[12] : p.in[13]) + l * 64;
    const float osc = (nt < 4) ? 0.125f : 1.f;
    const int m = m0 + row;
    int pos = 0;
    if (lat) {
      pos = (m - NPROMPT) & 1023;
      const float pr = (float)(pos >> 6), pc = (float)(pos & 63);
#pragma unroll 1
      for (int d = 0; d < 16; ++d) {
        const float f = exp2f(-(float)d * 0.8304820237218406f);
        const float ar = pr * f, ac = pc * f;
        const float sr = sinf(ar), cr = cosf(ar), sc_ = sinf(ac), cc_ = cosf(ac);
        float x1 = src[d] * rstd * nw[d], x2 = src[d + 16] * rstd * nw[d + 16];
        src[d] = (x1 * cr - x2 * sr) * osc; src[d + 16] = (x2 * cr + x1 * sr) * osc;
        x1 = src[32 + d] * rstd * nw[32 + d]; x2 = src[48 + d] * rstd * nw[48 + d];
        src[32 + d] = (x1 * cc_ - x2 * sc_) * osc; src[48 + d] = (x2 * cc_ + x1 * sc_) * osc;
      }
    } else {
#pragma unroll
      for (int d = 0; d < 64; d += 4) {
        float4 t = *(const float4*)(src + d);
        float4 w = *(const float4*)(nw + d);
        t.x *= rstd * w.x * osc; t.y *= rstd * w.y * osc; t.z *= rstd * w.z * osc; t.w *= rstd * w.w * osc;
        *(float4*)(src + d) = t;
      }
    }
    if (nt < 4) {
      bf16_t* dst = (bf16_t*)(p.ws + OFF_QBF) + (size_t)m * 512 + (nt * 2 + hh) * 64;
#pragma unroll
      for (int d = 0; d < 64; d += 8) {
        float4 t0 = *(const float4*)(src + d), t1 = *(const float4*)(src + d + 4);
        *(uint4*)(dst + d) = make_uint4(pack2(t0.x, t0.y), pack2(t0.z, t0.w), pack2(t1.x, t1.y), pack2(t1.z, t1.w));
      }
    } else {
      bf16_t* dst;
      int key;
      if (!lat) {
        const int b = m >> 8, s = m & 255;
        float* nk = p.out + OUT_NK + ((size_t)((b * 4 + l) * 256 + s)) * 128 + hh * 64;
#pragma unroll
        for (int d = 0; d < 64; d += 4) *(float4*)(nk + d) = *(const float4*)(src + d);
        dst = (bf16_t*)(p.ws + OFF_KBF) + (size_t)(b * 2 + hh) * (256 * 64);
        key = s;
      } else {
        const int b2 = (m - NPROMPT) >> 10;
        dst = (bf16_t*)(p.ws + OFF_KCAT) + (size_t)((l * 2 + b2) * 2 + hh) * (1280 * 64);
        key = 256 + pos;
      }
#pragma unroll
      for (int d = 0; d < 64; d += 8) {
        float4 t0 = *(const float4*)(src + d), t1 = *(const float4*)(src + d + 4);
        *(uint4*)(dst + kf_off(key, d)) = make_uint4(pack2(t0.x, t0.y), pack2(t0.z, t0.w), pack2(t1.x, t1.y), pack2(t1.z, t1.w));
      }
    }
  } else if (nt == 5) {
    if (!lat) {
      const int row = tid >> 1, hf = tid & 1;
      const int m = m0 + row, b = m >> 8, s = m & 255;
      float* nv = p.out + OUT_NV + ((size_t)((b * 4 + l) * 256 + s)) * 128 + hf * 64;
      const float* src = Ct + row * 132 + hf * 64;
#pragma unroll
      for (int d = 0; d < 64; d += 4) *(float4*)(nv + d) = *(const float4*)(src + d);
    }
    {
      const int col = tid & 127, rh = tid >> 7;
      const int kvh = col >> 6, d = col & 63;
      bf16_t* dst;
      int kstart;
      if (!lat) {
        const int b = m0 >> 8, s0 = m0 & 255;
        dst = (bf16_t*)(p.ws + OFF_VTP) + (size_t)(b * 2 + kvh) * (256 * 64);
        kstart = s0 + rh * 64;
      } else {
        const int b2 = (m0 - NPROMPT) >> 10, s0 = (m0 - NPROMPT) & 1023;
        dst = (bf16_t*)(p.ws + OFF_VTL) + (size_t)((l * 2 + b2) * 2 + kvh) * (1280 * 64);
        kstart = 256 + s0 + rh * 64;
      }
      const float* src = Ct + (rh * 64) * 132 + col;
#pragma unroll
      for (int g = 0; g < 8; ++g) {
        const int kk0 = (g >> 2) * 32 + ((g >> 1) & 1) * 16 + (g & 1) * 4;
        *(uint4*)(dst + vf_off(kstart + kk0, d)) =
            make_uint4(pack2(src[(kk0 + 0) * 132], src[(kk0 + 1) * 132]), pack2(src[(kk0 + 2) * 132], src[(kk0 + 3) * 132]),
                       pack2(src[(kk0 + 8) * 132], src[(kk0 + 9) * 132]), pack2(src[(kk0 + 10) * 132], src[(kk0 + 11) * 132]));
      }
    }
  } else if (nt < 10) {
    const int row = tid >> 1, hf = tid & 1;
    float* dst = (float*)(p.ws + OFF_PBUF) + (size_t)(m0 + row) * 1280 + (nt * 128 - 768) + hf * 64;
    const float* src = Ct + row * 132 + hf * 64;
#pragma unroll
    for (int d = 0; d < 64; d += 4) *(float4*)(dst + d) = *(const float4*)(src + d);
  } else {
    const int row = tid >> 1, hf = tid & 1;
    const int sidx = (nt - 10) >> 1, cg0 = (((nt - 10) & 1) * 128 + hf * 64) >> 2;
    float* dst = (float*)(p.ws + OFF_PHY) + ((size_t)cg0 * NTOK + (m0 + row)) * 12 + sidx * 4;
    const float* src = Ct + row * 132 + hf * 64;
#pragma unroll
    for (int g = 0; g < 16; ++g) *(float4*)(dst + (size_t)g * NTOK * 12) = *(const float4*)(src + 4 * g);
  }
  __syncthreads();
}

template <int EPI>
DI void gemm_phase(const Params& p, int l, const bf16_t* A, int lda, const bf16_t* BT, int ldb, int K, int NT,
                           int modpart, char* lds, float gscale = 1.f, int KS = 1) {
  const int tid = otid(), lane = tid & 63, wave = tid >> 6;
  const int wm = wave >> 1, wn = wave & 1, r = lane & 31, h = lane >> 5;
  const int ntiles = 80 * NT * KS;
  const int KT = K / (64 * KS);
  const int woff = (tid >> 3) * LROW + (tid & 7) * 16;
  for (int t = blockIdx.x; t < ntiles; t += gridDim.x) {
    const int ks = t / (80 * NT), tt = t - ks * (80 * NT);
    const int mt = tt % 80, nt = tt / 80;
    const int m0 = mt * 128, n0 = nt * 128;
    f32x16 acc[2][2];
#pragma unroll
    for (int i = 0; i < 2; ++i)
#pragma unroll
      for (int j = 0; j < 2; ++j)
#pragma unroll
        for (int e = 0; e < 16; ++e) acc[i][j][e] = 0.f;
    const bf16_t* Ag = A + ((size_t)mt * (K >> 6) + ks * KT) * 8192 + tid * 8;
    const bf16_t* Bg = BT + ((size_t)nt * (K >> 6) + ks * KT) * 8192 + tid * 8;
    uint4 ra[2][4], rb[2][4];
#pragma unroll
    for (int i = 0; i < 4; ++i) {
      ra[0][i] = *(const uint4*)(Ag + i * 2048);
      rb[0][i] = *(const uint4*)(Bg + i * 2048);
    }
#pragma unroll
    for (int i = 0; i < 4; ++i) {
      *(uint4*)(lds + woff + i * 32 * LROW) = ra[0][i];
      *(uint4*)(lds + LTILE + woff + i * 32 * LROW) = rb[0][i];
    }
#pragma unroll
    for (int i = 0; i < 4; ++i) {
      asm volatile("global_load_dwordx4 %0, %1, off" : "=v"(ra[1][i]) : "v"(Ag + i * 2048 + 8192) : "memory");
      asm volatile("global_load_dwordx4 %0, %1, off" : "=v"(rb[1][i]) : "v"(Bg + i * 2048 + 8192) : "memory");
    }
    __syncthreads();
    for (int kt2 = 0; kt2 < KT; kt2 += 2) {
#pragma unroll
      for (int u = 0; u < 2; ++u) {
        const int kt = kt2 + u;
        const char* cur = lds + u * LBUF;
        char* nxt = lds + (u ^ 1) * LBUF;
        const int kn = (kt + 2 < KT) ? kt + 2 : KT - 1;
        asm volatile("s_waitcnt vmcnt(0)" ::: "memory");
#pragma unroll
        for (int i = 0; i < 4; ++i) {
          asm volatile("global_load_dwordx4 %0, %1, off" : "=v"(ra[u][i]) : "v"(Ag + i * 2048 + (size_t)kn * 8192) : "memory");
          asm volatile("global_load_dwordx4 %0, %1, off" : "=v"(rb[u][i]) : "v"(Bg + i * 2048 + (size_t)kn * 8192) : "memory");
        }
#pragma unroll
        for (int st = 0; st < 4; ++st) {
          bf16x8 a0 = *(const bf16x8*)(cur + (wm * 64 + r) * LROW + st * 32 + h * 16);
          bf16x8 a1 = *(const bf16x8*)(cur + (wm * 64 + 32 + r) * LROW + st * 32 + h * 16);
          bf16x8 b0 = *(const bf16x8*)(cur + LTILE + (wn * 64 + r) * LROW + st * 32 + h * 16);
          bf16x8 b1 = *(const bf16x8*)(cur + LTILE + (wn * 64 + 32 + r) * LROW + st * 32 + h * 16);
          acc[0][0] = MFMA32(a0, b0, acc[0][0]);
          acc[0][1] = MFMA32(a0, b1, acc[0][1]);
          acc[1][0] = MFMA32(a1, b0, acc[1][0]);
          acc[1][1] = MFMA32(a1, b1, acc[1][1]);
          *(uint4*)(nxt + woff + st * 32 * LROW) = ra[u ^ 1][st];
          *(uint4*)(nxt + LTILE + woff + st * 32 * LROW) = rb[u ^ 1][st];
        }
        __syncthreads();
      }
    }
    asm volatile("s_waitcnt vmcnt(0)" ::: "memory");
#pragma unroll
    for (int i = 0; i < 4; ++i) {
      typedef unsigned u32x4_t __attribute__((ext_vector_type(4)));
      const u32x4_t t0 = {ra[0][i].x, ra[0][i].y, ra[0][i].z, ra[0][i].w}, t1 = {rb[0][i].x, rb[0][i].y, rb[0][i].z, rb[0][i].w};
      const u32x4_t t2 = {ra[1][i].x, ra[1][i].y, ra[1][i].z, ra[1][i].w}, t3 = {rb[1][i].x, rb[1][i].y, rb[1][i].z, rb[1][i].w};
      asm volatile("" :: "v"(t0), "v"(t1), "v"(t2), "v"(t3));
    }
    if (EPI == EPI_IN) {
      epi_in(p, l, m0, nt, acc, lds);
    } else if (EPI == EPI_RES) {
      const int ci = (m0 < NPROMPT) ? 0 : 1 + ((m0 - NPROMPT) >> 10);
      const float* gate = (const float*)(p.ws + OFF_MOD) + ((l * 3 + ci) * 6 + modpart) * 1024;
      float* xbuf = p.out;
      if (KS > 1) {
#pragma unroll
        for (int j = 0; j < 2; ++j) {
          const int n = n0 + wn * 64 + j * 32 + r;
          const float g = gate[n] * gscale;
#pragma unroll
          for (int i = 0; i < 2; ++i)
#pragma unroll
            for (int reg = 0; reg < 16; ++reg) {
              const int m = m0 + wm * 64 + i * 32 + (reg & 3) + 8 * (reg >> 2) + 4 * h;
              (void)__hip_atomic_fetch_add(xbuf + (size_t)m * 1024 + n, g * acc[i][j][reg], __ATOMIC_RELAXED, __HIP_MEMORY_SCOPE_AGENT);
            }
        }
      } else {
        float* Ct = (float*)lds;
#pragma unroll
        for (int i = 0; i < 2; ++i)
#pragma unroll
          for (int j = 0; j < 2; ++j)
#pragma unroll
            for (int reg = 0; reg < 16; ++reg)
              Ct[(wm * 64 + i * 32 + (reg & 3) + 8 * (reg >> 2) + 4 * h) * 132 + wn * 64 + j * 32 + r] = acc[i][j][reg];
        __syncthreads();
#pragma unroll
        for (int i = 0; i < 16; ++i) {
          const int c = tid + 256 * i, row = c >> 5, c4 = (c & 31) * 4;
          const float4 a = *(const float4*)(Ct + row * 132 + c4);
          const float4 g = *(const float4*)(gate + n0 + c4);
          float4* xp = (float4*)(xbuf + (size_t)(m0 + row) * 1024 + n0 + c4);
          float4 xv = *xp;
          xv.x += gscale * g.x * a.x; xv.y += gscale * g.y * a.y; xv.z += gscale * g.z * a.z; xv.w += gscale * g.w * a.w;
          *xp = xv;
        }
        __syncthreads();
      }
    } else {
      bf16_t* st = (bf16_t*)lds + (wm * 64 + 4 * h) * 72 + wn * 32 + r;
#pragma unroll
      for (int i = 0; i < 2; ++i)
#pragma unroll
        for (int reg = 0; reg < 16; ++reg) {
          const float a = acc[i][0][reg], b = acc[i][1][reg];
          st[(i * 32 + (reg & 3) + 8 * (reg >> 2)) * 72] = f2bf(a * fast_sigmoid(a) * b);
        }
      __syncthreads();
      {
        bf16_t* ub = (bf16_t*)(p.ws + OFF_UBF) + ((size_t)mt * 44 + nt) * 8192;
#pragma unroll
        for (int i = 0; i < 4; ++i) {
          const int c = tid + 256 * i;
          *(uint4*)(ub + c * 8) = *(const uint4*)((const bf16_t*)lds + (c >> 3) * 72 + (c & 7) * 8);
        }
      }
      __syncthreads();
    }
  }
}

DI void attn_wave(const bf16_t* __restrict__ q, const bf16_t* __restrict__ kp, const bf16_t* __restrict__ vt, int nkeys, bf16_t* __restrict__ mixb, int qtok, int head) {
  const int lane = otid() & 63, r = lane & 31, h = lane >> 5;
  bf16x8 qf[4];
#pragma unroll
  for (int st = 0; st < 4; ++st) qf[st] = *(const bf16x8*)(q + (size_t)r * 512 + st * 16 + h * 8);
  f32x16 O[2];
#pragma unroll
  for (int e = 0; e < 16; ++e) { O[0][e] = 0.f; O[1][e] = 0.f; }
  float m = -1e30f, lsum = 0.f;
  bf16x8 kfr[2][4];
#pragma unroll
  for (int sub = 0; sub < 2; ++sub)
#pragma unroll
    for (int st = 0; st < 4; ++st) kfr[sub][st] = *(const bf16x8*)(kp + (size_t)(((sub * 4 + st) * 64 + lane) << 3));
  for (int k0 = 0; k0 < nkeys; k0 += 64) {
    f32x16 S[2];
#pragma unroll
    for (int sub = 0; sub < 2; ++sub) {
#pragma unroll
      for (int e = 0; e < 16; ++e) S[sub][e] = 0.f;
#pragma unroll
      for (int st = 0; st < 4; ++st) S[sub] = MFMA32(kfr[sub][st], qf[st], S[sub]);
    }
    {
      const int kn = (k0 + 64 < nkeys) ? k0 + 64 : k0;
#pragma unroll
      for (int sub = 0; sub < 2; ++sub)
#pragma unroll
        for (int st = 0; st < 4; ++st) kfr[sub][st] = *(const bf16x8*)(kp + (size_t)(((((kn >> 5) + sub) * 4 + st) * 64 + lane) << 3));
    }
    bf16x8 vfr[2][2][2];
#pragma unroll
    for (int sub = 0; sub < 2; ++sub)
#pragma unroll
      for (int s2 = 0; s2 < 2; ++s2)
#pragma unroll
        for (int dt = 0; dt < 2; ++dt)
          vfr[sub][s2][dt] = *(const bf16x8*)(vt + (size_t)((((((k0 >> 5) + sub) * 2 + s2) * 2 + dt) * 64 + lane) << 3));
    float mx = m;
#pragma unroll
    for (int sub = 0; sub < 2; ++sub)
#pragma unroll
      for (int e = 0; e < 16; ++e) mx = fmaxf(mx, S[sub][e]);
    mx = fmaxf(mx, __shfl_xor(mx, 32));
    const float alpha = __expf(m - mx);
    m = mx;
    float ps = 0.f;
#pragma unroll
    for (int sub = 0; sub < 2; ++sub)
#pragma unroll
      for (int e = 0; e < 16; ++e) { float pv = __expf(S[sub][e] - mx); S[sub][e] = pv; ps += pv; }
    lsum = lsum * alpha + ps;
#pragma unroll
    for (int e = 0; e < 16; ++e) { O[0][e] *= alpha; O[1][e] *= alpha; }
#pragma unroll
    for (int sub = 0; sub < 2; ++sub)
#pragma unroll
      for (int s = 0; s < 2; ++s) {
        union { unsigned u[4]; bf16x8 v; } pf;
#pragma unroll
        for (int j = 0; j < 4; ++j) pf.u[j] = pack2(S[sub][8 * s + 2 * j], S[sub][8 * s + 2 * j + 1]);
#pragma unroll
        for (int dt = 0; dt < 2; ++dt) O[dt] = MFMA32(vfr[sub][s][dt], pf.v, O[dt]);
      }
  }
  lsum += __shfl_xor(lsum, 32);
  const float inv = 1.f / lsum;
  bf16_t* ob = mixb + ((size_t)(qtok >> 7) * 16 + head) * 8192 + ((qtok & 127) + r) * 64;
#pragma unroll
  for (int dt = 0; dt < 2; ++dt)
#pragma unroll
    for (int g = 0; g < 4; ++g) {
      const int d = dt * 32 + 8 * g + 4 * h;
      *(uint2*)(ob + d) = make_uint2(pack2(O[dt][4 * g] * inv, O[dt][4 * g + 1] * inv), pack2(O[dt][4 * g + 2] * inv, O[dt][4 * g + 3] * inv));
    }
}

DI float gelu_tanh(float x) { return 0.5f * x * (1.f + tanhf(0.7978845608028654f * (x + 0.044715f * x * x * x))); }

#ifndef PROBE_BAR
#define PROBE_BAR 0
#endif
DI void gsync(GBar& g) { gsync1(g); if (PROBE_BAR) { gsync1(g); gsync1(g); } }
DI float fast_gelu(float x) {
  const float u = 0.7978845608028654f * (x + 0.044715f * x * x * x);
  const float th = 1.f - 2.f * __builtin_amdgcn_rcpf(1.f + __expf(2.f * u));
  return 0.5f * x * (1.f + th);
}

DI void lru_gate_item(const Params& p, int l, int mt, int n, char* lds) {
  const int tid = otid(), lane = tid & 63, wave = tid >> 6, r = lane & 31, h = lane >> 5;
  float* XC = (float*)lds;
  bf16_t* Axc = (bf16_t*)(lds + 32768);
  const int m0 = mt * 128;
  const int L = (m0 < NPROMPT) ? 256 : 1024;
  const int tb = (m0 < NPROMPT) ? (m0 & 255) : ((m0 - NPROMPT) & 1023);
  const float* pbuf = (const float*)(p.ws + OFF_PBUF);
  float2* ab = (float2*)(p.ws + OFF_UBF);
  {
    const int ch = tid & 63, tq = tid >> 6, gch = n * 64 + ch;
    float cw[4];
#pragma unroll
    for (int k = 0; k < 4; ++k) cw[k] = p.in[14][(l * 4 + k) * 256 + gch];
    const float cb = p.in[15][l * 256 + gch];
    float x[35];
#pragma unroll
    for (int i = 0; i < 35; ++i) {
      const int ts = tb + tq * 32 + i - 2;
      x[i] = (ts >= 0 && ts < L) ? pbuf[(size_t)(m0 - tb + ts) * 1280 + gch] : 0.f;
    }
#pragma unroll
    for (int e = 0; e < 32; ++e) {
      const float xv = cb + cw[0] * x[e] + cw[1] * x[e + 1] + cw[2] * x[e + 2] + cw[3] * x[e + 3];
      XC[(tq * 32 + e) * 64 + ch] = xv;
      Axc[(tq * 32 + e) * 72 + ch] = f2bf(xv);
    }
  }
  __syncthreads();
  {
    const int dir = wave & 1, half = wave >> 1;
    bf16x8 wf[2][2][4];
    float gb[2][2], sp[2];
#pragma unroll
    for (int g = 0; g < 2; ++g) {
      const float* W = p.in[16] + ((size_t)((l * 2 + dir) * 2 + g) * 4 + n) * 4096;
#pragma unroll
      for (int ct = 0; ct < 2; ++ct) {
        const int j = r + 32 * ct;
        gb[g][ct] = p.in[17][((l * 2 + dir) * 2 + g) * 256 + n * 64 + j];
#pragma unroll
        for (int st = 0; st < 4; ++st) {
          const int i0 = 16 * st + 8 * h;
          union { unsigned u[4]; bf16x8 v; } f;
#pragma unroll
          for (int jj = 0; jj < 4; ++jj) f.u[jj] = pack2(W[(i0 + 2 * jj) * 64 + j], W[(i0 + 2 * jj + 1) * 64 + j]);
          wf[g][ct][st] = f.v;
        }
      }
    }
#pragma unroll
    for (int ct = 0; ct < 2; ++ct) sp[ct] = log1pf(expf(-p.in[18][(l * 2 + dir) * 256 + n * 64 + r + 32 * ct]));
#pragma unroll 1
    for (int rt = 0; rt < 2; ++rt) {
      f32x16 acc[2][2];
#pragma unroll
      for (int e = 0; e < 16; ++e) { acc[0][0][e] = 0.f; acc[0][1][e] = 0.f; acc[1][0][e] = 0.f; acc[1][1][e] = 0.f; }
#pragma unroll
      for (int st = 0; st < 4; ++st) {
        const bf16x8 af = *(const bf16x8*)(Axc + (half * 64 + rt * 32 + r) * 72 + 16 * st + 8 * h);
        acc[0][0] = MFMA32(af, wf[0][0][st], acc[0][0]);
        acc[0][1] = MFMA32(af, wf[0][1][st], acc[0][1]);
        acc[1][0] = MFMA32(af, wf[1][0][st], acc[1][0]);
        acc[1][1] = MFMA32(af, wf[1][1][st], acc[1][1]);
      }
#pragma unroll
      for (int ct = 0; ct < 2; ++ct)
#pragma unroll
        for (int reg = 0; reg < 16; ++reg) {
          const int tok = half * 64 + rt * 32 + (reg & 3) + 8 * (reg >> 2) + 4 * h;
          const int j = r + 32 * ct;
          const float rr = fast_sigmoid(acc[0][ct][reg] + gb[0][ct]);
          const float ii = fast_sigmoid(acc[1][ct][reg] + gb[1][ct]);
          const float xv = XC[tok * 64 + j];
          const float a = __expf(-8.f * rr * sp[ct]);
          const float bb = __builtin_sqrtf(fmaxf(fmaf(-a, a, 1.f), 0.f)) * (ii * xv);
          ab[((size_t)dir * NTOK + m0 + tok) * 256 + n * 64 + j] = make_float2(a, bb);
        }
    }
  }
  __syncthreads();
}

template <int CGS>
DI void lru_scan_item(const Params& p, int l, int bidx, int cbase, char* lds) {
  constexpr int NSEG = 256 / CGS;
  const int tid = otid();
  const bool lat = bidx >= 32;
  const int L = lat ? 1024 : 256;
  const int tok0 = lat ? NPROMPT + (bidx - 32) * 1024 : bidx * 256;
  const int ch = tid % CGS, sg = tid / CGS, gch = cbase + ch;
  const int SEGL = L / NSEG;
  float2* SEG = (float2*)lds;
  const float2* ab = (const float2*)(p.ws + OFF_UBF);
  float* hfbuf = (float*)(p.ws + OFF_UBF + 41943040);
  const float* pbuf = (const float*)(p.ws + OFF_PBUF);
  bf16_t* mix = (bf16_t*)(p.ws + OFF_MIX);
  const float2* abf = ab + ((size_t)0 * NTOK + tok0 + sg * SEGL) * 256 + gch;
  const float2* abb = ab + ((size_t)1 * NTOK + tok0 + sg * SEGL) * 256 + gch;
  {
    float A = 1.f, B = 0.f;
#pragma unroll 16
    for (int i = 0; i < SEGL; ++i) { const float2 v = abf[(size_t)i * 256]; B = v.x * B + v.y; A *= v.x; }
    SEG[(0 * NSEG + sg) * CGS + ch] = make_float2(A, B);
    A = 1.f; B = 0.f;
#pragma unroll 16
    for (int i = SEGL - 1; i >= 0; --i) { const float2 v = abb[(size_t)i * 256]; B = v.x * B + v.y; A *= v.x; }
    SEG[(1 * NSEG + sg) * CGS + ch] = make_float2(A, B);
  }
  __syncthreads();
  float hf = lat ? p.in[4][(((bidx - 32) * 4 + l) * 2 + 0) * 256 + gch] : 0.f;
  float hb = lat ? p.in[4][(((bidx - 32) * 4 + l) * 2 + 1) * 256 + gch] : 0.f;
  for (int q = 0; q < sg; ++q) { const float2 v = SEG[(0 * NSEG + q) * CGS + ch]; hf = v.x * hf + v.y; }
  for (int q = NSEG - 1; q > sg; --q) { const float2 v = SEG[(1 * NSEG + q) * CGS + ch]; hb = v.x * hb + v.y; }
  if (!lat) {
    if (sg == NSEG - 1) { const float2 v = SEG[(0 * NSEG + NSEG - 1) * CGS + ch]; p.out[OUT_ST + ((size_t)(bidx * 4 + l) * 2 + 0) * 256 + gch] = v.x * hf + v.y; }
    if (sg == 0) { const float2 v = SEG[(1 * NSEG + 0) * CGS + ch]; p.out[OUT_ST + ((size_t)(bidx * 4 + l) * 2 + 1) * 256 + gch] = v.x * hb + v.y; }
  }
  float* hfp = hfbuf + (size_t)(tok0 + sg * SEGL) * 256 + gch;
  for (int i0 = 0; i0 < SEGL; i0 += 16) {
    float2 v[16];
#pragma unroll
    for (int j = 0; j < 16; ++j) v[j] = abf[(size_t)(i0 + j) * 256];
#pragma unroll
    for (int j = 0; j < 16; ++j) { hf = v[j].x * hf + v[j].y; hfp[(size_t)(i0 + j) * 256] = hf; }
  }
  const float* lg = pbuf + (size_t)(tok0 + sg * SEGL) * 1280 + 256 + gch;
  bf16_t* mp = mix + blk(tok0 + sg * SEGL, 512 + gch, 16);
  for (int i0 = SEGL - 16; i0 >= 0; i0 -= 16) {
    float2 v[16];
    float gv[16], fv[16];
#pragma unroll
    for (int j = 0; j < 16; ++j) {
      v[j] = abb[(size_t)(i0 + j) * 256];
      gv[j] = lg[(size_t)(i0 + j) * 1280];
      fv[j] = hfp[(size_t)(i0 + j) * 256];
    }
#pragma unroll
    for (int j = 15; j >= 0; --j) {
      hb = v[j].x * hb + v[j].y;
      mp[(size_t)(i0 + j) * 64] = f2bf(fast_gelu(gv[j]) * (fv[j] + hb));
    }
  }
  __syncthreads();
}

DI bf16x8 ld16u(const bf16_t* p) { bf16x8 v; __builtin_memcpy(&v, p, 16); return v; }
typedef unsigned u32x4v __attribute__((ext_vector_type(4)));
DI bf16x8 ld16_shift(const bf16_t* p8, int ds2, int ds1, unsigned hb) {
  const u32x4v c0 = *(const u32x4v*)p8, c1 = *(const u32x4v*)(p8 + 8);
  unsigned t0 = ds2 ? c0[2] : c0[0], t1 = ds2 ? c0[3] : c0[1], t2 = ds2 ? c1[0] : c0[2], t3 = ds2 ? c1[1] : c0[3], t4 = ds2 ? c1[2] : c1[0], t5 = ds2 ? c1[3] : c1[1];
  unsigned u0 = ds1 ? t1 : t0, u1 = ds1 ? t2 : t1, u2 = ds1 ? t3 : t2, u3 = ds1 ? t4 : t3, u4 = ds1 ? t5 : t4;
  union { unsigned u[4]; bf16x8 v; } r;
  r.u[0] = __builtin_amdgcn_alignbyte(u1, u0, hb); r.u[1] = __builtin_amdgcn_alignbyte(u2, u1, hb);
  r.u[2] = __builtin_amdgcn_alignbyte(u3, u2, hb); r.u[3] = __builtin_amdgcn_alignbyte(u4, u3, hb);
  return r.v;
}
DI float bf2f(bf16_t v) { return __uint_as_float((unsigned)v << 16); }
DI float conv3_at(const float* __restrict__ pb, int t, int L, float w0, float w1, float w2) {
  float v = w1 * pb[(size_t)t * 1280];
  if (t > 0) v += w0 * pb[(size_t)(t - 1) * 1280];
  if (t < L - 1) v += w2 * pb[(size_t)(t + 1) * 1280];
  return v;
}

template <int L>
DI void hy_item(const Params& p, int l, int tokbase, int c0, char* lds) {
  constexpr int NB = L / 32, NQ = 32 / NB, PADLEN = (3 * NB - 2) * 32;
  const int tid = otid(), lane = tid & 63, wave = tid >> 6, h = lane >> 5;
  bf16_t* UP = (bf16_t*)lds;
  float* X1 = (float*)(lds + 24576);
  float* X2 = (float*)(lds + 24576 + 16384);
  const float* phy = (const float*)(p.ws + OFF_PHY) + (size_t)(c0 >> 2) * NTOK * 12;
  const float* hcw = p.in[19] + l * 3 * 768 + c0;
  for (int idx = tid; idx < 4 * NQ * 2 * (NB - 1) * 32; idx += 256) {
    const int e = idx % ((NB - 1) * 32), s2 = (idx / ((NB - 1) * 32)) & 1, sq = idx / (2 * (NB - 1) * 32);
    UP[sq * PADLEN + (s2 ? (2 * NB - 1) * 32 : 0) + e] = 0;
  }
  {
    float4 w[3][3];
#pragma unroll
    for (int k = 0; k < 3; ++k)
#pragma unroll
      for (int sidx = 0; sidx < 3; ++sidx) w[k][sidx] = *(const float4*)(hcw + k * 768 + sidx * 256);
    for (int pr = tid; pr < NQ * L; pr += 256) {
      const int q = pr / L, t = pr % L;
      const float* row = phy + (size_t)(tokbase + q * L + t) * 12;
      float4 o[3];
#pragma unroll
      for (int sidx = 0; sidx < 3; ++sidx) {
        const float4 m = *(const float4*)(row + sidx * 4);
        o[sidx] = make_float4(w[1][sidx].x * m.x, w[1][sidx].y * m.y, w[1][sidx].z * m.z, w[1][sidx].w * m.w);
        if (t > 0) {
          const float4 a = *(const float4*)(row - 12 + sidx * 4);
          o[sidx].x += w[0][sidx].x * a.x; o[sidx].y += w[0][sidx].y * a.y; o[sidx].z += w[0][sidx].z * a.z; o[sidx].w += w[0][sidx].w * a.w;
        }
        if (t < L - 1) {
          const float4 c = *(const float4*)(row + 12 + sidx * 4);
          o[sidx].x += w[2][sidx].x * c.x; o[sidx].y += w[2][sidx].y * c.y; o[sidx].z += w[2][sidx].z * c.z; o[sidx].w += w[2][sidx].w * c.w;
        }
      }
      const int ui = q * PADLEN + (NB - 1) * 32 + t;
      UP[(0 * NQ) * PADLEN + ui] = f2bf(o[0].x); UP[(1 * NQ) * PADLEN + ui] = f2bf(o[0].y);
      UP[(2 * NQ) * PADLEN + ui] = f2bf(o[0].z); UP[(3 * NQ) * PADLEN + ui] = f2bf(o[0].w);
      X1[0 * NQ * L + pr] = o[1].x; X1[1 * NQ * L + pr] = o[1].y; X1[2 * NQ * L + pr] = o[1].z; X1[3 * NQ * L + pr] = o[1].w;
      X2[0 * NQ * L + pr] = o[2].x; X2[1 * NQ * L + pr] = o[2].y; X2[2 * NQ * L + pr] = o[2].z; X2[3 * NQ * L + pr] = o[2].w;
    }
  }
  __syncthreads();
  {
    const int c = c0 + wave;
    const int col = lane & 31, q = col / NB, T = col % NB;
    bf16_t* U = UP + wave * NQ * PADLEN;
    const bf16_t* rv0 = ((L == 256) ? (const bf16_t*)(p.ws + OFF_TAP256) + (size_t)l * 2 * 256 * 512
                                    : (const bf16_t*)(p.ws + OFF_TAP1024) + (size_t)l * 2 * 256 * 2048) + (size_t)c * 2 * L;
    const bf16_t* rv1 = rv0 + (size_t)256 * 2 * L;
    const int aoff_u = L - 1 - (lane & 31) + 8 * h;
    const int ash = aoff_u & 7, aoff = aoff_u - ash;
    const int ds2 = (ash >> 2) & 1, ds1 = (ash >> 1) & 1; const unsigned hb = (ash & 1) * 2;
    const int boff = q * PADLEN + 32 * (T + NB - 1) + 8 * h;
    const int uo = q * PADLEN + (NB - 1) * 32 + 32 * T + 4 * h;
    const int xo = wave * NQ * L + q * L + 32 * T + 4 * h;
    const float skip0 = p.in[26][(l * 2 + 0) * 256 + c], skip1 = p.in[26][(l * 2 + 1) * 256 + c];
    f32x16 acc;
#pragma unroll
    for (int e = 0; e < 16; ++e) acc[e] = 0.f;
    f32x16 accB;
#pragma unroll
    for (int e = 0; e < 16; ++e) accB[e] = 0.f;
#pragma unroll 5
    for (int D = -(NB - 1); D <= NB - 1; ++D) {
      const int off = -32 * D;
      const bf16x8 a0 = ld16_shift(rv0 + aoff + off, ds2, ds1, hb), a1 = ld16_shift(rv0 + aoff + off + 16, ds2, ds1, hb);
      const bf16x8 b0 = *(const bf16x8*)(U + boff + off), b1 = *(const bf16x8*)(U + boff + off + 16);
      acc = MFMA32(a0, b0, acc);
      accB = MFMA32(a1, b1, accB);
    }
#pragma unroll
    for (int e = 0; e < 16; ++e) acc[e] += accB[e];
    float z[16];
#pragma unroll
    for (int g = 0; g < 4; ++g) {
      const uint2 vv = *(const uint2*)(U + uo + 8 * g);
      const float4 x1 = *(const float4*)(X1 + xo + 8 * g);
      z[4 * g + 0] = x1.x * (acc[4 * g + 0] + skip0 * __uint_as_float(vv.x << 16));
      z[4 * g + 1] = x1.y * (acc[4 * g + 1] + skip0 * __uint_as_float(vv.x & 0xffff0000u));
      z[4 * g + 2] = x1.z * (acc[4 * g + 2] + skip0 * __uint_as_float(vv.y << 16));
      z[4 * g + 3] = x1.w * (acc[4 * g + 3] + skip0 * __uint_as_float(vv.y & 0xffff0000u));
    }
    __builtin_amdgcn_wave_barrier();
#pragma unroll
    for (int g = 0; g < 4; ++g)
      *(uint2*)(U + uo + 8 * g) = make_uint2(pack2(z[4 * g], z[4 * g + 1]), pack2(z[4 * g + 2], z[4 * g + 3]));
    __builtin_amdgcn_wave_barrier();
#pragma unroll
    for (int e = 0; e < 16; ++e) acc[e] = 0.f;
#pragma unroll
    for (int e = 0; e < 16; ++e) accB[e] = 0.f;
#pragma unroll 5
    for (int D = -(NB - 1); D <= NB - 1; ++D) {
      const int off = -32 * D;
      const bf16x8 a0 = ld16_shift(rv1 + aoff + off, ds2, ds1, hb), a1 = ld16_shift(rv1 + aoff + off + 16, ds2, ds1, hb);
      const bf16x8 b0 = *(const bf16x8*)(U + boff + off), b1 = *(const bf16x8*)(U + boff + off + 16);
      acc = MFMA32(a0, b0, acc);
      accB = MFMA32(a1, b1, accB);
    }
#pragma unroll
    for (int e = 0; e < 16; ++e) acc[e] += accB[e];
    bf16_t* OUT = (bf16_t*)(lds + 57344) + (size_t)(q * L + 32 * T + 4 * h) * 4 + wave;
#pragma unroll
    for (int g = 0; g < 4; ++g) {
      const float4 x2 = *(const float4*)(X2 + xo + 8 * g);
      OUT[(8 * g + 0) * 4] = f2bf(x2.x * (acc[4 * g + 0] + skip1 * z[4 * g + 0]));
      OUT[(8 * g + 1) * 4] = f2bf(x2.y * (acc[4 * g + 1] + skip1 * z[4 * g + 1]));
      OUT[(8 * g + 2) * 4] = f2bf(x2.z * (acc[4 * g + 2] + skip1 * z[4 * g + 2]));
      OUT[(8 * g + 3) * 4] = f2bf(x2.w * (acc[4 * g + 3] + skip1 * z[4 * g + 3]));
    }
  }
  __syncthreads();
  {
    const uint2* OUTv = (const uint2*)(lds + 57344);
    bf16_t* mix = (bf16_t*)(p.ws + OFF_MIX);
    for (int idx = tid; idx < NQ * L; idx += 256) *(uint2*)(mix + blk(tokbase + idx, 768 + c0, 16)) = OUTv[idx];
  }
  __syncthreads();
}

DI void mixer_phase(const Params& p, int l, int sub, char* lds, int* s_item, int rep = 0) {
  const int tid = otid(), wave = tid >> 6;
  int* ctr = (int*)(p.ws + OFF_CTR) + l * 2 + sub + rep * 8;
  bf16_t* mix = (bf16_t*)(p.ws + OFF_MIX);
  const bf16_t* qbf = (const bf16_t*)(p.ws + OFF_QBF);
  const int nitems = sub ? 672 : 1088;
  for (;;) {
    if (tid == 0) *s_item = atomicAdd(ctr, 1);
    __syncthreads();
    const int it = *s_item;
    __syncthreads();
    if (it >= nitems) break;
    if (sub == 0) {
      if (it < 128) {
        const int j = it;
        hy_item<1024>(p, l, NPROMPT + (j >> 6) * 1024, (j & 63) * 4, lds);
      } else if (it < 256) {
        const int j = it - 128, b2 = j >> 6, head = (j >> 3) & 7, qb = j & 7, kvh = head >> 2;
        const int qtok = NPROMPT + b2 * 1024 + qb * 128 + wave * 32;
        attn_wave(qbf + (size_t)qtok * 512 + head * 64,
                  (const bf16_t*)(p.ws + OFF_KCAT) + (size_t)((l * 2 + b2) * 2 + kvh) * (1280 * 64),
                  (const bf16_t*)(p.ws + OFF_VTL) + (size_t)((l * 2 + b2) * 2 + kvh) * (1280 * 64), 1280,
                  mix, qtok, head);
      } else if (it < 576) {
        const int j = it - 256;
        lru_gate_item(p, l, j >> 2, j & 3, lds);
      } else {
        const int j = it - 576;
        hy_item<256>(p, l, (j >> 6) * 1024, (j & 63) * 4, lds);
      }
    } else {
      if (it < 32) {
        lru_scan_item<16>(p, l, 32 + (it >> 4), (it & 15) * 16, lds);
      } else if (it < 160) {
        const int j = it - 32;
        lru_scan_item<64>(p, l, j >> 2, (j & 3) * 64, lds);
      } else {
        const int j = it - 160, b = j >> 4, head = (j >> 1) & 7, qb = j & 1, kvh = head >> 2;
        const int qtok = b * 256 + qb * 128 + wave * 32;
        attn_wave(qbf + (size_t)qtok * 512 + head * 64,
                  (const bf16_t*)(p.ws + OFF_KBF) + (size_t)(b * 2 + kvh) * (256 * 64),
                  (const bf16_t*)(p.ws + OFF_VTP) + (size_t)(b * 2 + kvh) * (256 * 64), 256,
                  mix, qtok, head);
      }
    }
  }
}

#ifndef PROBE_P0
#define PROBE_P0 0
#endif
#ifndef PROBE_DG
#define PROBE_DG 0
#endif
#ifndef PROBE_MIX
#define PROBE_MIX 0
#endif
#ifndef PROBE_DUP
#define PROBE_DUP 0
#endif
#ifndef PHASE_SEL
#define PHASE_SEL -1
#endif
#define PSEL(k) (PHASE_SEL < 0 || PHASE_SEL == (k))
#ifndef STOP_P
#define STOP_P -1
#endif
#ifndef STOP_L
#define STOP_L 0
#endif
#define STOPAT(k) if (STOP_P == (k) && l == STOP_L) return;
__global__ void __launch_bounds__(256, 2) fwd_megakernel(Params p) {
  cg::grid_group grid = cg::this_grid();
  __shared__ __attribute__((aligned(16))) char lds[LDS_BYTES];
  __shared__ int s_item;
  GBar gbar;
  gbar.w = (unsigned*)(p.ws + OFF_CTR);
  gbar.x = (unsigned)__builtin_amdgcn_s_getreg((3 << 11) | 20) & 0xFu;
  gbar.epoch = 0; gbar.nloc = 1; gbar.nx = 1;
  if (threadIdx.x == 0) (void)gb_add(&gbar.w[CW_CNT(gbar.x)], 1u);
  grid.sync();
  if (threadIdx.x == 0) {
    unsigned cnt = 0, mine = 1;
    for (unsigned j = 0; j < 16; ++j) { const unsigned c = gb_ld(&gbar.w[CW_CNT(j)]); cnt += (c > 0u) ? 1u : 0u; if (j == gbar.x) mine = c; }
    gbar.nloc = mine; gbar.nx = cnt;
  }
  if (PSEL(0)) phase0(p, lds, &s_item);
  gsync(gbar);
#if PROBE_P0
#endif
  const bf16_t* hbf = (const bf16_t*)(p.ws + OFF_HBF);
  for (int l = 0; l < 4; ++l) {
    if (PSEL(1)) norm_phase(p, l, 0);
    gsync(gbar);
    STOPAT(1)
    if (PSEL(2)) gemm_phase<EPI_IN>(p, l, hbf, 1024, (const bf16_t*)(p.ws + OFF_WTIN) + (size_t)l * 2048 * 1024, 1024, 1024, 16, 0, lds);
    gsync(gbar);
#if PROBE_DUP
    gemm_phase<EPI_IN>(p, l, hbf, 1024, (const bf16_t*)(p.ws + OFF_WTIN) + (size_t)l * 2048 * 1024, 1024, 1024, 16, 0, lds);
    gsync(gbar);
#endif
    STOPAT(2)
    if (PSEL(3)) mixer_phase(p, l, 0, lds, &s_item);
    gsync(gbar);
    if (PSEL(3)) mixer_phase(p, l, 1, lds, &s_item);
    gsync(gbar);
#if PROBE_MIX
    mixer_phase(p, l, 0, lds, &s_item, 1);
    gsync(gbar);
    mixer_phase(p, l, 1, lds, &s_item, 1);
    gsync(gbar);
#endif
    STOPAT(3)
    if (PSEL(4)) gemm_phase<EPI_RES>(p, l, (const bf16_t*)(p.ws + OFF_MIX), 1024, (const bf16_t*)(p.ws + OFF_WTOUT) + (size_t)l * 1024 * 1024, 1024, 1024, 8, 2, lds, 1.f, 1);
    gsync(gbar);
#if PROBE_DG
    gemm_phase<EPI_RES>(p, l, (const bf16_t*)(p.ws + OFF_MIX), 1024, (const bf16_t*)(p.ws + OFF_WTOUT) + (size_t)l * 1024 * 1024, 1024, 1024, 8, 2, lds, 0.f);
    gsync(gbar);
#endif
    STOPAT(4)
    if (PSEL(1)) norm_phase(p, l, 1);
    gsync(gbar);
    STOPAT(5)
    if (PSEL(5)) gemm_phase<EPI_FFN>(p, l, hbf, 1024, (const bf16_t*)(p.ws + OFF_WT13) + (size_t)l * 5632 * 1024, 1024, 1024, 44, 0, lds);
    gsync(gbar);
#if PROBE_DUP
    gemm_phase<EPI_FFN>(p, l, hbf, 1024, (const bf16_t*)(p.ws + OFF_WT13) + (size_t)l * 5632 * 1024, 1024, 1024, 44, 0, lds);
    gsync(gbar);
#endif
    STOPAT(6)
    if (PSEL(4)) gemm_phase<EPI_RES>(p, l, (const bf16_t*)(p.ws + OFF_UBF), DFF, (const bf16_t*)(p.ws + OFF_WT2) + (size_t)l * 1024 * DFF, DFF, DFF, 8, 5, lds, 1.f, 1);
    gsync(gbar);
#if PROBE_DG
    gemm_phase<EPI_RES>(p, l, (const bf16_t*)(p.ws + OFF_UBF), DFF, (const bf16_t*)(p.ws + OFF_WT2) + (size_t)l * 1024 * DFF, DFF, DFF, 8, 5, lds, 0.f);
    gsync(gbar);
#endif
    STOPAT(7)
  }
}

#ifndef MULTI_LAUNCH
#define MULTI_LAUNCH 0
#endif
__global__ void __launch_bounds__(256, 2) phase_kernel(Params p, int phase, int l) {
  __shared__ __attribute__((aligned(16))) char lds[LDS_BYTES];
  __shared__ int s_item;
  const bf16_t* hbf = (const bf16_t*)(p.ws + OFF_HBF);
  switch (phase) {
    case 0: phase0(p, lds, &s_item); break;
    case 1: norm_phase(p, l, 0); break;
    case 2: gemm_phase<EPI_IN>(p, l, hbf, 1024, (const bf16_t*)(p.ws + OFF_WTIN) + (size_t)l * 2048 * 1024, 1024, 1024, 16, 0, lds); break;
    case 3: mixer_phase(p, l, 0, lds, &s_item); break;
    case 8: mixer_phase(p, l, 1, lds, &s_item); break;
    case 4: gemm_phase<EPI_RES>(p, l, (const bf16_t*)(p.ws + OFF_MIX), 1024, (const bf16_t*)(p.ws + OFF_WTOUT) + (size_t)l * 1024 * 1024, 1024, 1024, 8, 2, lds); break;
    case 5: norm_phase(p, l, 1); break;
    case 6: gemm_phase<EPI_FFN>(p, l, hbf, 1024, (const bf16_t*)(p.ws + OFF_WT13) + (size_t)l * 5632 * 1024, 1024, 1024, 44, 0, lds); break;
    default: gemm_phase<EPI_RES>(p, l, (const bf16_t*)(p.ws + OFF_UBF), DFF, (const bf16_t*)(p.ws + OFF_WT2) + (size_t)l * 1024 * DFF, DFF, DFF, 8, 5, lds); break;
  }
}

extern "C" void kernel_launch(void* const* d_in, const int* in_sizes, int n_in, void* d_out, int out_size, void* d_ws, size_t ws_size,
                              hipStream_t stream) {
  static int grid_blocks = 0;
  if (!grid_blocks) {
    int dev = 0, cus = 0, per_cu = 0;
    hipGetDevice(&dev);
    hipDeviceGetAttribute(&cus, hipDeviceAttributeMultiprocessorCount, dev);
    hipOccupancyMaxActiveBlocksPerMultiprocessor(&per_cu, fwd_megakernel, 256, 0);
    if (per_cu > 2) per_cu = 2;
    if (per_cu < 1) per_cu = 1;
    grid_blocks = cus * per_cu;
  }
  Params p{};
  for (int i = 0; i < 31; ++i) p.in[i] = (const float*)d_in[i];
  p.out = (float*)d_out;
  p.ws = (char*)d_ws;
  (void)hipMemsetAsync((char*)d_ws + OFF_CTR, 0, CTL_BYTES, stream);
#if MULTI_LAUNCH
  hipLaunchKernelGGL(phase_kernel, dim3(512), dim3(256), 0, stream, p, 0, 0);
  for (int l = 0; l < 4; ++l)
    for (int ph = 1; ph <= 7; ++ph) hipLaunchKernelGGL(phase_kernel, dim3(512), dim3(256), 0, stream, p, ph, l);
  return;
#endif
  void* args[] = {&p};
  hipError_t e = hipLaunchCooperativeKernel((void*)fwd_megakernel, dim3(grid_blocks), dim3(256), args, 0, stream);
  if (e != hipSuccess) fprintf(stderr, "cooperative launch failed: %s (grid %d)\n", hipGetErrorString(e), grid_blocks);
}
```

```cpp
#include <hip/hip_runtime.h>
#include <hip/hip_cooperative_groups.h>
#include <stdint.h>
#include <cstdio>
namespace cg = cooperative_groups;

typedef __attribute__((ext_vector_type(8))) short bf16x8;
typedef __attribute__((ext_vector_type(16))) float f32x16;
typedef unsigned short bf16_t;
#define DI __device__ __forceinline__
#define MFMA32(a, b, c) __builtin_amdgcn_mfma_f32_32x32x16_bf16((a), (b), (c), 0, 0, 0)

#define NTOK 10240
#define NPROMPT 8192
#define DM 1024
#define DFF 2816
#define OUT_NK 10485760
#define OUT_NV 14680064
#define OUT_ST 18874368

constexpr size_t OFF_WTIN   = 0;
constexpr size_t OFF_WTOUT  = OFF_WTIN + 16777216;
constexpr size_t OFF_WT13   = OFF_WTOUT + 8388608;
constexpr size_t OFF_WT2    = OFF_WT13 + 46137344;
constexpr size_t OFF_MOD    = OFF_WT2 + 23068672;
constexpr size_t OFF_TAP256 = OFF_MOD + 294912;
constexpr size_t OFF_TAP1024 = OFF_TAP256 + 4194304;
constexpr size_t OFF_KCAT   = OFF_TAP1024 + 16777216;
constexpr size_t OFF_VTL    = OFF_KCAT + 2621440;
constexpr size_t OFF_HBF    = OFF_VTL + 2621440;
constexpr size_t OFF_QBF    = OFF_HBF + 20971520;
constexpr size_t OFF_KBF    = OFF_QBF + 10485760;
constexpr size_t OFF_VTP    = OFF_KBF + 2097152;
constexpr size_t OFF_PBUF   = OFF_VTP + 2097152;
constexpr size_t OFF_MIX    = OFF_PBUF + 52428800;
constexpr size_t OFF_UBF    = OFF_MIX + 20971520;
constexpr size_t OFF_ZBUF   = OFF_UBF + 57671680;
constexpr size_t OFF_CTR    = OFF_ZBUF + 10485760;
constexpr size_t OFF_PHY    = OFF_CTR + 16384;
constexpr size_t WS_TOTAL   = OFF_PHY + (size_t)64 * 10240 * 12 * 4;

struct Params {
  const float* in[31];
  float* out;
  char* ws;
};

#define LDS_BYTES 73728
#define LROW 144
#define LTILE (128 * 144)
#define LBUF (2 * LTILE)

DI bf16_t f2bf(float x) { unsigned u = __float_as_uint(x); u += 0x7fffu + ((u >> 16) & 1u); return (bf16_t)(u >> 16); }
DI unsigned pack2(float a, float b) { return (unsigned)f2bf(a) | ((unsigned)f2bf(b) << 16); }
DI size_t blk(int m, int k, int KTF) { return ((size_t)((m >> 7) * KTF + (k >> 6)) * 128 + (m & 127)) * 64 + (k & 63); }
DI int otid() { int t = threadIdx.x; asm volatile("" : "+v"(t)); return t; }
DI void sync_g() { asm volatile("s_waitcnt vmcnt(0)" ::: "memory"); __syncthreads(); }
#define CW_CNT(j) (64 * (1 + (j)))
#define CW_SUB(j) (64 * (17 + (j)))
#define CW_TOP (64 * 33)
#define CW_GEN (64 * 34)
#define CW_XGEN(j) (64 * (35 + (j)))
#define CTL_BYTES 16384
struct GBar { unsigned* w; unsigned x, nloc, nx, epoch; };
DI unsigned gb_ld(unsigned* p) { return __hip_atomic_load(p, __ATOMIC_RELAXED, __HIP_MEMORY_SCOPE_AGENT); }
DI unsigned gb_add(unsigned* p, unsigned v) { return __hip_atomic_fetch_add(p, v, __ATOMIC_RELAXED, __HIP_MEMORY_SCOPE_AGENT); }
DI void gsync1(GBar& g) {
  asm volatile("s_waitcnt vmcnt(0)" ::: "memory");
  __syncthreads();
  if (threadIdx.x == 0) {
    g.epoch++;
    const unsigned old = gb_add(&g.w[CW_SUB(g.x)], 1u);
    if (old + 1u == g.epoch * g.nloc) {
      __builtin_amdgcn_fence(__ATOMIC_RELEASE, "agent");
      asm volatile("s_waitcnt vmcnt(0)" ::: "memory");
      const unsigned old2 = gb_add(&g.w[CW_TOP], 1u);
      if (old2 + 1u == g.epoch * g.nx) (void)gb_add(&g.w[CW_GEN], 1u);
      while (gb_ld(&g.w[CW_GEN]) < g.epoch) __builtin_amdgcn_s_sleep(2);
      (void)gb_add(&g.w[CW_XGEN(g.x)], 1u);
    } else {
      while (gb_ld(&g.w[CW_XGEN(g.x)]) < g.epoch) __builtin_amdgcn_s_sleep(2);
    }
    __builtin_amdgcn_fence(__ATOMIC_ACQUIRE, "agent");
    asm volatile("s_waitcnt vmcnt(0)" ::: "memory");
  }
  __syncthreads();
}
DI float fast_sigmoid(float x) { return __builtin_amdgcn_rcpf(1.f + __expf(-x)); }
DI float sigmoidf_(float x) { return 1.f / (1.f + __expf(-x)); }

DI void p0_transpose(const float* __restrict__ src, int K, int N, int kt, int nt, bf16_t* __restrict__ dst, int mode) {
  const int tid = otid();
  const int n = tid & 63, c = nt * 64 + n, k0 = kt * 128 + (tid >> 6) * 32;
  float v[32];
#pragma unroll
  for (int j = 0; j < 32; ++j) v[j] = src[(size_t)(k0 + j) * N + c];
  int nrow;
  if (mode == 0) nrow = c;
  else nrow = nt * 128 + (n >> 5) * 64 + (mode - 1) * 32 + (n & 31);
  uint4* d = (uint4*)(dst + blk(nrow, k0, K >> 6));
#pragma unroll
  for (int q = 0; q < 4; ++q)
    d[q] = make_uint4(pack2(v[8 * q], v[8 * q + 1]), pack2(v[8 * q + 2], v[8 * q + 3]), pack2(v[8 * q + 4], v[8 * q + 5]), pack2(v[8 * q + 6], v[8 * q + 7]));
}

DI void p0_mod(const Params& p, int l, int cc, float* lds) {
  const int tid = otid();
  float* s = lds;
  float* red = lds + 3072;
  for (int idx = tid; idx < 3072; idx += 256) {
    int ci = idx >> 10, k = idx & 1023;
    float v = (ci == 0) ? p.in[6][k] : p.in[5][(ci - 1) * 1024 + k];
    s[idx] = v / (1.f + expf(-v));
  }
  __syncthreads();
  const int col = tid & 63, kg = tid >> 6;
  const float* W = p.in[7] + (size_t)l * 1024 * 6144 + cc * 64 + col;
  float a0 = 0.f, a1 = 0.f, a2 = 0.f;
#pragma unroll 16
  for (int k = kg * 256; k < kg * 256 + 256; ++k) {
    float w = W[(size_t)k * 6144];
    a0 += s[k] * w; a1 += s[1024 + k] * w; a2 += s[2048 + k] * w;
  }
  red[(kg * 3 + 0) * 64 + col] = a0; red[(kg * 3 + 1) * 64 + col] = a1; red[(kg * 3 + 2) * 64 + col] = a2;
  __syncthreads();
  if (tid < 192) {
    int ci = tid >> 6, c = tid & 63;
    float v = red[(0 * 3 + ci) * 64 + c] + red[(1 * 3 + ci) * 64 + c] + red[(2 * 3 + ci) * 64 + c] + red[(3 * 3 + ci) * 64 + c];
    v += p.in[8][l * 6144 + cc * 64 + c];
    float* mod = (float*)(p.ws + OFF_MOD);
    mod[(l * 3 + ci) * 6144 + cc * 64 + c] = v;
  }
  __syncthreads();
}

DI void p0_taps(const Params& p, int l, int g, float* lds) {
  const int tid = otid();
  float* zf = lds;
  float* h1 = lds + 320;
  float* h2 = lds + 832;
  const int tt0 = g * 8;
  const int L = (tt0 < 256) ? 256 : 1024;
  const int tbase = (tt0 < 256) ? tt0 : tt0 - 256;
  const float invL = 1.f / (float)L;
  for (int idx = tid; idx < 264; idx += 256) {
    int ti = idx / 33, f = idx % 33;
    float t = (float)(tbase + ti);
    float v;
    if (f == 0) v = t * invL;
    else {
      int bi = (f - 1) & 15;
      float band = 1e-4f + (float)bi * ((15.f - 1e-4f) / 15.f);
      float ph = t * band * invL;
      ph -= floorf(ph);
      float ang = 6.283185307179586f * ph;
      v = (f <= 16) ? cosf(ang) : -sinf(ang);
    }
    zf[ti * 40 + f] = v;
  }
  __syncthreads();
  const float* w1 = p.in[20] + l * 33 * 64;
  const float* b1 = p.in[21] + l * 64;
  const float* w2 = p.in[22] + l * 64 * 64;
  const float* b2 = p.in[23] + l * 64;
  const float* w3 = p.in[24] + (size_t)l * 64 * 1024;
  const float* b3 = p.in[25] + l * 1024;
  for (int idx = tid; idx < 512; idx += 256) {
    int ti = idx >> 6, j = idx & 63;
    float a = b1[j];
#pragma unroll 11
    for (int f = 0; f < 33; ++f) a += zf[ti * 40 + f] * w1[f * 64 + j];
    h1[ti * 64 + j] = sinf(a);
  }
  __syncthreads();
  for (int idx = tid; idx < 512; idx += 256) {
    int ti = idx >> 6, j = idx & 63;
    float a = b2[j];
#pragma unroll 16
    for (int f = 0; f < 64; ++f) a += h1[ti * 64 + f] * w2[f * 64 + j];
    h2[ti * 64 + j] = sinf(a);
  }
  __syncthreads();
  float acc[4][8];
#pragma unroll
  for (int q = 0; q < 4; ++q)
#pragma unroll
    for (int ti = 0; ti < 8; ++ti) acc[q][ti] = 0.f;
#pragma unroll 8
  for (int i = 0; i < 64; ++i) {
    float w[4];
#pragma unroll
    for (int q = 0; q < 4; ++q) w[q] = w3[i * 1024 + q * 256 + tid];
#pragma unroll
    for (int ti = 0; ti < 8; ++ti) {
      float hv = h2[ti * 64 + i];
#pragma unroll
      for (int q = 0; q < 4; ++q) acc[q][ti] += hv * w[q];
    }
  }
  const int ch = tid;
  const float d0 = -3.0701134573253945f, d1 = -15.350567286626973f;
  const float delta = d0 + (float)ch * ((d1 - d0) / 255.f);
  bf16_t* tapbase = (L == 256) ? (bf16_t*)(p.ws + OFF_TAP256) + (size_t)l * 2 * 256 * 512
                               : (bf16_t*)(p.ws + OFF_TAP1024) + (size_t)l * 2 * 256 * 2048;
#pragma unroll
  for (int q = 0; q < 4; ++q) {
    const int order = q >> 1, side = q & 1;
    const float bb = b3[q * 256 + ch];
#pragma unroll
    for (int ti = 0; ti < 8; ++ti) {
      int t = tbase + ti;
      float tn = (float)t * invL;
      float val = (acc[q][ti] + bb) * expf(tn * delta);
      int x;
      if (side == 0) x = L + t;
      else { if (t == 0) { x = 0; val = 0.f; } else x = L - t; }
      tapbase[((size_t)order * 256 + ch) * 2 * L + (2 * L - 1 - x)] = f2bf(val);
    }
  }
  __syncthreads();
}

DI int kf_off(int key, int d) { return ((((key >> 5) * 4 + (d >> 4)) * 64 + ((d >> 3) & 1) * 32 + (key & 31)) << 3) + (d & 7); }
DI int vf_off(int key, int d) { return (((((key >> 5) * 2 + ((key >> 4) & 1)) * 2 + (d >> 5)) * 64 + ((key >> 2) & 1) * 32 + (d & 31)) << 3) + (key & 3) + 4 * ((key >> 3) & 1); }
DI void p0_cache(const Params& p, int it) {
  const int tid = otid();
  bf16_t* kcat = (bf16_t*)(p.ws + OFF_KCAT);
  bf16_t* vtl = (bf16_t*)(p.ws + OFF_VTL);
  for (int e = tid; e < 4096; e += 256) {
    int rr = it * 32 + (e >> 7), c = e & 127;
    int s = rr & 255, bl = rr >> 8, l = bl & 3, b = bl >> 2;
    float kv = p.in[2][(size_t)rr * 128 + c];
    float vv = p.in[3][(size_t)rr * 128 + c];
    const int kvh = c >> 6, d = c & 63;
    const size_t sb = (size_t)((l * 2 + b) * 2 + kvh) * (1280 * 64);
    kcat[sb + kf_off(s, d)] = f2bf(kv);
    vtl[sb + vf_off(s, d)] = f2bf(vv);
  }
}

DI void phase0(const Params& p, char* lds, int* s_item) {
  const int NTAP = 640, NMOD = 384, NCACHE = 64, NTR = 5760;
  const int total = NTAP + NMOD + NCACHE + NTR;
  int* ctr = (int*)(p.ws + OFF_CTR) + 16;
  const int tid = otid();
  for (;;) {
    if (tid == 0) *s_item = atomicAdd(ctr, 1);
    __syncthreads();
    const int it = *s_item;
    __syncthreads();
    if (it >= total) break;
    int r = it;
    if (r < NTAP) { p0_taps(p, r / 160, r % 160, (float*)lds); continue; }
    r -= NTAP;
    if (r < NMOD) { p0_mod(p, r / 96, r % 96, (float*)lds); continue; }
    r -= NMOD;
    if (r < NCACHE) { p0_cache(p, r); continue; }
    r -= NCACHE;
    int l = r / 1440; r %= 1440;
    if (r < 256) p0_transpose(p.in[11] + (size_t)l * 1024 * 2048, 1024, 2048, r / 32, r % 32, (bf16_t*)(p.ws + OFF_WTIN) + (size_t)l * 2048 * 1024, 0);
    else if (r < 384) { r -= 256; p0_transpose(p.in[27] + (size_t)l * 1024 * 1024, 1024, 1024, r / 16, r % 16, (bf16_t*)(p.ws + OFF_WTOUT) + (size_t)l * 1024 * 1024, 0); }
    else if (r < 736) { r -= 384; p0_transpose(p.in[28] + (size_t)l * 1024 * 2816, 1024, 2816, r / 44, r % 44, (bf16_t*)(p.ws + OFF_WT13) + (size_t)l * 5632 * 1024, 1); }
    else if (r < 1088) { r -= 736; p0_transpose(p.in[29] + (size_t)l * 1024 * 2816, 1024, 2816, r / 44, r % 44, (bf16_t*)(p.ws + OFF_WT13) + (size_t)l * 5632 * 1024, 2); }
    else { r -= 1088; p0_transpose(p.in[30] + (size_t)l * 2816 * 1024, 2816, 1024, r / 16, r % 16, (bf16_t*)(p.ws + OFF_WT2) + (size_t)l * 1024 * 2816, 0); }
  }
}

DI void norm_phase(const Params& p, int l, int which) {
  float* xbuf = p.out;
  bf16_t* hbf = (bf16_t*)(p.ws + OFF_HBF);
  const float* mod = (const float*)(p.ws + OFF_MOD);
  const float* nw = p.in[which ? 10 : 9] + l * 1024;
  const int tid_ = otid(); const int wave = tid_ >> 6, lane = tid_ & 63;
  const bool first = (l == 0 && which == 0);
  constexpr int RB = 5;
  const int nwaves = gridDim.x * 4;
  for (int row0 = blockIdx.x * 4 + wave; row0 < NTOK; row0 += nwaves * RB) {
    float4 v[RB][4];
#pragma unroll
    for (int j = 0; j < RB; ++j) {
      const int row = row0 + j * nwaves;
      if (row < NTOK) {
        const float* src;
        if (first) src = (row < NPROMPT) ? p.in[0] + (size_t)row * 1024 : p.in[1] + (size_t)(row - NPROMPT) * 1024;
        else src = xbuf + (size_t)row * 1024;
#pragma unroll
        for (int i = 0; i < 4; ++i) v[j][i] = *(const float4*)(src + i * 256 + lane * 4);
      } else {
#pragma unroll
        for (int i = 0; i < 4; ++i) v[j][i] = make_float4(0.f, 0.f, 0.f, 0.f);
      }
    }
#pragma unroll
    for (int j = 0; j < RB; ++j) {
      const int row = row0 + j * nwaves;
      if (row >= NTOK) break;
      float ss = 0.f;
#pragma unroll
      for (int i = 0; i < 4; ++i) ss += v[j][i].x * v[j][i].x + v[j][i].y * v[j][i].y + v[j][i].z * v[j][i].z + v[j][i].w * v[j][i].w;
#pragma unroll
      for (int o = 32; o >= 1; o >>= 1) ss += __shfl_xor(ss, o);
      const float rstd = rsqrtf(ss * (1.f / 1024.f) + 1e-6f);
      const int ci = (row < NPROMPT) ? 0 : 1 + ((row - NPROMPT) >> 10);
      const float* sh = mod + ((l * 3 + ci) * 6 + (which ? 3 : 0)) * 1024;
      const float* sc = sh + 1024;
#pragma unroll
      for (int i = 0; i < 4; ++i) {
        const int col = i * 256 + lane * 4;
        const float4 w4 = *(const float4*)(nw + col), s4 = *(const float4*)(sc + col), h4 = *(const float4*)(sh + col);
        const float y0 = v[j][i].x * rstd * w4.x * (1.f + s4.x) + h4.x;
        const float y1 = v[j][i].y * rstd * w4.y * (1.f + s4.y) + h4.y;
        const float y2 = v[j][i].z * rstd * w4.z * (1.f + s4.z) + h4.z;
        const float y3 = v[j][i].w * rstd * w4.w * (1.f + s4.w) + h4.w;
        *(uint2*)(hbf + blk(row, col, 16)) = make_uint2(pack2(y0, y1), pack2(y2, y3));
        if (first) *(float4*)(xbuf + (size_t)row * 1024 + col) = v[j][i];
      }
    }
  }
}

enum { EPI_IN = 0, EPI_RES = 1, EPI_FFN = 2 };

DI void epi_in(const Params& p, int l, int m0, int nt, const f32x16 (&acc)[2][2], char* lds) {
  const int tid = otid(), lane = tid & 63, wave = tid >> 6;
  const int wm = wave >> 1, wn = wave & 1, r = lane & 31, h = lane >> 5;
  float* Ct = (float*)lds;
#pragma unroll
  for (int i = 0; i < 2; ++i)
#pragma unroll
    for (int j = 0; j < 2; ++j)
#pragma unroll
      for (int reg = 0; reg < 16; ++reg) {
        int row = wm * 64 + i * 32 + (reg & 3) + 8 * (reg >> 2) + 4 * h;
        int col = wn * 64 + j * 32 + r;
        Ct[row * 132 + col] = acc[i][j][reg];
      }
  __syncthreads();
  const bool lat = (m0 >= NPROMPT);
  if (nt < 5) {
    const int row = tid >> 1, hh = tid & 1;
    float* src = Ct + row * 132 + hh * 64;
    float ss = 0.f;
#pragma unroll
    for (int d = 0; d < 64; d += 4) {
      float4 t = *(const float4*)(src + d);
      ss += t.x * t.x + t.y * t.y + t.z * t.z + t.w * t.w;
    }
    const float rstd = rsqrtf(ss * (1.f / 64.f) + 1e-6f);
    const float* nw = (nt < 4 ? p.in[12] : p.in[13]) + l * 64;
    const float osc = (nt < 4) ? 0.125f : 1.f;
    const int m = m0 + row;
    int pos = 0;
    if (lat) {
      pos = (m - NPROMPT) & 1023;
      const float pr = (float)(pos >> 6), pc = (float)(pos & 63);
#pragma unroll 1
      for (int d = 0; d < 16; ++d) {
        const float f = exp2f(-(float)d * 0.8304820237218406f);
        const float ar = pr * f, ac = pc * f;
        const float sr = sinf(ar), cr = cosf(ar), sc_ = sinf(ac), cc_ = cosf(ac);
        float x1 = src[d] * rstd * nw[d], x2 = src[d + 16] * rstd * nw[d + 16];
        src[d] = (x1 * cr - x2 * sr) * osc; src[d + 16] = (x2 * cr + x1 * sr) * osc;
        x1 = src[32 + d] * rstd * nw[32 + d]; x2 = src[48 + d] * rstd * nw[48 + d];
        src[32 + d] = (x1 * cc_ - x2 * sc_) * osc; src[48 + d] = (x2 * cc_ + x1 * sc_) * osc;
      }
    } else {
#pragma unroll
      for (int d = 0; d < 64; d += 4) {
        float4 t = *(const float4*)(src + d);
        float4 w = *(const float4*)(nw + d);
        t.x *= rstd * w.x * osc; t.y *= rstd * w.y * osc; t.z *= rstd * w.z * osc; t.w *= rstd * w.w * osc;
        *(float4*)(src + d) = t;
      }
    }
    if (nt < 4) {
      bf16_t* dst = (bf16_t*)(p.ws + OFF_QBF) + (size_t)m * 512 + (nt * 2 + hh) * 64;
#pragma unroll
      for (int d = 0; d < 64; d += 8) {
        float4 t0 = *(const float4*)(src + d), t1 = *(const float4*)(src + d + 4);
        *(uint4*)(dst + d) = make_uint4(pack2(t0.x, t0.y), pack2(t0.z, t0.w), pack2(t1.x, t1.y), pack2(t1.z, t1.w));
      }
    } else {
      bf16_t* dst;
      int key;
      if (!lat) {
        const int b = m >> 8, s = m & 255;
        float* nk = p.out + OUT_NK + ((size_t)((b * 4 + l) * 256 + s)) * 128 + hh * 64;
#pragma unroll
        for (int d = 0; d < 64; d += 4) *(float4*)(nk + d) = *(const float4*)(src + d);
        dst = (bf16_t*)(p.ws + OFF_KBF) + (size_t)(b * 2 + hh) * (256 * 64);
        key = s;
      } else {
        const int b2 = (m - NPROMPT) >> 10;
        dst = (bf16_t*)(p.ws + OFF_KCAT) + (size_t)((l * 2 + b2) * 2 + hh) * (1280 * 64);
        key = 256 + pos;
      }
#pragma unroll
      for (int d = 0; d < 64; d += 8) {
        float4 t0 = *(const float4*)(src + d), t1 = *(const float4*)(src + d + 4);
        *(uint4*)(dst + kf_off(key, d)) = make_uint4(pack2(t0.x, t0.y), pack2(t0.z, t0.w), pack2(t1.x, t1.y), pack2(t1.z, t1.w));
      }
    }
  } else if (nt == 5) {
    if (!lat) {
      const int row = tid >> 1, hf = tid & 1;
      const int m = m0 + row, b = m >> 8, s = m & 255;
      float* nv = p.out + OUT_NV + ((size_t)((b * 4 + l) * 256 + s)) * 128 + hf * 64;
      const float* src = Ct + row * 132 + hf * 64;
#pragma unroll
      for (int d = 0; d < 64; d += 4) *(float4*)(nv + d) = *(const float4*)(src + d);
    }
    {
      const int col = tid & 127, rh = tid >> 7;
      const int kvh = col >> 6, d = col & 63;
      bf16_t* dst;
      int kstart;
      if (!lat) {
        const int b = m0 >> 8, s0 = m0 & 255;
        dst = (bf16_t*)(p.ws + OFF_VTP) + (size_t)(b * 2 + kvh) * (256 * 64);
        kstart = s0 + rh * 64;
      } else {
        const int b2 = (m0 - NPROMPT) >> 10, s0 = (m0 - NPROMPT) & 1023;
        dst = (bf16_t*)(p.ws + OFF_VTL) + (size_t)((l * 2 + b2) * 2 + kvh) * (1280 * 64);
        kstart = 256 + s0 + rh * 64;
      }
      const float* src = Ct + (rh * 64) * 132 + col;
#pragma unroll
      for (int g = 0; g < 8; ++g) {
        const int kk0 = (g >> 2) * 32 + ((g >> 1) & 1) * 16 + (g & 1) * 4;
        *(uint4*)(dst + vf_off(kstart + kk0, d)) =
            make_uint4(pack2(src[(kk0 + 0) * 132], src[(kk0 + 1) * 132]), pack2(src[(kk0 + 2) * 132], src[(kk0 + 3) * 132]),
                       pack2(src[(kk0 + 8) * 132], src[(kk0 + 9) * 132]), pack2(src[(kk0 + 10) * 132], src[(kk0 + 11) * 132]));
      }
    }
  } else if (nt < 10) {
    const int row = tid >> 1, hf = tid & 1;
    float* dst = (float*)(p.ws + OFF_PBUF) + (size_t)(m0 + row) * 1280 + (nt * 128 - 768) + hf * 64;
    const float* src = Ct + row * 132 + hf * 64;
#pragma unroll
    for (int d = 0; d < 64; d += 4) *(float4*)(dst + d) = *(const float4*)(src + d);
  } else {
    const int row = tid >> 1, hf = tid & 1;
    const int sidx = (nt - 10) >> 1, cg0 = (((nt - 10) & 1) * 128 + hf * 64) >> 2;
    float* dst = (float*)(p.ws + OFF_PHY) + ((size_t)cg0 * NTOK + (m0 + row)) * 12 + sidx * 4;
    const float* src = Ct + row * 132 + hf * 64;
#pragma unroll
    for (int g = 0; g < 16; ++g) *(float4*)(dst + (size_t)g * NTOK * 12) = *(const float4*)(src + 4 * g);
  }
  __syncthreads();
}

template <int EPI>
DI void gemm_phase(const Params& p, int l, const bf16_t* A, int lda, const bf16_t* BT, int ldb, int K, int NT,
                           int modpart, char* lds, float gscale = 1.f, int KS = 1) {
  const int tid = otid(), lane = tid & 63, wave = tid >> 6;
  const int wm = wave >> 1, wn = wave & 1, r = lane & 31, h = lane >> 5;
  const int ntiles = 80 * NT * KS;
  const int KT = K / (64 * KS);
  const int woff = (tid >> 3) * LROW + (tid & 7) * 16;
  for (int t = blockIdx.x; t < ntiles; t += gridDim.x) {
    const int ks = t / (80 * NT), tt = t - ks * (80 * NT);
    const int mt = tt % 80, nt = tt / 80;
    const int m0 = mt * 128, n0 = nt * 128;
    f32x16 acc[2][2];
#pragma unroll
    for (int i = 0; i < 2; ++i)
#pragma unroll
      for (int j = 0; j < 2; ++j)
#pragma unroll
        for (int e = 0; e < 16; ++e) acc[i][j][e] = 0.f;
    const bf16_t* Ag = A + ((size_t)mt * (K >> 6) + ks * KT) * 8192 + tid * 8;
    const bf16_t* Bg = BT + ((size_t)nt * (K >> 6) + ks * KT) * 8192 + tid * 8;
    uint4 ra[2][4], rb[2][4];
#pragma unroll
    for (int i = 0; i < 4; ++i) {
      ra[0][i] = *(const uint4*)(Ag + i * 2048);
      rb[0][i] = *(const uint4*)(Bg + i * 2048);
    }
#pragma unroll
    for (int i = 0; i < 4; ++i) {
      *(uint4*)(lds + woff + i * 32 * LROW) = ra[0][i];
      *(uint4*)(lds + LTILE + woff + i * 32 * LROW) = rb[0][i];
    }
#pragma unroll
    for (int i = 0; i < 4; ++i) {
      asm volatile("global_load_dwordx4 %0, %1, off" : "=v"(ra[1][i]) : "v"(Ag + i * 2048 + 8192) : "memory");
      asm volatile("global_load_dwordx4 %0, %1, off" : "=v"(rb[1][i]) : "v"(Bg + i * 2048 + 8192) : "memory");
    }
    __syncthreads();
    for (int kt2 = 0; kt2 < KT; kt2 += 2) {
#pragma unroll
      for (int u = 0; u < 2; ++u) {
        const int kt = kt2 + u;
        const char* cur = lds + u * LBUF;
        char* nxt = lds + (u ^ 1) * LBUF;
        const int kn = (kt + 2 < KT) ? kt + 2 : KT - 1;
        asm volatile("s_waitcnt vmcnt(0)" ::: "memory");
#pragma unroll
        for (int i = 0; i < 4; ++i) {
          asm volatile("global_load_dwordx4 %0, %1, off" : "=v"(ra[u][i]) : "v"(Ag + i * 2048 + (size_t)kn * 8192) : "memory");
          asm volatile("global_load_dwordx4 %0, %1, off" : "=v"(rb[u][i]) : "v"(Bg + i * 2048 + (size_t)kn * 8192) : "memory");
        }
        __builtin_amdgcn_s_setprio(1);
#pragma unroll
        for (int st = 0; st < 4; ++st) {
          bf16x8 a0 = *(const bf16x8*)(cur + (wm * 64 + r) * LROW + st * 32 + h * 16);
          bf16x8 a1 = *(const bf16x8*)(cur + (wm * 64 + 32 + r) * LROW + st * 32 + h * 16);
          bf16x8 b0 = *(const bf16x8*)(cur + LTILE + (wn * 64 + r) * LROW + st * 32 + h * 16);
          bf16x8 b1 = *(const bf16x8*)(cur + LTILE + (wn * 64 + 32 + r) * LROW + st * 32 + h * 16);
          acc[0][0] = MFMA32(a0, b0, acc[0][0]);
          acc[0][1] = MFMA32(a0, b1, acc[0][1]);
          acc[1][0] = MFMA32(a1, b0, acc[1][0]);
          acc[1][1] = MFMA32(a1, b1, acc[1][1]);
          *(uint4*)(nxt + woff + st * 32 * LROW) = ra[u ^ 1][st];
          *(uint4*)(nxt + LTILE + woff + st * 32 * LROW) = rb[u ^ 1][st];
        }
        __builtin_amdgcn_s_setprio(0);
        __syncthreads();
      }
    }
    asm volatile("s_waitcnt vmcnt(0)" ::: "memory");
#pragma unroll
    for (int i = 0; i < 4; ++i) {
      typedef unsigned u32x4_t __attribute__((ext_vector_type(4)));
      const u32x4_t t0 = {ra[0][i].x, ra[0][i].y, ra[0][i].z, ra[0][i].w}, t1 = {rb[0][i].x, rb[0][i].y, rb[0][i].z, rb[0][i].w};
      const u32x4_t t2 = {ra[1][i].x, ra[1][i].y, ra[1][i].z, ra[1][i].w}, t3 = {rb[1][i].x, rb[1][i].y, rb[1][i].z, rb[1][i].w};
      asm volatile("" :: "v"(t0), "v"(t1), "v"(t2), "v"(t3));
    }
    if (EPI == EPI_IN) {
      epi_in(p, l, m0, nt, acc, lds);
    } else if (EPI == EPI_RES) {
      const int ci = (m0 < NPROMPT) ? 0 : 1 + ((m0 - NPROMPT) >> 10);
      const float* gate = (const float*)(p.ws + OFF_MOD) + ((l * 3 + ci) * 6 + modpart) * 1024;
      float* xbuf = p.out;
      if (KS > 1) {
#pragma unroll
        for (int j = 0; j < 2; ++j) {
          const int n = n0 + wn * 64 + j * 32 + r;
          const float g = gate[n] * gscale;
#pragma unroll
          for (int i = 0; i < 2; ++i)
#pragma unroll
            for (int reg = 0; reg < 16; ++reg) {
              const int m = m0 + wm * 64 + i * 32 + (reg & 3) + 8 * (reg >> 2) + 4 * h;
              (void)__hip_atomic_fetch_add(xbuf + (size_t)m * 1024 + n, g * acc[i][j][reg], __ATOMIC_RELAXED, __HIP_MEMORY_SCOPE_AGENT);
            }
        }
      } else {
        float* Ct = (float*)lds;
#pragma unroll
        for (int i = 0; i < 2; ++i)
#pragma unroll
          for (int j = 0; j < 2; ++j)
#pragma unroll
            for (int reg = 0; reg < 16; ++reg)
              Ct[(wm * 64 + i * 32 + (reg & 3) + 8 * (reg >> 2) + 4 * h) * 132 + wn * 64 + j * 32 + r] = acc[i][j][reg];
        __syncthreads();
#pragma unroll
        for (int i = 0; i < 16; ++i) {
          const int c = tid + 256 * i, row = c >> 5, c4 = (c & 31) * 4;
          const float4 a = *(const float4*)(Ct + row * 132 + c4);
          const float4 g = *(const float4*)(gate + n0 + c4);
          float4* xp = (float4*)(xbuf + (size_t)(m0 + row) * 1024 + n0 + c4);
          float4 xv = *xp;
          xv.x += gscale * g.x * a.x; xv.y += gscale * g.y * a.y; xv.z += gscale * g.z * a.z; xv.w += gscale * g.w * a.w;
          *xp = xv;
        }
        __syncthreads();
      }
    } else {
      bf16_t* st = (bf16_t*)lds + (wm * 64 + 4 * h) * 72 + wn * 32 + r;
#pragma unroll
      for (int i = 0; i < 2; ++i)
#pragma unroll
        for (int reg = 0; reg < 16; ++reg) {
          const float a = acc[i][0][reg], b = acc[i][1][reg];
          st[(i * 32 + (reg & 3) + 8 * (reg >> 2)) * 72] = f2bf(a * fast_sigmoid(a) * b);
        }
      __syncthreads();
      {
        bf16_t* ub = (bf16_t*)(p.ws + OFF_UBF) + ((size_t)mt * 44 + nt) * 8192;
#pragma unroll
        for (int i = 0; i < 4; ++i) {
          const int c = tid + 256 * i;
          *(uint4*)(ub + c * 8) = *(const uint4*)((const bf16_t*)lds + (c >> 3) * 72 + (c & 7) * 8);
        }
      }
      __syncthreads();
    }
  }
}

DI void attn_wave(const bf16_t* __restrict__ q, const bf16_t* __restrict__ kp, const bf16_t* __restrict__ vt, int nkeys, bf16_t* __restrict__ mixb, int qtok, int head) {
  const int lane = otid() & 63, r = lane & 31, h = lane >> 5;
  bf16x8 qf[4];
#pragma unroll
  for (int st = 0; st < 4; ++st) qf[st] = *(const bf16x8*)(q + (size_t)r * 512 + st * 16 + h * 8);
  f32x16 O[2];
#pragma unroll
  for (int e = 0; e < 16; ++e) { O[0][e] = 0.f; O[1][e] = 0.f; }
  float m = -1e30f, lsum = 0.f;
  bf16x8 kfr[2][4];
#pragma unroll
  for (int sub = 0; sub < 2; ++sub)
#pragma unroll
    for (int st = 0; st < 4; ++st) kfr[sub][st] = *(const bf16x8*)(kp + (size_t)(((sub * 4 + st) * 64 + lane) << 3));
  for (int k0 = 0; k0 < nkeys; k0 += 64) {
    f32x16 S[2];
#pragma unroll
    for (int sub = 0; sub < 2; ++sub) {
#pragma unroll
      for (int e = 0; e < 16; ++e) S[sub][e] = 0.f;
#pragma unroll
      for (int st = 0; st < 4; ++st) S[sub] = MFMA32(kfr[sub][st], qf[st], S[sub]);
    }
    {
      const int kn = (k0 + 64 < nkeys) ? k0 + 64 : k0;
#pragma unroll
      for (int sub = 0; sub < 2; ++sub)
#pragma unroll
        for (int st = 0; st < 4; ++st) kfr[sub][st] = *(const bf16x8*)(kp + (size_t)(((((kn >> 5) + sub) * 4 + st) * 64 + lane) << 3));
    }
    bf16x8 vfr[2][2][2];
#pragma unroll
    for (int sub = 0; sub < 2; ++sub)
#pragma unroll
      for (int s2 = 0; s2 < 2; ++s2)
#pragma unroll
        for (int dt = 0; dt < 2; ++dt)
          vfr[sub][s2][dt] = *(const bf16x8*)(vt + (size_t)((((((k0 >> 5) + sub) * 2 + s2) * 2 + dt) * 64 + lane) << 3));
    float mx = m;
#pragma unroll
    for (int sub = 0; sub < 2; ++sub)
#pragma unroll
      for (int e = 0; e < 16; ++e) mx = fmaxf(mx, S[sub][e]);
    mx = fmaxf(mx, __shfl_xor(mx, 32));
    const float alpha = __expf(m - mx);
    m = mx;
    float ps = 0.f;
#pragma unroll
    for (int sub = 0; sub < 2; ++sub)
#pragma unroll
      for (int e = 0; e < 16; ++e) { float pv = __expf(S[sub][e] - mx); S[sub][e] = pv; ps += pv; }
    lsum = lsum * alpha + ps;
#pragma unroll
    for (int e = 0; e < 16; ++e) { O[0][e] *= alpha; O[1][e] *= alpha; }
#pragma unroll
    for (int sub = 0; sub < 2; ++sub)
#pragma unroll
      for (int s = 0; s < 2; ++s) {
        union { unsigned u[4]; bf16x8 v; } pf;
#pragma unroll
        for (int j = 0; j < 4; ++j) pf.u[j] = pack2(S[sub][8 * s + 2 * j], S[sub][8 * s + 2 * j + 1]);
#pragma unroll
        for (int dt = 0; dt < 2; ++dt) O[dt] = MFMA32(vfr[sub][s][dt], pf.v, O[dt]);
      }
  }
  lsum += __shfl_xor(lsum, 32);
  const float inv = 1.f / lsum;
  bf16_t* ob = mixb + ((size_t)(qtok >> 7) * 16 + head) * 8192 + ((qtok & 127) + r) * 64;
#pragma unroll
  for (int dt = 0; dt < 2; ++dt)
#pragma unroll
    for (int g = 0; g < 4; ++g) {
      const int d = dt * 32 + 8 * g + 4 * h;
      *(uint2*)(ob + d) = make_uint2(pack2(O[dt][4 * g] * inv, O[dt][4 * g + 1] * inv), pack2(O[dt][4 * g + 2] * inv, O[dt][4 * g + 3] * inv));
    }
}

DI float gelu_tanh(float x) { return 0.5f * x * (1.f + tanhf(0.7978845608028654f * (x + 0.044715f * x * x * x))); }

#ifndef PROBE_BAR
#define PROBE_BAR 0
#endif
DI void gsync(GBar& g) { gsync1(g); if (PROBE_BAR) { gsync1(g); gsync1(g); } }
DI float fast_gelu(float x) {
  const float u = 0.7978845608028654f * (x + 0.044715f * x * x * x);
  const float th = 1.f - 2.f * __builtin_amdgcn_rcpf(1.f + __expf(2.f * u));
  return 0.5f * x * (1.f + th);
}

DI void lru_gate_item(const Params& p, int l, int mt, int n, char* lds) {
  const int tid = otid(), lane = tid & 63, wave = tid >> 6, r = lane & 31, h = lane >> 5;
  float* XC = (float*)lds;
  bf16_t* Axc = (bf16_t*)(lds + 32768);
  const int m0 = mt * 128;
  const int L = (m0 < NPROMPT) ? 256 : 1024;
  const int tb = (m0 < NPROMPT) ? (m0 & 255) : ((m0 - NPROMPT) & 1023);
  const float* pbuf = (const float*)(p.ws + OFF_PBUF);
  float2* ab = (float2*)(p.ws + OFF_UBF);
  {
    const int ch = tid & 63, tq = tid >> 6, gch = n * 64 + ch;
    float cw[4];
#pragma unroll
    for (int k = 0; k < 4; ++k) cw[k] = p.in[14][(l * 4 + k) * 256 + gch];
    const float cb = p.in[15][l * 256 + gch];
    float x[35];
#pragma unroll
    for (int i = 0; i < 35; ++i) {
      const int ts = tb + tq * 32 + i - 2;
      x[i] = (ts >= 0 && ts < L) ? pbuf[(size_t)(m0 - tb + ts) * 1280 + gch] : 0.f;
    }
#pragma unroll
    for (int e = 0; e < 32; ++e) {
      const float xv = cb + cw[0] * x[e] + cw[1] * x[e + 1] + cw[2] * x[e + 2] + cw[3] * x[e + 3];
      XC[(tq * 32 + e) * 64 + ch] = xv;
      Axc[(tq * 32 + e) * 72 + ch] = f2bf(xv);
    }
  }
  __syncthreads();
  {
    const int dir = wave & 1, half = wave >> 1;
    bf16x8 wf[2][2][4];
    float gb[2][2], sp[2];
#pragma unroll
    for (int g = 0; g < 2; ++g) {
      const float* W = p.in[16] + ((size_t)((l * 2 + dir) * 2 + g) * 4 + n) * 4096;
#pragma unroll
      for (int ct = 0; ct < 2; ++ct) {
        const int j = r + 32 * ct;
        gb[g][ct] = p.in[17][((l * 2 + dir) * 2 + g) * 256 + n * 64 + j];
#pragma unroll
        for (int st = 0; st < 4; ++st) {
          const int i0 = 16 * st + 8 * h;
          union { unsigned u[4]; bf16x8 v; } f;
#pragma unroll
          for (int jj = 0; jj < 4; ++jj) f.u[jj] = pack2(W[(i0 + 2 * jj) * 64 + j], W[(i0 + 2 * jj + 1) * 64 + j]);
          wf[g][ct][st] = f.v;
        }
      }
    }
#pragma unroll
    for (int ct = 0; ct < 2; ++ct) sp[ct] = log1pf(expf(-p.in[18][(l * 2 + dir) * 256 + n * 64 + r + 32 * ct]));
#pragma unroll 1
    for (int rt = 0; rt < 2; ++rt) {
      f32x16 acc[2][2];
#pragma unroll
      for (int e = 0; e < 16; ++e) { acc[0][0][e] = 0.f; acc[0][1][e] = 0.f; acc[1][0][e] = 0.f; acc[1][1][e] = 0.f; }
#pragma unroll
      for (int st = 0; st < 4; ++st) {
        const bf16x8 af = *(const bf16x8*)(Axc + (half * 64 + rt * 32 + r) * 72 + 16 * st + 8 * h);
        acc[0][0] = MFMA32(af, wf[0][0][st], acc[0][0]);
        acc[0][1] = MFMA32(af, wf[0][1][st], acc[0][1]);
        acc[1][0] = MFMA32(af, wf[1][0][st], acc[1][0]);
        acc[1][1] = MFMA32(af, wf[1][1][st], acc[1][1]);
      }
#pragma unroll
      for (int ct = 0; ct < 2; ++ct)
#pragma unroll
        for (int reg = 0; reg < 16; ++reg) {
          const int tok = half * 64 + rt * 32 + (reg & 3) + 8 * (reg >> 2) + 4 * h;
          const int j = r + 32 * ct;
          const float rr = fast_sigmoid(acc[0][ct][reg] + gb[0][ct]);
          const float ii = fast_sigmoid(acc[1][ct][reg] + gb[1][ct]);
          const float xv = XC[tok * 64 + j];
          const float a = __expf(-8.f * rr * sp[ct]);
          const float bb = __builtin_sqrtf(fmaxf(fmaf(-a, a, 1.f), 0.f)) * (ii * xv);
          ab[((size_t)dir * NTOK + m0 + tok) * 256 + n * 64 + j] = make_float2(a, bb);
        }
    }
  }
  __syncthreads();
}

template <int CGS>
DI void lru_scan_item(const Params& p, int l, int bidx, int cbase, char* lds) {
  constexpr int NSEG = 256 / CGS;
  const int tid = otid();
  const bool lat = bidx >= 32;
  const int L = lat ? 1024 : 256;
  const int tok0 = lat ? NPROMPT + (bidx - 32) * 1024 : bidx * 256;
  const int ch = tid % CGS, sg = tid / CGS, gch = cbase + ch;
  const int SEGL = L / NSEG;
  float2* SEG = (float2*)lds;
  const float2* ab = (const float2*)(p.ws + OFF_UBF);
  float* hfbuf = (float*)(p.ws + OFF_UBF + 41943040);
  const float* pbuf = (const float*)(p.ws + OFF_PBUF);
  bf16_t* mix = (bf16_t*)(p.ws + OFF_MIX);
  const float2* abf = ab + ((size_t)0 * NTOK + tok0 + sg * SEGL) * 256 + gch;
  const float2* abb = ab + ((size_t)1 * NTOK + tok0 + sg * SEGL) * 256 + gch;
  {
    float A = 1.f, B = 0.f;
#pragma unroll 16
    for (int i = 0; i < SEGL; ++i) { const float2 v = abf[(size_t)i * 256]; B = v.x * B + v.y; A *= v.x; }
    SEG[(0 * NSEG + sg) * CGS + ch] = make_float2(A, B);
    A = 1.f; B = 0.f;
#pragma unroll 16
    for (int i = SEGL - 1; i >= 0; --i) { const float2 v = abb[(size_t)i * 256]; B = v.x * B + v.y; A *= v.x; }
    SEG[(1 * NSEG + sg) * CGS + ch] = make_float2(A, B);
  }
  __syncthreads();
  float hf = lat ? p.in[4][(((bidx - 32) * 4 + l) * 2 + 0) * 256 + gch] : 0.f;
  float hb = lat ? p.in[4][(((bidx - 32) * 4 + l) * 2 + 1) * 256 + gch] : 0.f;
  for (int q = 0; q < sg; ++q) { const float2 v = SEG[(0 * NSEG + q) * CGS + ch]; hf = v.x * hf + v.y; }
  for (int q = NSEG - 1; q > sg; --q) { const float2 v = SEG[(1 * NSEG + q) * CGS + ch]; hb = v.x * hb + v.y; }
  if (!lat) {
    if (sg == NSEG - 1) { const float2 v = SEG[(0 * NSEG + NSEG - 1) * CGS + ch]; p.out[OUT_ST + ((size_t)(bidx * 4 + l) * 2 + 0) * 256 + gch] = v.x * hf + v.y; }
    if (sg == 0) { const float2 v = SEG[(1 * NSEG + 0) * CGS + ch]; p.out[OUT_ST + ((size_t)(bidx * 4 + l) * 2 + 1) * 256 + gch] = v.x * hb + v.y; }
  }
  float* hfp = hfbuf + (size_t)(tok0 + sg * SEGL) * 256 + gch;
  for (int i0 = 0; i0 < SEGL; i0 += 16) {
    float2 v[16];
#pragma unroll
    for (int j = 0; j < 16; ++j) v[j] = abf[(size_t)(i0 + j) * 256];
#pragma unroll
    for (int j = 0; j < 16; ++j) { hf = v[j].x * hf + v[j].y; hfp[(size_t)(i0 + j) * 256] = hf; }
  }
  const float* lg = pbuf + (size_t)(tok0 + sg * SEGL) * 1280 + 256 + gch;
  bf16_t* mp = mix + blk(tok0 + sg * SEGL, 512 + gch, 16);
  for (int i0 = SEGL - 16; i0 >= 0; i0 -= 16) {
    float2 v[16];
    float gv[16], fv[16];
#pragma unroll
    for (int j = 0; j < 16; ++j) {
      v[j] = abb[(size_t)(i0 + j) * 256];
      gv[j] = lg[(size_t)(i0 + j) * 1280];
      fv[j] = hfp[(size_t)(i0 + j) * 256];
    }
#pragma unroll
    for (int j = 15; j >= 0; --j) {
      hb = v[j].x * hb + v[j].y;
      mp[(size_t)(i0 + j) * 64] = f2bf(fast_gelu(gv[j]) * (fv[j] + hb));
    }
  }
  __syncthreads();
}

DI bf16x8 ld16u(const bf16_t* p) { bf16x8 v; __builtin_memcpy(&v, p, 16); return v; }
typedef unsigned u32x4v __attribute__((ext_vector_type(4)));
DI bf16x8 ld16_shift(const bf16_t* p8, int ds2, int ds1, unsigned hb) {
  const u32x4v c0 = *(const u32x4v*)p8, c1 = *(const u32x4v*)(p8 + 8);
  unsigned t0 = ds2 ? c0[2] : c0[0], t1 = ds2 ? c0[3] : c0[1], t2 = ds2 ? c1[0] : c0[2], t3 = ds2 ? c1[1] : c0[3], t4 = ds2 ? c1[2] : c1[0], t5 = ds2 ? c1[3] : c1[1];
  unsigned u0 = ds1 ? t1 : t0, u1 = ds1 ? t2 : t1, u2 = ds1 ? t3 : t2, u3 = ds1 ? t4 : t3, u4 = ds1 ? t5 : t4;
  union { unsigned u[4]; bf16x8 v; } r;
  r.u[0] = __builtin_amdgcn_alignbyte(u1, u0, hb); r.u[1] = __builtin_amdgcn_alignbyte(u2, u1, hb);
  r.u[2] = __builtin_amdgcn_alignbyte(u3, u2, hb); r.u[3] = __builtin_amdgcn_alignbyte(u4, u3, hb);
  return r.v;
}
DI float bf2f(bf16_t v) { return __uint_as_float((unsigned)v << 16); }
DI float conv3_at(const float* __restrict__ pb, int t, int L, float w0, float w1, float w2) {
  float v = w1 * pb[(size_t)t * 1280];
  if (t > 0) v += w0 * pb[(size_t)(t - 1) * 1280];
  if (t < L - 1) v += w2 * pb[(size_t)(t + 1) * 1280];
  return v;
}

template <int L>
DI void hy_item(const Params& p, int l, int tokbase, int c0, char* lds) {
  constexpr int NB = L / 32, NQ = 32 / NB, PADLEN = (3 * NB - 2) * 32;
  const int tid = otid(), lane = tid & 63, wave = tid >> 6, h = lane >> 5;
  bf16_t* UP = (bf16_t*)lds;
  float* X1 = (float*)(lds + 24576);
  float* X2 = (float*)(lds + 24576 + 16384);
  const float* phy = (const float*)(p.ws + OFF_PHY) + (size_t)(c0 >> 2) * NTOK * 12;
  const float* hcw = p.in[19] + l * 3 * 768 + c0;
  for (int idx = tid; idx < 4 * NQ * 2 * (NB - 1) * 32; idx += 256) {
    const int e = idx % ((NB - 1) * 32), s2 = (idx / ((NB - 1) * 32)) & 1, sq = idx / (2 * (NB - 1) * 32);
    UP[sq * PADLEN + (s2 ? (2 * NB - 1) * 32 : 0) + e] = 0;
  }
  {
    float4 w[3][3];
#pragma unroll
    for (int k = 0; k < 3; ++k)
#pragma unroll
      for (int sidx = 0; sidx < 3; ++sidx) w[k][sidx] = *(const float4*)(hcw + k * 768 + sidx * 256);
    for (int pr = tid; pr < NQ * L; pr += 256) {
      const int q = pr / L, t = pr % L;
      const float* row = phy + (size_t)(tokbase + q * L + t) * 12;
      float4 o[3];
#pragma unroll
      for (int sidx = 0; sidx < 3; ++sidx) {
        const float4 m = *(const float4*)(row + sidx * 4);
        o[sidx] = make_float4(w[1][sidx].x * m.x, w[1][sidx].y * m.y, w[1][sidx].z * m.z, w[1][sidx].w * m.w);
        if (t > 0) {
          const float4 a = *(const float4*)(row - 12 + sidx * 4);
          o[sidx].x += w[0][sidx].x * a.x; o[sidx].y += w[0][sidx].y * a.y; o[sidx].z += w[0][sidx].z * a.z; o[sidx].w += w[0][sidx].w * a.w;
        }
        if (t < L - 1) {
          const float4 c = *(const float4*)(row + 12 + sidx * 4);
          o[sidx].x += w[2][sidx].x * c.x; o[sidx].y += w[2][sidx].y * c.y; o[sidx].z += w[2][sidx].z * c.z; o[sidx].w += w[2][sidx].w * c.w;
        }
      }
      const int ui = q * PADLEN + (NB - 1) * 32 + t;
      UP[(0 * NQ) * PADLEN + ui] = f2bf(o[0].x); UP[(1 * NQ) * PADLEN + ui] = f2bf(o[0].y);
      UP[(2 * NQ) * PADLEN + ui] = f2bf(o[0].z); UP[(3 * NQ) * PADLEN + ui] = f2bf(o[0].w);
      X1[0 * NQ * L + pr] = o[1].x; X1[1 * NQ * L + pr] = o[1].y; X1[2 * NQ * L + pr] = o[1].z; X1[3 * NQ * L + pr] = o[1].w;
      X2[0 * NQ * L + pr] = o[2].x; X2[1 * NQ * L + pr] = o[2].y; X2[2 * NQ * L + pr] = o[2].z; X2[3 * NQ * L + pr] = o[2].w;
    }
  }
  __syncthreads();
  {
    const int c = c0 + wave;
    const int col = lane & 31, q = col / NB, T = col % NB;
    bf16_t* U = UP + wave * NQ * PADLEN;
    const bf16_t* rv0 = ((L == 256) ? (const bf16_t*)(p.ws + OFF_TAP256) + (size_t)l * 2 * 256 * 512
                                    : (const bf16_t*)(p.ws + OFF_TAP1024) + (size_t)l * 2 * 256 * 2048) + (size_t)c * 2 * L;
    const bf16_t* rv1 = rv0 + (size_t)256 * 2 * L;
    const int aoff_u = L - 1 - (lane & 31) + 8 * h;
    const int ash = aoff_u & 7, aoff = aoff_u - ash;
    const int ds2 = (ash >> 2) & 1, ds1 = (ash >> 1) & 1; const unsigned hb = (ash & 1) * 2;
    const int boff = q * PADLEN + 32 * (T + NB - 1) + 8 * h;
    const int uo = q * PADLEN + (NB - 1) * 32 + 32 * T + 4 * h;
    const int xo = wave * NQ * L + q * L + 32 * T + 4 * h;
    const float skip0 = p.in[26][(l * 2 + 0) * 256 + c], skip1 = p.in[26][(l * 2 + 1) * 256 + c];
    f32x16 acc;
#pragma unroll
    for (int e = 0; e < 16; ++e) acc[e] = 0.f;
    f32x16 accB;
#pragma unroll
    for (int e = 0; e < 16; ++e) accB[e] = 0.f;
#pragma unroll 5
    for (int D = -(NB - 1); D <= NB - 1; ++D) {
      const int off = -32 * D;
      const bf16x8 a0 = ld16_shift(rv0 + aoff + off, ds2, ds1, hb), a1 = ld16_shift(rv0 + aoff + off + 16, ds2, ds1, hb);
      const bf16x8 b0 = *(const bf16x8*)(U + boff + off), b1 = *(const bf16x8*)(U + boff + off + 16);
      acc = MFMA32(a0, b0, acc);
      accB = MFMA32(a1, b1, accB);
    }
#pragma unroll
    for (int e = 0; e < 16; ++e) acc[e] += accB[e];
    float z[16];
#pragma unroll
    for (int g = 0; g < 4; ++g) {
      const uint2 vv = *(const uint2*)(U + uo + 8 * g);
      const float4 x1 = *(const float4*)(X1 + xo + 8 * g);
      z[4 * g + 0] = x1.x * (acc[4 * g + 0] + skip0 * __uint_as_float(vv.x << 16));
      z[4 * g + 1] = x1.y * (acc[4 * g + 1] + skip0 * __uint_as_float(vv.x & 0xffff0000u));
      z[4 * g + 2] = x1.z * (acc[4 * g + 2] + skip0 * __uint_as_float(vv.y << 16));
      z[4 * g + 3] = x1.w * (acc[4 * g + 3] + skip0 * __uint_as_float(vv.y & 0xffff0000u));
    }
    __builtin_amdgcn_wave_barrier();
#pragma unroll
    for (int g = 0; g < 4; ++g)
      *(uint2*)(U + uo + 8 * g) = make_uint2(pack2(z[4 * g], z[4 * g + 1]), pack2(z[4 * g + 2], z[4 * g + 3]));
    __builtin_amdgcn_wave_barrier();
#pragma unroll
    for (int e = 0; e < 16; ++e) acc[e] = 0.f;
#pragma unroll
    for (int e = 0; e < 16; ++e) accB[e] = 0.f;
#pragma unroll 5
    for (int D = -(NB - 1); D <= NB - 1; ++D) {
      const int off = -32 * D;
      const bf16x8 a0 = ld16_shift(rv1 + aoff + off, ds2, ds1, hb), a1 = ld16_shift(rv1 + aoff + off + 16, ds2, ds1, hb);
      const bf16x8 b0 = *(const bf16x8*)(U + boff + off), b1 = *(const bf16x8*)(U + boff + off + 16);
      acc = MFMA32(a0, b0, acc);
      accB = MFMA32(a1, b1, accB);
    }
#pragma unroll
    for (int e = 0; e < 16; ++e) acc[e] += accB[e];
    bf16_t* OUT = (bf16_t*)(lds + 57344) + (size_t)(q * L + 32 * T + 4 * h) * 4 + wave;
#pragma unroll
    for (int g = 0; g < 4; ++g) {
      const float4 x2 = *(const float4*)(X2 + xo + 8 * g);
      OUT[(8 * g + 0) * 4] = f2bf(x2.x * (acc[4 * g + 0] + skip1 * z[4 * g + 0]));
      OUT[(8 * g + 1) * 4] = f2bf(x2.y * (acc[4 * g + 1] + skip1 * z[4 * g + 1]));
      OUT[(8 * g + 2) * 4] = f2bf(x2.z * (acc[4 * g + 2] + skip1 * z[4 * g + 2]));
      OUT[(8 * g + 3) * 4] = f2bf(x2.w * (acc[4 * g + 3] + skip1 * z[4 * g + 3]));
    }
  }
  __syncthreads();
  {
    const uint2* OUTv = (const uint2*)(lds + 57344);
    bf16_t* mix = (bf16_t*)(p.ws + OFF_MIX);
    for (int idx = tid; idx < NQ * L; idx += 256) *(uint2*)(mix + blk(tokbase + idx, 768 + c0, 16)) = OUTv[idx];
  }
  __syncthreads();
}

DI void mixer_phase(const Params& p, int l, int sub, char* lds, int* s_item, int rep = 0) {
  const int tid = otid(), wave = tid >> 6;
  int* ctr = (int*)(p.ws + OFF_CTR) + l * 2 + sub + rep * 8;
  bf16_t* mix = (bf16_t*)(p.ws + OFF_MIX);
  const bf16_t* qbf = (const bf16_t*)(p.ws + OFF_QBF);
  const int nitems = sub ? 672 : 1088;
  for (;;) {
    if (tid == 0) *s_item = atomicAdd(ctr, 1);
    __syncthreads();
    const int it = *s_item;
    __syncthreads();
    if (it >= nitems) break;
    if (sub == 0) {
      if (it < 128) {
        const int j = it;
        hy_item<1024>(p, l, NPROMPT + (j >> 6) * 1024, (j & 63) * 4, lds);
      } else if (it < 256) {
        const int j = it - 128, b2 = j >> 6, head = (j >> 3) & 7, qb = j & 7, kvh = head >> 2;
        const int qtok = NPROMPT + b2 * 1024 + qb * 128 + wave * 32;
        attn_wave(qbf + (size_t)qtok * 512 + head * 64,
                  (const bf16_t*)(p.ws + OFF_KCAT) + (size_t)((l * 2 + b2) * 2 + kvh) * (1280 * 64),
                  (const bf16_t*)(p.ws + OFF_VTL) + (size_t)((l * 2 + b2) * 2 + kvh) * (1280 * 64), 1280,
                  mix, qtok, head);
      } else if (it < 576) {
        const int j = it - 256;
        lru_gate_item(p, l, j >> 2, j & 3, lds);
      } else {
        const int j = it - 576;
        hy_item<256>(p, l, (j >> 6) * 1024, (j & 63) * 4, lds);
      }
    } else {
      if (it < 32) {
        lru_scan_item<16>(p, l, 32 + (it >> 4), (it & 15) * 16, lds);
      } else if (it < 160) {
        const int j = it - 32;
        lru_scan_item<64>(p, l, j >> 2, (j & 3) * 64, lds);
      } else {
        const int j = it - 160, b = j >> 4, head = (j >> 1) & 7, qb = j & 1, kvh = head >> 2;
        const int qtok = b * 256 + qb * 128 + wave * 32;
        attn_wave(qbf + (size_t)qtok * 512 + head * 64,
                  (const bf16_t*)(p.ws + OFF_KBF) + (size_t)(b * 2 + kvh) * (256 * 64),
                  (const bf16_t*)(p.ws + OFF_VTP) + (size_t)(b * 2 + kvh) * (256 * 64), 256,
                  mix, qtok, head);
      }
    }
  }
}

#ifndef PROBE_P0
#define PROBE_P0 0
#endif
#ifndef PROBE_DG
#define PROBE_DG 0
#endif
#ifndef PROBE_MIX
#define PROBE_MIX 0
#endif
#ifndef PROBE_DUP
#define PROBE_DUP 0
#endif
#ifndef PHASE_SEL
#define PHASE_SEL -1
#endif
#define PSEL(k) (PHASE_SEL < 0 || PHASE_SEL == (k))
#ifndef STOP_P
#define STOP_P -1
#endif
#ifndef STOP_L
#define STOP_L 0
#endif
#define STOPAT(k) if (STOP_P == (k) && l == STOP_L) return;
__global__ void __launch_bounds__(256, 2) fwd_megakernel(Params p) {
  cg::grid_group grid = cg::this_grid();
  __shared__ __attribute__((aligned(16))) char lds[LDS_BYTES];
  __shared__ int s_item;
  GBar gbar;
  gbar.w = (unsigned*)(p.ws + OFF_CTR);
  gbar.x = (unsigned)__builtin_amdgcn_s_getreg((3 << 11) | 20) & 0xFu;
  gbar.epoch = 0; gbar.nloc = 1; gbar.nx = 1;
  if (threadIdx.x == 0) (void)gb_add(&gbar.w[CW_CNT(gbar.x)], 1u);
  grid.sync();
  if (threadIdx.x == 0) {
    unsigned cnt = 0, mine = 1;
    for (unsigned j = 0; j < 16; ++j) { const unsigned c = gb_ld(&gbar.w[CW_CNT(j)]); cnt += (c > 0u) ? 1u : 0u; if (j == gbar.x) mine = c; }
    gbar.nloc = mine; gbar.nx = cnt;
  }
  if (PSEL(0)) phase0(p, lds, &s_item);
  gsync(gbar);
#if PROBE_P0
#endif
  const bf16_t* hbf = (const bf16_t*)(p.ws + OFF_HBF);
  for (int l = 0; l < 4; ++l) {
    if (PSEL(1)) norm_phase(p, l, 0);
    gsync(gbar);
    STOPAT(1)
    if (PSEL(2)) gemm_phase<EPI_IN>(p, l, hbf, 1024, (const bf16_t*)(p.ws + OFF_WTIN) + (size_t)l * 2048 * 1024, 1024, 1024, 16, 0, lds);
    gsync(gbar);
#if PROBE_DUP
    gemm_phase<EPI_IN>(p, l, hbf, 1024, (const bf16_t*)(p.ws + OFF_WTIN) + (size_t)l * 2048 * 1024, 1024, 1024, 16, 0, lds);
    gsync(gbar);
#endif
    STOPAT(2)
    if (PSEL(3)) mixer_phase(p, l, 0, lds, &s_item);
    gsync(gbar);
    if (PSEL(3)) mixer_phase(p, l, 1, lds, &s_item);
    gsync(gbar);
#if PROBE_MIX
    mixer_phase(p, l, 0, lds, &s_item, 1);
    gsync(gbar);
    mixer_phase(p, l, 1, lds, &s_item, 1);
    gsync(gbar);
#endif
    STOPAT(3)
    if (PSEL(4)) gemm_phase<EPI_RES>(p, l, (const bf16_t*)(p.ws + OFF_MIX), 1024, (const bf16_t*)(p.ws + OFF_WTOUT) + (size_t)l * 1024 * 1024, 1024, 1024, 8, 2, lds, 1.f, 1);
    gsync(gbar);
#if PROBE_DG
    gemm_phase<EPI_RES>(p, l, (const bf16_t*)(p.ws + OFF_MIX), 1024, (const bf16_t*)(p.ws + OFF_WTOUT) + (size_t)l * 1024 * 1024, 1024, 1024, 8, 2, lds, 0.f);
    gsync(gbar);
#endif
    STOPAT(4)
    if (PSEL(1)) norm_phase(p, l, 1);
    gsync(gbar);
    STOPAT(5)
    if (PSEL(5)) gemm_phase<EPI_FFN>(p, l, hbf, 1024, (const bf16_t*)(p.ws + OFF_WT13) + (size_t)l * 5632 * 1024, 1024, 1024, 44, 0, lds);
    gsync(gbar);
#if PROBE_DUP
    gemm_phase<EPI_FFN>(p, l, hbf, 1024, (const bf16_t*)(p.ws + OFF_WT13) + (size_t)l * 5632 * 1024, 1024, 1024, 44, 0, lds);
    gsync(gbar);
#endif
    STOPAT(6)
    if (PSEL(4)) gemm_phase<EPI_RES>(p, l, (const bf16_t*)(p.ws + OFF_UBF), DFF, (const bf16_t*)(p.ws + OFF_WT2) + (size_t)l * 1024 * DFF, DFF, DFF, 8, 5, lds, 1.f, 1);
    gsync(gbar);
#if PROBE_DG
    gemm_phase<EPI_RES>(p, l, (const bf16_t*)(p.ws + OFF_UBF), DFF, (const bf16_t*)(p.ws + OFF_WT2) + (size_t)l * 1024 * DFF, DFF, DFF, 8, 5, lds, 0.f);
    gsync(gbar);
#endif
    STOPAT(7)
  }
}

#ifndef MULTI_LAUNCH
#define MULTI_LAUNCH 0
#endif
__global__ void __launch_bounds__(256, 2) phase_kernel(Params p, int phase, int l) {
  __shared__ __attribute__((aligned(16))) char lds[LDS_BYTES];
  __shared__ int s_item;
  const bf16_t* hbf = (const bf16_t*)(p.ws + OFF_HBF);
  switch (phase) {
    case 0: phase0(p, lds, &s_item); break;
    case 1: norm_phase(p, l, 0); break;
    case 2: gemm_phase<EPI_IN>(p, l, hbf, 1024, (const bf16_t*)(p.ws + OFF_WTIN) + (size_t)l * 2048 * 1024, 1024, 1024, 16, 0, lds); break;
    case 3: mixer_phase(p, l, 0, lds, &s_item); break;
    case 8: mixer_phase(p, l, 1, lds, &s_item); break;
    case 4: gemm_phase<EPI_RES>(p, l, (const bf16_t*)(p.ws + OFF_MIX), 1024, (const bf16_t*)(p.ws + OFF_WTOUT) + (size_t)l * 1024 * 1024, 1024, 1024, 8, 2, lds); break;
    case 5: norm_phase(p, l, 1); break;
    case 6: gemm_phase<EPI_FFN>(p, l, hbf, 1024, (const bf16_t*)(p.ws + OFF_WT13) + (size_t)l * 5632 * 1024, 1024, 1024, 44, 0, lds); break;
    default: gemm_phase<EPI_RES>(p, l, (const bf16_t*)(p.ws + OFF_UBF), DFF, (const bf16_t*)(p.ws + OFF_WT2) + (size_t)l * 1024 * DFF, DFF, DFF, 8, 5, lds); break;
  }
}

extern "C" void kernel_launch(void* const* d_in, const int* in_sizes, int n_in, void* d_out, int out_size, void* d_ws, size_t ws_size,
                              hipStream_t stream) {
  static int grid_blocks = 0;
  if (!grid_blocks) {
    int dev = 0, cus = 0, per_cu = 0;
    hipGetDevice(&dev);
    hipDeviceGetAttribute(&cus, hipDeviceAttributeMultiprocessorCount, dev);
    hipOccupancyMaxActiveBlocksPerMultiprocessor(&per_cu, fwd_megakernel, 256, 0);
    if (per_cu > 2) per_cu = 2;
    if (per_cu < 1) per_cu = 1;
    grid_blocks = cus * per_cu;
  }
  Params p{};
  for (int i = 0; i < 31; ++i) p.in[i] = (const float*)d_in[i];
  p.out = (float*)d_out;
  p.ws = (char*)d_ws;
  (void)hipMemsetAsync((char*)d_ws + OFF_CTR, 0, CTL_BYTES, stream);
#if MULTI_LAUNCH
  hipLaunchKernelGGL(phase_kernel, dim3(512), dim3(256), 0, stream, p, 0, 0);
  for (int l = 0; l < 4; ++l)
    for (int ph = 1; ph <= 7; ++ph) hipLaunchKernelGGL(phase_kernel, dim3(512), dim3(256), 0, stream, p, ph, l);
  return;
#endif
  void* args[] = {&p};
  hipError_t e = hipLaunchCooperativeKernel((void*)fwd_megakernel, dim3(grid_blocks), dim3(256), args, 0, stream);
  if (e != hipSuccess) fprintf(stderr, "cooperative launch failed: %s (grid %d)\n", hipGetErrorString(e), grid_blocks);
}
```

```cpp
#include <hip/hip_runtime.h>
#include <hip/hip_cooperative_groups.h>
#include <stdint.h>
#include <cstdio>
namespace cg = cooperative_groups;

typedef __attribute__((ext_vector_type(8))) short bf16x8;
typedef __attribute__((ext_vector_type(16))) float f32x16;
typedef unsigned short bf16_t;
#define DI __device__ __forceinline__
#define MFMA32(a, b, c) __builtin_amdgcn_mfma_f32_32x32x16_bf16((a), (b), (c), 0, 0, 0)

#define NTOK 10240
#define NPROMPT 8192
#define DM 1024
#define DFF 2816
#define OUT_NK 10485760
#define OUT_NV 14680064
#define OUT_ST 18874368

constexpr size_t OFF_WTIN   = 0;
constexpr size_t OFF_WTOUT  = OFF_WTIN + 16777216;
constexpr size_t OFF_WT13   = OFF_WTOUT + 8388608;
constexpr size_t OFF_WT2    = OFF_WT13 + 46137344;
constexpr size_t OFF_MOD    = OFF_WT2 + 23068672;
constexpr size_t OFF_TAP256 = OFF_MOD + 294912;
constexpr size_t OFF_TAP1024 = OFF_TAP256 + 4194304;
constexpr size_t OFF_KCAT   = OFF_TAP1024 + 16777216;
constexpr size_t OFF_VTL    = OFF_KCAT + 2621440;
constexpr size_t OFF_HBF    = OFF_VTL + 2621440;
constexpr size_t OFF_QBF    = OFF_HBF + 20971520;
constexpr size_t OFF_KBF    = OFF_QBF + 10485760;
constexpr size_t OFF_VTP    = OFF_KBF + 2097152;
constexpr size_t OFF_PBUF   = OFF_VTP + 2097152;
constexpr size_t OFF_MIX    = OFF_PBUF + 52428800;
constexpr size_t OFF_UBF    = OFF_MIX + 20971520;
constexpr size_t OFF_ZBUF   = OFF_UBF + 57671680;
constexpr size_t OFF_CTR    = OFF_ZBUF + 10485760;
constexpr size_t OFF_PHY    = OFF_CTR + 16384;
constexpr size_t WS_TOTAL   = OFF_PHY + (size_t)64 * 10240 * 12 * 4;

struct Params {
  const float* in[31];
  float* out;
  char* ws;
};

#define LDS_BYTES 73728
#define LROW 144
#define LTILE (128 * 144)
#define LBUF (2 * LTILE)

DI bf16_t f2bf(float x) { unsigned u = __float_as_uint(x); u += 0x7fffu + ((u >> 16) & 1u); return (bf16_t)(u >> 16); }
DI unsigned pack2(float a, float b) { return (unsigned)f2bf(a) | ((unsigned)f2bf(b) << 16); }
DI size_t blk(int m, int k, int KTF) { return ((size_t)((m >> 7) * KTF + (k >> 6)) * 128 + (m & 127)) * 64 + (k & 63); }
DI int otid() { int t = threadIdx.x; asm volatile("" : "+v"(t)); return t; }
DI void sync_g() { asm volatile("s_waitcnt vmcnt(0)" ::: "memory"); __syncthreads(); }
#define CW_CNT(j) (64 * (1 + (j)))
#define CW_SUB(j) (64 * (17 + (j)))
#define CW_TOP (64 * 33)
#define CW_GEN (64 * 34)
#define CW_XGEN(j) (64 * (35 + (j)))
#define CTL_BYTES 16384
struct GBar { unsigned* w; unsigned x, nloc, nx, epoch; };
DI unsigned gb_ld(unsigned* p) { return __hip_atomic_load(p, __ATOMIC_RELAXED, __HIP_MEMORY_SCOPE_AGENT); }
DI unsigned gb_add(unsigned* p, unsigned v) { return __hip_atomic_fetch_add(p, v, __ATOMIC_RELAXED, __HIP_MEMORY_SCOPE_AGENT); }
DI void gsync1(GBar& g) {
  asm volatile("s_waitcnt vmcnt(0)" ::: "memory");
  __syncthreads();
  if (threadIdx.x == 0) {
    g.epoch++;
    const unsigned old = gb_add(&g.w[CW_SUB(g.x)], 1u);
    if (old + 1u == g.epoch * g.nloc) {
      __builtin_amdgcn_fence(__ATOMIC_RELEASE, "agent");
      asm volatile("s_waitcnt vmcnt(0)" ::: "memory");
      const unsigned old2 = gb_add(&g.w[CW_TOP], 1u);
      if (old2 + 1u == g.epoch * g.nx) (void)gb_add(&g.w[CW_GEN], 1u);
    }
    while (gb_ld(&g.w[CW_GEN]) < g.epoch) __builtin_amdgcn_s_sleep(1);
    __builtin_amdgcn_fence(__ATOMIC_ACQUIRE, "agent");
    asm volatile("s_waitcnt vmcnt(0)" ::: "memory");
  }
  __syncthreads();
}
DI float fast_sigmoid(float x) { return __builtin_amdgcn_rcpf(1.f + __expf(-x)); }
DI float sigmoidf_(float x) { return 1.f / (1.f + __expf(-x)); }

DI void p0_transpose(const float* __restrict__ src, int K, int N, int kt, int nt, bf16_t* __restrict__ dst, int mode) {
  const int tid = otid();
  const int n = tid & 63, c = nt * 64 + n, k0 = kt * 128 + (tid >> 6) * 32;
  float v[32];
#pragma unroll
  for (int j = 0; j < 32; ++j) v[j] = src[(size_t)(k0 + j) * N + c];
  int nrow;
  if (mode == 0) nrow = c;
  else nrow = nt * 128 + (n >> 5) * 64 + (mode - 1) * 32 + (n & 31);
  uint4* d = (uint4*)(dst + blk(nrow, k0, K >> 6));
#pragma unroll
  for (int q = 0; q < 4; ++q)
    d[q] = make_uint4(pack2(v[8 * q], v[8 * q + 1]), pack2(v[8 * q + 2], v[8 * q + 3]), pack2(v[8 * q + 4], v[8 * q + 5]), pack2(v[8 * q + 6], v[8 * q + 7]));
}

DI void p0_mod(const Params& p, int l, int cc, float* lds) {
  const int tid = otid();
  float* s = lds;
  float* red = lds + 3072;
  for (int idx = tid; idx < 3072; idx += 256) {
    int ci = idx >> 10, k = idx & 1023;
    float v = (ci == 0) ? p.in[6][k] : p.in[5][(ci - 1) * 1024 + k];
    s[idx] = v / (1.f + expf(-v));
  }
  __syncthreads();
  const int col = tid & 63, kg = tid >> 6;
  const float* W = p.in[7] + (size_t)l * 1024 * 6144 + cc * 64 + col;
  float a0 = 0.f, a1 = 0.f, a2 = 0.f;
#pragma unroll 16
  for (int k = kg * 256; k < kg * 256 + 256; ++k) {
    float w = W[(size_t)k * 6144];
    a0 += s[k] * w; a1 += s[1024 + k] * w; a2 += s[2048 + k] * w;
  }
  red[(kg * 3 + 0) * 64 + col] = a0; red[(kg * 3 + 1) * 64 + col] = a1; red[(kg * 3 + 2) * 64 + col] = a2;
  __syncthreads();
  if (tid < 192) {
    int ci = tid >> 6, c = tid & 63;
    float v = red[(0 * 3 + ci) * 64 + c] + red[(1 * 3 + ci) * 64 + c] + red[(2 * 3 + ci) * 64 + c] + red[(3 * 3 + ci) * 64 + c];
    v += p.in[8][l * 6144 + cc * 64 + c];
    float* mod = (float*)(p.ws + OFF_MOD);
    mod[(l * 3 + ci) * 6144 + cc * 64 + c] = v;
  }
  __syncthreads();
}

DI void p0_taps(const Params& p, int l, int g, float* lds) {
  const int tid = otid();
  float* zf = lds;
  float* h1 = lds + 320;
  float* h2 = lds + 832;
  const int tt0 = g * 8;
  const int L = (tt0 < 256) ? 256 : 1024;
  const int tbase = (tt0 < 256) ? tt0 : tt0 - 256;
  const float invL = 1.f / (float)L;
  for (int idx = tid; idx < 264; idx += 256) {
    int ti = idx / 33, f = idx % 33;
    float t = (float)(tbase + ti);
    float v;
    if (f == 0) v = t * invL;
    else {
      int bi = (f - 1) & 15;
      float band = 1e-4f + (float)bi * ((15.f - 1e-4f) / 15.f);
      float ph = t * band * invL;
      ph -= floorf(ph);
      float ang = 6.283185307179586f * ph;
      v = (f <= 16) ? cosf(ang) : -sinf(ang);
    }
    zf[ti * 40 + f] = v;
  }
  __syncthreads();
  const float* w1 = p.in[20] + l * 33 * 64;
  const float* b1 = p.in[21] + l * 64;
  const float* w2 = p.in[22] + l * 64 * 64;
  const float* b2 = p.in[23] + l * 64;
  const float* w3 = p.in[24] + (size_t)l * 64 * 1024;
  const float* b3 = p.in[25] + l * 1024;
  for (int idx = tid; idx < 512; idx += 256) {
    int ti = idx >> 6, j = idx & 63;
    float a = b1[j];
#pragma unroll 11
    for (int f = 0; f < 33; ++f) a += zf[ti * 40 + f] * w1[f * 64 + j];
    h1[ti * 64 + j] = sinf(a);
  }
  __syncthreads();
  for (int idx = tid; idx < 512; idx += 256) {
    int ti = idx >> 6, j = idx & 63;
    float a = b2[j];
#pragma unroll 16
    for (int f = 0; f < 64; ++f) a += h1[ti * 64 + f] * w2[f * 64 + j];
    h2[ti * 64 + j] = sinf(a);
  }
  __syncthreads();
  float acc[4][8];
#pragma unroll
  for (int q = 0; q < 4; ++q)
#pragma unroll
    for (int ti = 0; ti < 8; ++ti) acc[q][ti] = 0.f;
#pragma unroll 8
  for (int i = 0; i < 64; ++i) {
    float w[4];
#pragma unroll
    for (int q = 0; q < 4; ++q) w[q] = w3[i * 1024 + q * 256 + tid];
#pragma unroll
    for (int ti = 0; ti < 8; ++ti) {
      float hv = h2[ti * 64 + i];
#pragma unroll
      for (int q = 0; q < 4; ++q) acc[q][ti] += hv * w[q];
    }
  }
  const int ch = tid;
  const float d0 = -3.0701134573253945f, d1 = -15.350567286626973f;
  const float delta = d0 + (float)ch * ((d1 - d0) / 255.f);
  bf16_t* tapbase = (L == 256) ? (bf16_t*)(p.ws + OFF_TAP256) + (size_t)l * 2 * 256 * 512
                               : (bf16_t*)(p.ws + OFF_TAP1024) + (size_t)l * 2 * 256 * 2048;
#pragma unroll
  for (int q = 0; q < 4; ++q) {
    const int order = q >> 1, side = q & 1;
    const float bb = b3[q * 256 + ch];
#pragma unroll
    for (int ti = 0; ti < 8; ++ti) {
      int t = tbase + ti;
      float tn = (float)t * invL;
      float val = (acc[q][ti] + bb) * expf(tn * delta);
      int x;
      if (side == 0) x = L + t;
      else { if (t == 0) { x = 0; val = 0.f; } else x = L - t; }
      tapbase[((size_t)order * 256 + ch) * 2 * L + (2 * L - 1 - x)] = f2bf(val);
    }
  }
  __syncthreads();
}

DI int kf_off(int key, int d) { return ((((key >> 5) * 4 + (d >> 4)) * 64 + ((d >> 3) & 1) * 32 + (key & 31)) << 3) + (d & 7); }
DI int vf_off(int key, int d) { return (((((key >> 5) * 2 + ((key >> 4) & 1)) * 2 + (d >> 5)) * 64 + ((key >> 2) & 1) * 32 + (d & 31)) << 3) + (key & 3) + 4 * ((key >> 3) & 1); }
DI void p0_cache(const Params& p, int it) {
  const int tid = otid();
  bf16_t* kcat = (bf16_t*)(p.ws + OFF_KCAT);
  bf16_t* vtl = (bf16_t*)(p.ws + OFF_VTL);
  for (int e = tid; e < 4096; e += 256) {
    int rr = it * 32 + (e >> 7), c = e & 127;
    int s = rr & 255, bl = rr >> 8, l = bl & 3, b = bl >> 2;
    float kv = p.in[2][(size_t)rr * 128 + c];
    float vv = p.in[3][(size_t)rr * 128 + c];
    const int kvh = c >> 6, d = c & 63;
    const size_t sb = (size_t)((l * 2 + b) * 2 + kvh) * (1280 * 64);
    kcat[sb + kf_off(s, d)] = f2bf(kv);
    vtl[sb + vf_off(s, d)] = f2bf(vv);
  }
}

DI void phase0(const Params& p, char* lds, int* s_item) {
  const int NTAP = 640, NMOD = 384, NCACHE = 64, NTR = 5760;
  const int total = NTAP + NMOD + NCACHE + NTR;
  int* ctr = (int*)(p.ws + OFF_CTR) + 16;
  const int tid = otid();
  for (;;) {
    if (tid == 0) *s_item = atomicAdd(ctr, 1);
    __syncthreads();
    const int it = *s_item;
    __syncthreads();
    if (it >= total) break;
    int r = it;
    if (r < NTAP) { p0_taps(p, r / 160, r % 160, (float*)lds); continue; }
    r -= NTAP;
    if (r < NMOD) { p0_mod(p, r / 96, r % 96, (float*)lds); continue; }
    r -= NMOD;
    if (r < NCACHE) { p0_cache(p, r); continue; }
    r -= NCACHE;
    int l = r / 1440; r %= 1440;
    if (r < 256) p0_transpose(p.in[11] + (size_t)l * 1024 * 2048, 1024, 2048, r / 32, r % 32, (bf16_t*)(p.ws + OFF_WTIN) + (size_t)l * 2048 * 1024, 0);
    else if (r < 384) { r -= 256; p0_transpose(p.in[27] + (size_t)l * 1024 * 1024, 1024, 1024, r / 16, r % 16, (bf16_t*)(p.ws + OFF_WTOUT) + (size_t)l * 1024 * 1024, 0); }
    else if (r < 736) { r -= 384; p0_transpose(p.in[28] + (size_t)l * 1024 * 2816, 1024, 2816, r / 44, r % 44, (bf16_t*)(p.ws + OFF_WT13) + (size_t)l * 5632 * 1024, 1); }
    else if (r < 1088) { r -= 736; p0_transpose(p.in[29] + (size_t)l * 1024 * 2816, 1024, 2816, r / 44, r % 44, (bf16_t*)(p.ws + OFF_WT13) + (size_t)l * 5632 * 1024, 2); }
    else { r -= 1088; p0_transpose(p.in[30] + (size_t)l * 2816 * 1024, 2816, 1024, r / 16, r % 16, (bf16_t*)(p.ws + OFF_WT2) + (size_t)l * 1024 * 2816, 0); }
  }
}

DI void norm_phase(const Params& p, int l, int which) {
  float* xbuf = p.out;
  bf16_t* hbf = (bf16_t*)(p.ws + OFF_HBF);
  const float* mod = (const float*)(p.ws + OFF_MOD);
  const float* nw = p.in[which ? 10 : 9] + l * 1024;
  const int tid_ = otid(); const int wave = tid_ >> 6, lane = tid_ & 63;
  const bool first = (l == 0 && which == 0);
  constexpr int RB = 5;
  const int nwaves = gridDim.x * 4;
  for (int row0 = blockIdx.x * 4 + wave; row0 < NTOK; row0 += nwaves * RB) {
    float4 v[RB][4];
#pragma unroll
    for (int j = 0; j < RB; ++j) {
      const int row = row0 + j * nwaves;
      if (row < NTOK) {
        const float* src;
        if (first) src = (row < NPROMPT) ? p.in[0] + (size_t)row * 1024 : p.in[1] + (size_t)(row - NPROMPT) * 1024;
        else src = xbuf + (size_t)row * 1024;
#pragma unroll
        for (int i = 0; i < 4; ++i) v[j][i] = *(const float4*)(src + i * 256 + lane * 4);
      } else {
#pragma unroll
        for (int i = 0; i < 4; ++i) v[j][i] = make_float4(0.f, 0.f, 0.f, 0.f);
      }
    }
#pragma unroll
    for (int j = 0; j < RB; ++j) {
      const int row = row0 + j * nwaves;
      if (row >= NTOK) break;
      float ss = 0.f;
#pragma unroll
      for (int i = 0; i < 4; ++i) ss += v[j][i].x * v[j][i].x + v[j][i].y * v[j][i].y + v[j][i].z * v[j][i].z + v[j][i].w * v[j][i].w;
#pragma unroll
      for (int o = 32; o >= 1; o >>= 1) ss += __shfl_xor(ss, o);
      const float rstd = rsqrtf(ss * (1.f / 1024.f) + 1e-6f);
      const int ci = (row < NPROMPT) ? 0 : 1 + ((row - NPROMPT) >> 10);
      const float* sh = mod + ((l * 3 + ci) * 6 + (which ? 3 : 0)) * 1024;
      const float* sc = sh + 1024;
#pragma unroll
      for (int i = 0; i < 4; ++i) {
        const int col = i * 256 + lane * 4;
        const float4 w4 = *(const float4*)(nw + col), s4 = *(const float4*)(sc + col), h4 = *(const float4*)(sh + col);
        const float y0 = v[j][i].x * rstd * w4.x * (1.f + s4.x) + h4.x;
        const float y1 = v[j][i].y * rstd * w4.y * (1.f + s4.y) + h4.y;
        const float y2 = v[j][i].z * rstd * w4.z * (1.f + s4.z) + h4.z;
        const float y3 = v[j][i].w * rstd * w4.w * (1.f + s4.w) + h4.w;
        *(uint2*)(hbf + blk(row, col, 16)) = make_uint2(pack2(y0, y1), pack2(y2, y3));
        if (first) *(float4*)(xbuf + (size_t)row * 1024 + col) = v[j][i];
      }
    }
  }
}

enum { EPI_IN = 0, EPI_RES = 1, EPI_FFN = 2 };

DI void epi_in(const Params& p, int l, int m0, int nt, const f32x16 (&acc)[2][2], char* lds) {
  const int tid = otid(), lane = tid & 63, wave = tid >> 6;
  const int wm = wave >> 1, wn = wave & 1, r = lane & 31, h = lane >> 5;
  float* Ct = (float*)lds;
#pragma unroll
  for (int i = 0; i < 2; ++i)
#pragma unroll
    for (int j = 0; j < 2; ++j)
#pragma unroll
      for (int reg = 0; reg < 16; ++reg) {
        int row = wm * 64 + i * 32 + (reg & 3) + 8 * (reg >> 2) + 4 * h;
        int col = wn * 64 + j * 32 + r;
        Ct[row * 132 + col] = acc[i][j][reg];
      }
  __syncthreads();
  const bool lat = (m0 >= NPROMPT);
  if (nt < 5) {
    const int row = tid >> 1, hh = tid & 1;
    float* src = Ct + row * 132 + hh * 64;
    float ss = 0.f;
#pragma unroll
    for (int d = 0; d < 64; d += 4) {
      float4 t = *(const float4*)(src + d);
      ss += t.x * t.x + t.y * t.y + t.z * t.z + t.w * t.w;
    }
    const float rstd = rsqrtf(ss * (1.f / 64.f) + 1e-6f);
    const float* nw = (nt < 4 ? p.in[12] : p.in[13]) + l * 64;
    const float osc = (nt < 4) ? 0.125f : 1.f;
    const int m = m0 + row;
    int pos = 0;
    if (lat) {
      pos = (m - NPROMPT) & 1023;
      const float pr = (float)(pos >> 6), pc = (float)(pos & 63);
#pragma unroll 1
      for (int d = 0; d < 16; ++d) {
        const float f = exp2f(-(float)d * 0.8304820237218406f);
        const float ar = pr * f, ac = pc * f;
        const float sr = sinf(ar), cr = cosf(ar), sc_ = sinf(ac), cc_ = cosf(ac);
        float x1 = src[d] * rstd * nw[d], x2 = src[d + 16] * rstd * nw[d + 16];
        src[d] = (x1 * cr - x2 * sr) * osc; src[d + 16] = (x2 * cr + x1 * sr) * osc;
        x1 = src[32 + d] * rstd * nw[32 + d]; x2 = src[48 + d] * rstd * nw[48 + d];
        src[32 + d] = (x1 * cc_ - x2 * sc_) * osc; src[48 + d] = (x2 * cc_ + x1 * sc_) * osc;
      }
    } else {
#pragma unroll
      for (int d = 0; d < 64; d += 4) {
        float4 t = *(const float4*)(src + d);
        float4 w = *(const float4*)(nw + d);
        t.x *= rstd * w.x * osc; t.y *= rstd * w.y * osc; t.z *= rstd * w.z * osc; t.w *= rstd * w.w * osc;
        *(float4*)(src + d) = t;
      }
    }
    if (nt < 4) {
      bf16_t* dst = (bf16_t*)(p.ws + OFF_QBF) + (size_t)m * 512 + (nt * 2 + hh) * 64;
#pragma unroll
      for (int d = 0; d < 64; d += 8) {
        float4 t0 = *(const float4*)(src + d), t1 = *(const float4*)(src + d + 4);
        *(uint4*)(dst + d) = make_uint4(pack2(t0.x, t0.y), pack2(t0.z, t0.w), pack2(t1.x, t1.y), pack2(t1.z, t1.w));
      }
    } else {
      bf16_t* dst;
      int key;
      if (!lat) {
        const int b = m >> 8, s = m & 255;
        float* nk = p.out + OUT_NK + ((size_t)((b * 4 + l) * 256 + s)) * 128 + hh * 64;
#pragma unroll
        for (int d = 0; d < 64; d += 4) *(float4*)(nk + d) = *(const float4*)(src + d);
        dst = (bf16_t*)(p.ws + OFF_KBF) + (size_t)(b * 2 + hh) * (256 * 64);
        key = s;
      } else {
        const int b2 = (m - NPROMPT) >> 10;
        dst = (bf16_t*)(p.ws + OFF_KCAT) + (size_t)((l * 2 + b2) * 2 + hh) * (1280 * 64);
        key = 256 + pos;
      }
#pragma unroll
      for (int d = 0; d < 64; d += 8) {
        float4 t0 = *(const float4*)(src + d), t1 = *(const float4*)(src + d + 4);
        *(uint4*)(dst + kf_off(key, d)) = make_uint4(pack2(t0.x, t0.y), pack2(t0.z, t0.w), pack2(t1.x, t1.y), pack2(t1.z, t1.w));
      }
    }
  } else if (nt == 5) {
    if (!lat) {
      const int row = tid >> 1, hf = tid & 1;
      const int m = m0 + row, b = m >> 8, s = m & 255;
      float* nv = p.out + OUT_NV + ((size_t)((b * 4 + l) * 256 + s)) * 128 + hf * 64;
      const float* src = Ct + row * 132 + hf * 64;
#pragma unroll
      for (int d = 0; d < 64; d += 4) *(float4*)(nv + d) = *(const float4*)(src + d);
    }
    {
      const int col = tid & 127, rh = tid >> 7;
      const int kvh = col >> 6, d = col & 63;
      bf16_t* dst;
      int kstart;
      if (!lat) {
        const int b = m0 >> 8, s0 = m0 & 255;
        dst = (bf16_t*)(p.ws + OFF_VTP) + (size_t)(b * 2 + kvh) * (256 * 64);
        kstart = s0 + rh * 64;
      } else {
        const int b2 = (m0 - NPROMPT) >> 10, s0 = (m0 - NPROMPT) & 1023;
        dst = (bf16_t*)(p.ws + OFF_VTL) + (size_t)((l * 2 + b2) * 2 + kvh) * (1280 * 64);
        kstart = 256 + s0 + rh * 64;
      }
      const float* src = Ct + (rh * 64) * 132 + col;
#pragma unroll
      for (int g = 0; g < 8; ++g) {
        const int kk0 = (g >> 2) * 32 + ((g >> 1) & 1) * 16 + (g & 1) * 4;
        *(uint4*)(dst + vf_off(kstart + kk0, d)) =
            make_uint4(pack2(src[(kk0 + 0) * 132], src[(kk0 + 1) * 132]), pack2(src[(kk0 + 2) * 132], src[(kk0 + 3) * 132]),
                       pack2(src[(kk0 + 8) * 132], src[(kk0 + 9) * 132]), pack2(src[(kk0 + 10) * 132], src[(kk0 + 11) * 132]));
      }
    }
  } else if (nt < 10) {
    const int row = tid >> 1, hf = tid & 1;
    float* dst = (float*)(p.ws + OFF_PBUF) + (size_t)(m0 + row) * 1280 + (nt * 128 - 768) + hf * 64;
    const float* src = Ct + row * 132 + hf * 64;
#pragma unroll
    for (int d = 0; d < 64; d += 4) *(float4*)(dst + d) = *(const float4*)(src + d);
  } else {
    const int row = tid >> 1, hf = tid & 1;
    const int sidx = (nt - 10) >> 1, cg0 = (((nt - 10) & 1) * 128 + hf * 64) >> 2;
    float* dst = (float*)(p.ws + OFF_PHY) + ((size_t)cg0 * NTOK + (m0 + row)) * 12 + sidx * 4;
    const float* src = Ct + row * 132 + hf * 64;
#pragma unroll
    for (int g = 0; g < 16; ++g) *(float4*)(dst + (size_t)g * NTOK * 12) = *(const float4*)(src + 4 * g);
  }
  __syncthreads();
}

template <int EPI>
DI void gemm_phase(const Params& p, int l, const bf16_t* A, int lda, const bf16_t* BT, int ldb, int K, int NT,
                           int modpart, char* lds, float gscale = 1.f, int KS = 1) {
  const int tid = otid(), lane = tid & 63, wave = tid >> 6;
  const int wm = wave >> 1, wn = wave & 1, r = lane & 31, h = lane >> 5;
  const int ntiles = 80 * NT * KS;
  const int KT = K / (64 * KS);
  const int woff = (tid >> 3) * LROW + (tid & 7) * 16;
  for (int t = blockIdx.x; t < ntiles; t += gridDim.x) {
    const int ks = t / (80 * NT), tt = t - ks * (80 * NT);
    const int mt = tt % 80, nt = tt / 80;
    const int m0 = mt * 128, n0 = nt * 128;
    f32x16 acc[2][2];
#pragma unroll
    for (int i = 0; i < 2; ++i)
#pragma unroll
      for (int j = 0; j < 2; ++j)
#pragma unroll
        for (int e = 0; e < 16; ++e) acc[i][j][e] = 0.f;
    const bf16_t* Ag = A + ((size_t)mt * (K >> 6) + ks * KT) * 8192 + tid * 8;
    const bf16_t* Bg = BT + ((size_t)nt * (K >> 6) + ks * KT) * 8192 + tid * 8;
    uint4 ra[2][4], rb[2][4];
#pragma unroll
    for (int i = 0; i < 4; ++i) {
      ra[0][i] = *(const uint4*)(Ag + i * 2048);
      rb[0][i] = *(const uint4*)(Bg + i * 2048);
    }
#pragma unroll
    for (int i = 0; i < 4; ++i) {
      *(uint4*)(lds + woff + i * 32 * LROW) = ra[0][i];
      *(uint4*)(lds + LTILE + woff + i * 32 * LROW) = rb[0][i];
    }
#pragma unroll
    for (int i = 0; i < 4; ++i) {
      asm volatile("global_load_dwordx4 %0, %1, off" : "=v"(ra[1][i]) : "v"(Ag + i * 2048 + 8192) : "memory");
      asm volatile("global_load_dwordx4 %0, %1, off" : "=v"(rb[1][i]) : "v"(Bg + i * 2048 + 8192) : "memory");
    }
    __syncthreads();
    for (int kt2 = 0; kt2 < KT; kt2 += 2) {
#pragma unroll
      for (int u = 0; u < 2; ++u) {
        const int kt = kt2 + u;
        const char* cur = lds + u * LBUF;
        char* nxt = lds + (u ^ 1) * LBUF;
        const int kn = (kt + 2 < KT) ? kt + 2 : KT - 1;
        asm volatile("s_waitcnt vmcnt(0)" ::: "memory");
#pragma unroll
        for (int i = 0; i < 4; ++i) {
          asm volatile("global_load_dwordx4 %0, %1, off" : "=v"(ra[u][i]) : "v"(Ag + i * 2048 + (size_t)kn * 8192) : "memory");
          asm volatile("global_load_dwordx4 %0, %1, off" : "=v"(rb[u][i]) : "v"(Bg + i * 2048 + (size_t)kn * 8192) : "memory");
        }
        __builtin_amdgcn_s_setprio(1);
#pragma unroll
        for (int st = 0; st < 4; ++st) {
          bf16x8 a0 = *(const bf16x8*)(cur + (wm * 64 + r) * LROW + st * 32 + h * 16);
          bf16x8 a1 = *(const bf16x8*)(cur + (wm * 64 + 32 + r) * LROW + st * 32 + h * 16);
          bf16x8 b0 = *(const bf16x8*)(cur + LTILE + (wn * 64 + r) * LROW + st * 32 + h * 16);
          bf16x8 b1 = *(const bf16x8*)(cur + LTILE + (wn * 64 + 32 + r) * LROW + st * 32 + h * 16);
          acc[0][0] = MFMA32(a0, b0, acc[0][0]);
          acc[0][1] = MFMA32(a0, b1, acc[0][1]);
          acc[1][0] = MFMA32(a1, b0, acc[1][0]);
          acc[1][1] = MFMA32(a1, b1, acc[1][1]);
          *(uint4*)(nxt + woff + st * 32 * LROW) = ra[u ^ 1][st];
          *(uint4*)(nxt + LTILE + woff + st * 32 * LROW) = rb[u ^ 1][st];
        }
        __builtin_amdgcn_s_setprio(0);
        __syncthreads();
      }
    }
    asm volatile("s_waitcnt vmcnt(0)" ::: "memory");
#pragma unroll
    for (int i = 0; i < 4; ++i) {
      typedef unsigned u32x4_t __attribute__((ext_vector_type(4)));
      const u32x4_t t0 = {ra[0][i].x, ra[0][i].y, ra[0][i].z, ra[0][i].w}, t1 = {rb[0][i].x, rb[0][i].y, rb[0][i].z, rb[0][i].w};
      const u32x4_t t2 = {ra[1][i].x, ra[1][i].y, ra[1][i].z, ra[1][i].w}, t3 = {rb[1][i].x, rb[1][i].y, rb[1][i].z, rb[1][i].w};
      asm volatile("" :: "v"(t0), "v"(t1), "v"(t2), "v"(t3));
    }
    if (EPI == EPI_IN) {
      epi_in(p, l, m0, nt, acc, lds);
    } else if (EPI == EPI_RES) {
      const int ci = (m0 < NPROMPT) ? 0 : 1 + ((m0 - NPROMPT) >> 10);
      const float* gate = (const float*)(p.ws + OFF_MOD) + ((l * 3 + ci) * 6 + modpart) * 1024;
      float* xbuf = p.out;
      if (KS > 1) {
#pragma unroll
        for (int j = 0; j < 2; ++j) {
          const int n = n0 + wn * 64 + j * 32 + r;
          const float g = gate[n] * gscale;
#pragma unroll
          for (int i = 0; i < 2; ++i)
#pragma unroll
            for (int reg = 0; reg < 16; ++reg) {
              const int m = m0 + wm * 64 + i * 32 + (reg & 3) + 8 * (reg >> 2) + 4 * h;
              (void)__hip_atomic_fetch_add(xbuf + (size_t)m * 1024 + n, g * acc[i][j][reg], __ATOMIC_RELAXED, __HIP_MEMORY_SCOPE_AGENT);
            }
        }
      } else {
        float* Ct = (float*)lds;
#pragma unroll
        for (int i = 0; i < 2; ++i)
#pragma unroll
          for (int j = 0; j < 2; ++j)
#pragma unroll
            for (int reg = 0; reg < 16; ++reg)
              Ct[(wm * 64 + i * 32 + (reg & 3) + 8 * (reg >> 2) + 4 * h) * 132 + wn * 64 + j * 32 + r] = acc[i][j][reg];
        __syncthreads();
#pragma unroll
        for (int i = 0; i < 16; ++i) {
          const int c = tid + 256 * i, row = c >> 5, c4 = (c & 31) * 4;
          const float4 a = *(const float4*)(Ct + row * 132 + c4);
          const float4 g = *(const float4*)(gate + n0 + c4);
          float4* xp = (float4*)(xbuf + (size_t)(m0 + row) * 1024 + n0 + c4);
          float4 xv = *xp;
          xv.x += gscale * g.x * a.x; xv.y += gscale * g.y * a.y; xv.z += gscale * g.z * a.z; xv.w += gscale * g.w * a.w;
          *xp = xv;
        }
        __syncthreads();
      }
    } else {
      bf16_t* st = (bf16_t*)lds + (wm * 64 + 4 * h) * 72 + wn * 32 + r;
#pragma unroll
      for (int i = 0; i < 2; ++i)
#pragma unroll
        for (int reg = 0; reg < 16; ++reg) {
          const float a = acc[i][0][reg], b = acc[i][1][reg];
          st[(i * 32 + (reg & 3) + 8 * (reg >> 2)) * 72] = f2bf(a * fast_sigmoid(a) * b);
        }
      __syncthreads();
      {
        bf16_t* ub = (bf16_t*)(p.ws + OFF_UBF) + ((size_t)mt * 44 + nt) * 8192;
#pragma unroll
        for (int i = 0; i < 4; ++i) {
          const int c = tid + 256 * i;
          *(uint4*)(ub + c * 8) = *(const uint4*)((const bf16_t*)lds + (c >> 3) * 72 + (c & 7) * 8);
        }
      }
      __syncthreads();
    }
  }
}

DI void attn_wave(const bf16_t* __restrict__ q, const bf16_t* __restrict__ kp, const bf16_t* __restrict__ vt, int nkeys, bf16_t* __restrict__ mixb, int qtok, int head) {
  const int lane = otid() & 63, r = lane & 31, h = lane >> 5;
  bf16x8 qf[4];
#pragma unroll
  for (int st = 0; st < 4; ++st) qf[st] = *(const bf16x8*)(q + (size_t)r * 512 + st * 16 + h * 8);
  f32x16 O[2];
#pragma unroll
  for (int e = 0; e < 16; ++e) { O[0][e] = 0.f; O[1][e] = 0.f; }
  float m = -1e30f, lsum = 0.f;
  bf16x8 kfr[2][4];
#pragma unroll
  for (int sub = 0; sub < 2; ++sub)
#pragma unroll
    for (int st = 0; st < 4; ++st) kfr[sub][st] = *(const bf16x8*)(kp + (size_t)(((sub * 4 + st) * 64 + lane) << 3));
  for (int k0 = 0; k0 < nkeys; k0 += 64) {
    f32x16 S[2];
#pragma unroll
    for (int sub = 0; sub < 2; ++sub) {
#pragma unroll
      for (int e = 0; e < 16; ++e) S[sub][e] = 0.f;
#pragma unroll
      for (int st = 0; st < 4; ++st) S[sub] = MFMA32(kfr[sub][st], qf[st], S[sub]);
    }
    {
      const int kn = (k0 + 64 < nkeys) ? k0 + 64 : k0;
#pragma unroll
      for (int sub = 0; sub < 2; ++sub)
#pragma unroll
        for (int st = 0; st < 4; ++st) kfr[sub][st] = *(const bf16x8*)(kp + (size_t)(((((kn >> 5) + sub) * 4 + st) * 64 + lane) << 3));
    }
    bf16x8 vfr[2][2][2];
#pragma unroll
    for (int sub = 0; sub < 2; ++sub)
#pragma unroll
      for (int s2 = 0; s2 < 2; ++s2)
#pragma unroll
        for (int dt = 0; dt < 2; ++dt)
          vfr[sub][s2][dt] = *(const bf16x8*)(vt + (size_t)((((((k0 >> 5) + sub) * 2 + s2) * 2 + dt) * 64 + lane) << 3));
    float mx = m;
#pragma unroll
    for (int sub = 0; sub < 2; ++sub)
#pragma unroll
      for (int e = 0; e < 16; ++e) mx = fmaxf(mx, S[sub][e]);
    mx = fmaxf(mx, __shfl_xor(mx, 32));
    const float alpha = __expf(m - mx);
    m = mx;
    float ps = 0.f;
#pragma unroll
    for (int sub = 0; sub < 2; ++sub)
#pragma unroll
      for (int e = 0; e < 16; ++e) { float pv = __expf(S[sub][e] - mx); S[sub][e] = pv; ps += pv; }
    lsum = lsum * alpha + ps;
#pragma unroll
    for (int e = 0; e < 16; ++e) { O[0][e] *= alpha; O[1][e] *= alpha; }
#pragma unroll
    for (int sub = 0; sub < 2; ++sub)
#pragma unroll
      for (int s = 0; s < 2; ++s) {
        union { unsigned u[4]; bf16x8 v; } pf;
#pragma unroll
        for (int j = 0; j < 4; ++j) pf.u[j] = pack2(S[sub][8 * s + 2 * j], S[sub][8 * s + 2 * j + 1]);
#pragma unroll
        for (int dt = 0; dt < 2; ++dt) O[dt] = MFMA32(vfr[sub][s][dt], pf.v, O[dt]);
      }
  }
  lsum += __shfl_xor(lsum, 32);
  const float inv = 1.f / lsum;
  bf16_t* ob = mixb + ((size_t)(qtok >> 7) * 16 + head) * 8192 + ((qtok & 127) + r) * 64;
#pragma unroll
  for (int dt = 0; dt < 2; ++dt)
#pragma unroll
    for (int g = 0; g < 4; ++g) {
      const int d = dt * 32 + 8 * g + 4 * h;
      *(uint2*)(ob + d) = make_uint2(pack2(O[dt][4 * g] * inv, O[dt][4 * g + 1] * inv), pack2(O[dt][4 * g + 2] * inv, O[dt][4 * g + 3] * inv));
    }
}

DI float gelu_tanh(float x) { return 0.5f * x * (1.f + tanhf(0.7978845608028654f * (x + 0.044715f * x * x * x))); }

#ifndef PROBE_BAR
#define PROBE_BAR 0
#endif
DI void gsync(GBar& g) { gsync1(g); if (PROBE_BAR) { gsync1(g); gsync1(g); } }
DI float fast_gelu(float x) {
  const float u = 0.7978845608028654f * (x + 0.044715f * x * x * x);
  const float th = 1.f - 2.f * __builtin_amdgcn_rcpf(1.f + __expf(2.f * u));
  return 0.5f * x * (1.f + th);
}

DI void lru_gate_item(const Params& p, int l, int mt, int n, char* lds) {
  const int tid = otid(), lane = tid & 63, wave = tid >> 6, r = lane & 31, h = lane >> 5;
  float* XC = (float*)lds;
  bf16_t* Axc = (bf16_t*)(lds + 32768);
  const int m0 = mt * 128;
  const int L = (m0 < NPROMPT) ? 256 : 1024;
  const int tb = (m0 < NPROMPT) ? (m0 & 255) : ((m0 - NPROMPT) & 1023);
  const float* pbuf = (const float*)(p.ws + OFF_PBUF);
  float2* ab = (float2*)(p.ws + OFF_UBF);
  {
    const int ch = tid & 63, tq = tid >> 6, gch = n * 64 + ch;
    float cw[4];
#pragma unroll
    for (int k = 0; k < 4; ++k) cw[k] = p.in[14][(l * 4 + k) * 256 + gch];
    const float cb = p.in[15][l * 256 + gch];
    float x[35];
#pragma unroll
    for (int i = 0; i < 35; ++i) {
      const int ts = tb + tq * 32 + i - 2;
      x[i] = (ts >= 0 && ts < L) ? pbuf[(size_t)(m0 - tb + ts) * 1280 + gch] : 0.f;
    }
#pragma unroll
    for (int e = 0; e < 32; ++e) {
      const float xv = cb + cw[0] * x[e] + cw[1] * x[e + 1] + cw[2] * x[e + 2] + cw[3] * x[e + 3];
      XC[(tq * 32 + e) * 64 + ch] = xv;
      Axc[(tq * 32 + e) * 72 + ch] = f2bf(xv);
    }
  }
  __syncthreads();
  {
    const int dir = wave & 1, half = wave >> 1;
    bf16x8 wf[2][2][4];
    float gb[2][2], sp[2];
#pragma unroll
    for (int g = 0; g < 2; ++g) {
      const float* W = p.in[16] + ((size_t)((l * 2 + dir) * 2 + g) * 4 + n) * 4096;
#pragma unroll
      for (int ct = 0; ct < 2; ++ct) {
        const int j = r + 32 * ct;
        gb[g][ct] = p.in[17][((l * 2 + dir) * 2 + g) * 256 + n * 64 + j];
#pragma unroll
        for (int st = 0; st < 4; ++st) {
          const int i0 = 16 * st + 8 * h;
          union { unsigned u[4]; bf16x8 v; } f;
#pragma unroll
          for (int jj = 0; jj < 4; ++jj) f.u[jj] = pack2(W[(i0 + 2 * jj) * 64 + j], W[(i0 + 2 * jj + 1) * 64 + j]);
          wf[g][ct][st] = f.v;
        }
      }
    }
#pragma unroll
    for (int ct = 0; ct < 2; ++ct) sp[ct] = log1pf(expf(-p.in[18][(l * 2 + dir) * 256 + n * 64 + r + 32 * ct]));
#pragma unroll 1
    for (int rt = 0; rt < 2; ++rt) {
      f32x16 acc[2][2];
#pragma unroll
      for (int e = 0; e < 16; ++e) { acc[0][0][e] = 0.f; acc[0][1][e] = 0.f; acc[1][0][e] = 0.f; acc[1][1][e] = 0.f; }
#pragma unroll
      for (int st = 0; st < 4; ++st) {
        const bf16x8 af = *(const bf16x8*)(Axc + (half * 64 + rt * 32 + r) * 72 + 16 * st + 8 * h);
        acc[0][0] = MFMA32(af, wf[0][0][st], acc[0][0]);
        acc[0][1] = MFMA32(af, wf[0][1][st], acc[0][1]);
        acc[1][0] = MFMA32(af, wf[1][0][st], acc[1][0]);
        acc[1][1] = MFMA32(af, wf[1][1][st], acc[1][1]);
      }
#pragma unroll
      for (int ct = 0; ct < 2; ++ct)
#pragma unroll
        for (int reg = 0; reg < 16; ++reg) {
          const int tok = half * 64 + rt * 32 + (reg & 3) + 8 * (reg >> 2) + 4 * h;
          const int j = r + 32 * ct;
          const float rr = fast_sigmoid(acc[0][ct][reg] + gb[0][ct]);
          const float ii = fast_sigmoid(acc[1][ct][reg] + gb[1][ct]);
          const float xv = XC[tok * 64 + j];
          const float a = __expf(-8.f * rr * sp[ct]);
          const float bb = __builtin_sqrtf(fmaxf(fmaf(-a, a, 1.f), 0.f)) * (ii * xv);
          ab[((size_t)dir * NTOK + m0 + tok) * 256 + n * 64 + j] = make_float2(a, bb);
        }
    }
  }
  __syncthreads();
}

template <int CGS>
DI void lru_scan_item(const Params& p, int l, int bidx, int cbase, char* lds) {
  constexpr int NSEG = 256 / CGS;
  const int tid = otid();
  const bool lat = bidx >= 32;
  const int L = lat ? 1024 : 256;
  const int tok0 = lat ? NPROMPT + (bidx - 32) * 1024 : bidx * 256;
  const int ch = tid % CGS, sg = tid / CGS, gch = cbase + ch;
  const int SEGL = L / NSEG;
  float2* SEG = (float2*)lds;
  const float2* ab = (const float2*)(p.ws + OFF_UBF);
  float* hfbuf = (float*)(p.ws + OFF_UBF + 41943040);
  const float* pbuf = (const float*)(p.ws + OFF_PBUF);
  bf16_t* mix = (bf16_t*)(p.ws + OFF_MIX);
  const float2* abf = ab + ((size_t)0 * NTOK + tok0 + sg * SEGL) * 256 + gch;
  const float2* abb = ab + ((size_t)1 * NTOK + tok0 + sg * SEGL) * 256 + gch;
  {
    float A = 1.f, B = 0.f;
#pragma unroll 16
    for (int i = 0; i < SEGL; ++i) { const float2 v = abf[(size_t)i * 256]; B = v.x * B + v.y; A *= v.x; }
    SEG[(0 * NSEG + sg) * CGS + ch] = make_float2(A, B);
    A = 1.f; B = 0.f;
#pragma unroll 16
    for (int i = SEGL - 1; i >= 0; --i) { const float2 v = abb[(size_t)i * 256]; B = v.x * B + v.y; A *= v.x; }
    SEG[(1 * NSEG + sg) * CGS + ch] = make_float2(A, B);
  }
  __syncthreads();
  float hf = lat ? p.in[4][(((bidx - 32) * 4 + l) * 2 + 0) * 256 + gch] : 0.f;
  float hb = lat ? p.in[4][(((bidx - 32) * 4 + l) * 2 + 1) * 256 + gch] : 0.f;
  for (int q = 0; q < sg; ++q) { const float2 v = SEG[(0 * NSEG + q) * CGS + ch]; hf = v.x * hf + v.y; }
  for (int q = NSEG - 1; q > sg; --q) { const float2 v = SEG[(1 * NSEG + q) * CGS + ch]; hb = v.x * hb + v.y; }
  if (!lat) {
    if (sg == NSEG - 1) { const float2 v = SEG[(0 * NSEG + NSEG - 1) * CGS + ch]; p.out[OUT_ST + ((size_t)(bidx * 4 + l) * 2 + 0) * 256 + gch] = v.x * hf + v.y; }
    if (sg == 0) { const float2 v = SEG[(1 * NSEG + 0) * CGS + ch]; p.out[OUT_ST + ((size_t)(bidx * 4 + l) * 2 + 1) * 256 + gch] = v.x * hb + v.y; }
  }
  float* hfp = hfbuf + (size_t)(tok0 + sg * SEGL) * 256 + gch;
  for (int i0 = 0; i0 < SEGL; i0 += 16) {
    float2 v[16];
#pragma unroll
    for (int j = 0; j < 16; ++j) v[j] = abf[(size_t)(i0 + j) * 256];
#pragma unroll
    for (int j = 0; j < 16; ++j) { hf = v[j].x * hf + v[j].y; hfp[(size_t)(i0 + j) * 256] = hf; }
  }
  const float* lg = pbuf + (size_t)(tok0 + sg * SEGL) * 1280 + 256 + gch;
  bf16_t* mp = mix + blk(tok0 + sg * SEGL, 512 + gch, 16);
  for (int i0 = SEGL - 16; i0 >= 0; i0 -= 16) {
    float2 v[16];
    float gv[16], fv[16];
#pragma unroll
    for (int j = 0; j < 16; ++j) {
      v[j] = abb[(size_t)(i0 + j) * 256];
      gv[j] = lg[(size_t)(i0 + j) * 1280];
      fv[j] = hfp[(size_t)(i0 + j) * 256];
    }
#pragma unroll
    for (int j = 15; j >= 0; --j) {
      hb = v[j].x * hb + v[j].y;
      mp[(size_t)(i0 + j) * 64] = f2bf(fast_gelu(gv[j]) * (fv[j] + hb));
    }
  }
  __syncthreads();
}

DI bf16x8 ld16u(const bf16_t* p) { bf16x8 v; __builtin_memcpy(&v, p, 16); return v; }
typedef unsigned u32x4v __attribute__((ext_vector_type(4)));
DI bf16x8 ld16_shift(const bf16_t* p8, int ds2, int ds1, unsigned hb) {
  const u32x4v c0 = *(const u32x4v*)p8, c1 = *(const u32x4v*)(p8 + 8);
  unsigned t0 = ds2 ? c0[2] : c0[0], t1 = ds2 ? c0[3] : c0[1], t2 = ds2 ? c1[0] : c0[2], t3 = ds2 ? c1[1] : c0[3], t4 = ds2 ? c1[2] : c1[0], t5 = ds2 ? c1[3] : c1[1];
  unsigned u0 = ds1 ? t1 : t0, u1 = ds1 ? t2 : t1, u2 = ds1 ? t3 : t2, u3 = ds1 ? t4 : t3, u4 = ds1 ? t5 : t4;
  union { unsigned u[4]; bf16x8 v; } r;
  r.u[0] = __builtin_amdgcn_alignbyte(u1, u0, hb); r.u[1] = __builtin_amdgcn_alignbyte(u2, u1, hb);
  r.u[2] = __builtin_amdgcn_alignbyte(u3, u2, hb); r.u[3] = __builtin_amdgcn_alignbyte(u4, u3, hb);
  return r.v;
}
DI float bf2f(bf16_t v) { return __uint_as_float((unsigned)v << 16); }
DI float conv3_at(const float* __restrict__ pb, int t, int L, float w0, float w1, float w2) {
  float v = w1 * pb[(size_t)t * 1280];
  if (t > 0) v += w0 * pb[(size_t)(t - 1) * 1280];
  if (t < L - 1) v += w2 * pb[(size_t)(t + 1) * 1280];
  return v;
}

template <int L>
DI void hy_item(const Params& p, int l, int tokbase, int c0, char* lds) {
  constexpr int NB = L / 32, NQ = 32 / NB, PADLEN = (3 * NB - 2) * 32;
  const int tid = otid(), lane = tid & 63, wave = tid >> 6, h = lane >> 5;
  bf16_t* UP = (bf16_t*)lds;
  float* X1 = (float*)(lds + 24576);
  float* X2 = (float*)(lds + 24576 + 16384);
  const float* phy = (const float*)(p.ws + OFF_PHY) + (size_t)(c0 >> 2) * NTOK * 12;
  const float* hcw = p.in[19] + l * 3 * 768 + c0;
  for (int idx = tid; idx < 4 * NQ * 2 * (NB - 1) * 32; idx += 256) {
    const int e = idx % ((NB - 1) * 32), s2 = (idx / ((NB - 1) * 32)) & 1, sq = idx / (2 * (NB - 1) * 32);
    UP[sq * PADLEN + (s2 ? (2 * NB - 1) * 32 : 0) + e] = 0;
  }
  {
    float4 w[3][3];
#pragma unroll
    for (int k = 0; k < 3; ++k)
#pragma unroll
      for (int sidx = 0; sidx < 3; ++sidx) w[k][sidx] = *(const float4*)(hcw + k * 768 + sidx * 256);
    for (int pr = tid; pr < NQ * L; pr += 256) {
      const int q = pr / L, t = pr % L;
      const float* row = phy + (size_t)(tokbase + q * L + t) * 12;
      float4 o[3];
#pragma unroll
      for (int sidx = 0; sidx < 3; ++sidx) {
        const float4 m = *(const float4*)(row + sidx * 4);
        o[sidx] = make_float4(w[1][sidx].x * m.x, w[1][sidx].y * m.y, w[1][sidx].z * m.z, w[1][sidx].w * m.w);
        if (t > 0) {
          const float4 a = *(const float4*)(row - 12 + sidx * 4);
          o[sidx].x += w[0][sidx].x * a.x; o[sidx].y += w[0][sidx].y * a.y; o[sidx].z += w[0][sidx].z * a.z; o[sidx].w += w[0][sidx].w * a.w;
        }
        if (t < L - 1) {
          const float4 c = *(const float4*)(row + 12 + sidx * 4);
          o[sidx].x += w[2][sidx].x * c.x; o[sidx].y += w[2][sidx].y * c.y; o[sidx].z += w[2][sidx].z * c.z; o[sidx].w += w[2][sidx].w * c.w;
        }
      }
      const int ui = q * PADLEN + (NB - 1) * 32 + t;
      UP[(0 * NQ) * PADLEN + ui] = f2bf(o[0].x); UP[(1 * NQ) * PADLEN + ui] = f2bf(o[0].y);
      UP[(2 * NQ) * PADLEN + ui] = f2bf(o[0].z); UP[(3 * NQ) * PADLEN + ui] = f2bf(o[0].w);
      X1[0 * NQ * L + pr] = o[1].x; X1[1 * NQ * L + pr] = o[1].y; X1[2 * NQ * L + pr] = o[1].z; X1[3 * NQ * L + pr] = o[1].w;
      X2[0 * NQ * L + pr] = o[2].x; X2[1 * NQ * L + pr] = o[2].y; X2[2 * NQ * L + pr] = o[2].z; X2[3 * NQ * L + pr] = o[2].w;
    }
  }
  __syncthreads();
  {
    const int c = c0 + wave;
    const int col = lane & 31, q = col / NB, T = col % NB;
    bf16_t* U = UP + wave * NQ * PADLEN;
    const bf16_t* rv0 = ((L == 256) ? (const bf16_t*)(p.ws + OFF_TAP256) + (size_t)l * 2 * 256 * 512
                                    : (const bf16_t*)(p.ws + OFF_TAP1024) + (size_t)l * 2 * 256 * 2048) + (size_t)c * 2 * L;
    const bf16_t* rv1 = rv0 + (size_t)256 * 2 * L;
    const int aoff_u = L - 1 - (lane & 31) + 8 * h;
    const int ash = aoff_u & 7, aoff = aoff_u - ash;
    const int ds2 = (ash >> 2) & 1, ds1 = (ash >> 1) & 1; const unsigned hb = (ash & 1) * 2;
    const int boff = q * PADLEN + 32 * (T + NB - 1) + 8 * h;
    const int uo = q * PADLEN + (NB - 1) * 32 + 32 * T + 4 * h;
    const int xo = wave * NQ * L + q * L + 32 * T + 4 * h;
    const float skip0 = p.in[26][(l * 2 + 0) * 256 + c], skip1 = p.in[26][(l * 2 + 1) * 256 + c];
    f32x16 acc;
#pragma unroll
    for (int e = 0; e < 16; ++e) acc[e] = 0.f;
    f32x16 accB;
#pragma unroll
    for (int e = 0; e < 16; ++e) accB[e] = 0.f;
#pragma unroll 5
    for (int D = -(NB - 1); D <= NB - 1; ++D) {
      const int off = -32 * D;
      const bf16x8 a0 = ld16_shift(rv0 + aoff + off, ds2, ds1, hb), a1 = ld16_shift(rv0 + aoff + off + 16, ds2, ds1, hb);
      const bf16x8 b0 = *(const bf16x8*)(U + boff + off), b1 = *(const bf16x8*)(U + boff + off + 16);
      acc = MFMA32(a0, b0, acc);
      accB = MFMA32(a1, b1, accB);
    }
#pragma unroll
    for (int e = 0; e < 16; ++e) acc[e] += accB[e];
    float z[16];
#pragma unroll
    for (int g = 0; g < 4; ++g) {
      const uint2 vv = *(const uint2*)(U + uo + 8 * g);
      const float4 x1 = *(const float4*)(X1 + xo + 8 * g);
      z[4 * g + 0] = x1.x * (acc[4 * g + 0] + skip0 * __uint_as_float(vv.x << 16));
      z[4 * g + 1] = x1.y * (acc[4 * g + 1] + skip0 * __uint_as_float(vv.x & 0xffff0000u));
      z[4 * g + 2] = x1.z * (acc[4 * g + 2] + skip0 * __uint_as_float(vv.y << 16));
      z[4 * g + 3] = x1.w * (acc[4 * g + 3] + skip0 * __uint_as_float(vv.y & 0xffff0000u));
    }
    __builtin_amdgcn_wave_barrier();
#pragma unroll
    for (int g = 0; g < 4; ++g)
      *(uint2*)(U + uo + 8 * g) = make_uint2(pack2(z[4 * g], z[4 * g + 1]), pack2(z[4 * g + 2], z[4 * g + 3]));
    __builtin_amdgcn_wave_barrier();
#pragma unroll
    for (int e = 0; e < 16; ++e) acc[e] = 0.f;
#pragma unroll
    for (int e = 0; e < 16; ++e) accB[e] = 0.f;
#pragma unroll 5
    for (int D = -(NB - 1); D <= NB - 1; ++D) {
      const int off = -32 * D;
      const bf16x8 a0 = ld16_shift(rv1 + aoff + off, ds2, ds1, hb), a1 = ld16_shift(rv1 + aoff + off + 16, ds2, ds1, hb);
      const bf16x8 b0 = *(const bf16x8*)(U + boff + off), b1 = *(const bf16x8*)(U + boff + off + 16);
      acc = MFMA32(a0, b0, acc);
      accB = MFMA32(a1, b1, accB);
    }
#pragma unroll
    for (int e = 0; e < 16; ++e) acc[e] += accB[e];
    bf16_t* OUT = (bf16_t*)(lds + 57344) + (size_t)(q * L + 32 * T + 4 * h) * 4 + wave;
#pragma unroll
    for (int g = 0; g < 4; ++g) {
      const float4 x2 = *(const float4*)(X2 + xo + 8 * g);
      OUT[(8 * g + 0) * 4] = f2bf(x2.x * (acc[4 * g + 0] + skip1 * z[4 * g + 0]));
      OUT[(8 * g + 1) * 4] = f2bf(x2.y * (acc[4 * g + 1] + skip1 * z[4 * g + 1]));
      OUT[(8 * g + 2) * 4] = f2bf(x2.z * (acc[4 * g + 2] + skip1 * z[4 * g + 2]));
      OUT[(8 * g + 3) * 4] = f2bf(x2.w * (acc[4 * g + 3] + skip1 * z[4 * g + 3]));
    }
  }
  __syncthreads();
  {
    const uint2* OUTv = (const uint2*)(lds + 57344);
    bf16_t* mix = (bf16_t*)(p.ws + OFF_MIX);
    for (int idx = tid; idx < NQ * L; idx += 256) *(uint2*)(mix + blk(tokbase + idx, 768 + c0, 16)) = OUTv[idx];
  }
  __syncthreads();
}

DI void mixer_phase(const Params& p, int l, int sub, char* lds, int* s_item, int rep = 0) {
  const int tid = otid(), wave = tid >> 6;
  int* ctr = (int*)(p.ws + OFF_CTR) + l * 2 + sub + rep * 8;
  bf16_t* mix = (bf16_t*)(p.ws + OFF_MIX);
  const bf16_t* qbf = (const bf16_t*)(p.ws + OFF_QBF);
  const int nitems = sub ? 672 : 1088;
  for (;;) {
    if (tid == 0) *s_item = atomicAdd(ctr, 1);
    __syncthreads();
    const int it = *s_item;
    __syncthreads();
    if (it >= nitems) break;
    if (sub == 0) {
      if (it < 128) {
        const int j = it;
        hy_item<1024>(p, l, NPROMPT + (j >> 6) * 1024, (j & 63) * 4, lds);
      } else if (it < 256) {
        const int j = it - 128, b2 = j >> 6, head = (j >> 3) & 7, qb = j & 7, kvh = head >> 2;
        const int qtok = NPROMPT + b2 * 1024 + qb * 128 + wave * 32;
        attn_wave(qbf + (size_t)qtok * 512 + head * 64,
                  (const bf16_t*)(p.ws + OFF_KCAT) + (size_t)((l * 2 + b2) * 2 + kvh) * (1280 * 64),
                  (const bf16_t*)(p.ws + OFF_VTL) + (size_t)((l * 2 + b2) * 2 + kvh) * (1280 * 64), 1280,
                  mix, qtok, head);
      } else if (it < 576) {
        const int j = it - 256;
        lru_gate_item(p, l, j >> 2, j & 3, lds);
      } else {
        const int j = it - 576;
        hy_item<256>(p, l, (j >> 6) * 1024, (j & 63) * 4, lds);
      }
    } else {
      if (it < 32) {
        lru_scan_item<16>(p, l, 32 + (it >> 4), (it & 15) * 16, lds);
      } else if (it < 160) {
        const int j = it - 32;
        lru_scan_item<64>(p, l, j >> 2, (j & 3) * 64, lds);
      } else {
        const int j = it - 160, b = j >> 4, head = (j >> 1) & 7, qb = j & 1, kvh = head >> 2;
        const int qtok = b * 256 + qb * 128 + wave * 32;
        attn_wave(qbf + (size_t)qtok * 512 + head * 64,
                  (const bf16_t*)(p.ws + OFF_KBF) + (size_t)(b * 2 + kvh) * (256 * 64),
                  (const bf16_t*)(p.ws + OFF_VTP) + (size_t)(b * 2 + kvh) * (256 * 64), 256,
                  mix, qtok, head);
      }
    }
  }
}

#ifndef PROBE_P0
#define PROBE_P0 0
#endif
#ifndef PROBE_DG
#define PROBE_DG 0
#endif
#ifndef PROBE_MIX
#define PROBE_MIX 0
#endif
#ifndef PROBE_DUP
#define PROBE_DUP 0
#endif
#ifndef PHASE_SEL
#define PHASE_SEL -1
#endif
#define PSEL(k) (PHASE_SEL < 0 || PHASE_SEL == (k))
#ifndef STOP_P
#define STOP_P -1
#endif
#ifndef STOP_L
#define STOP_L 0
#endif
#define STOPAT(k) if (STOP_P == (k) && l == STOP_L) return;
__global__ void __launch_bounds__(256, 2) fwd_megakernel(Params p) {
  cg::grid_group grid = cg::this_grid();
  __shared__ __attribute__((aligned(16))) char lds[LDS_BYTES];
  __shared__ int s_item;
  GBar gbar;
  gbar.w = (unsigned*)(p.ws + OFF_CTR);
  gbar.x = (unsigned)__builtin_amdgcn_s_getreg((3 << 11) | 20) & 0xFu;
  gbar.epoch = 0; gbar.nloc = 1; gbar.nx = 1;
  if (threadIdx.x == 0) (void)gb_add(&gbar.w[CW_CNT(gbar.x)], 1u);
  grid.sync();
  if (threadIdx.x == 0) {
    unsigned cnt = 0, mine = 1;
    for (unsigned j = 0; j < 16; ++j) { const unsigned c = gb_ld(&gbar.w[CW_CNT(j)]); cnt += (c > 0u) ? 1u : 0u; if (j == gbar.x) mine = c; }
    gbar.nloc = mine; gbar.nx = cnt;
  }
  if (PSEL(0)) phase0(p, lds, &s_item);
  gsync(gbar);
#if PROBE_P0
#endif
  const bf16_t* hbf = (const bf16_t*)(p.ws + OFF_HBF);
  for (int l = 0; l < 4; ++l) {
    if (PSEL(1)) norm_phase(p, l, 0);
    gsync(gbar);
    STOPAT(1)
    if (PSEL(2)) gemm_phase<EPI_IN>(p, l, hbf, 1024, (const bf16_t*)(p.ws + OFF_WTIN) + (size_t)l * 2048 * 1024, 1024, 1024, 16, 0, lds);
    gsync(gbar);
#if PROBE_DUP
    gemm_phase<EPI_IN>(p, l, hbf, 1024, (const bf16_t*)(p.ws + OFF_WTIN) + (size_t)l * 2048 * 1024, 1024, 1024, 16, 0, lds);
    gsync(gbar);
#endif
    STOPAT(2)
    if (PSEL(3)) mixer_phase(p, l, 0, lds, &s_item);
    gsync(gbar);
    if (PSEL(3)) mixer_phase(p, l, 1, lds, &s_item);
    gsync(gbar);
#if PROBE_MIX
    mixer_phase(p, l, 0, lds, &s_item, 1);
    gsync(gbar);
    mixer_phase(p, l, 1, lds, &s_item, 1);
    gsync(gbar);
#endif
    STOPAT(3)
    if (PSEL(4)) gemm_phase<EPI_RES>(p, l, (const bf16_t*)(p.ws + OFF_MIX), 1024, (const bf16_t*)(p.ws + OFF_WTOUT) + (size_t)l * 1024 * 1024, 1024, 1024, 8, 2, lds, 1.f, 1);
    gsync(gbar);
#if PROBE_DG
    gemm_phase<EPI_RES>(p, l, (const bf16_t*)(p.ws + OFF_MIX), 1024, (const bf16_t*)(p.ws + OFF_WTOUT) + (size_t)l * 1024 * 1024, 1024, 1024, 8, 2, lds, 0.f);
    gsync(gbar);
#endif
    STOPAT(4)
    if (PSEL(1)) norm_phase(p, l, 1);
    gsync(gbar);
    STOPAT(5)
    if (PSEL(5)) gemm_phase<EPI_FFN>(p, l, hbf, 1024, (const bf16_t*)(p.ws + OFF_WT13) + (size_t)l * 5632 * 1024, 1024, 1024, 44, 0, lds);
    gsync(gbar);
#if PROBE_DUP
    gemm_phase<EPI_FFN>(p, l, hbf, 1024, (const bf16_t*)(p.ws + OFF_WT13) + (size_t)l * 5632 * 1024, 1024, 1024, 44, 0, lds);
    gsync(gbar);
#endif
    STOPAT(6)
    if (PSEL(4)) gemm_phase<EPI_RES>(p, l, (const bf16_t*)(p.ws + OFF_UBF), DFF, (const bf16_t*)(p.ws + OFF_WT2) + (size_t)l * 1024 * DFF, DFF, DFF, 8, 5, lds, 1.f, 1);
    gsync(gbar);
#if PROBE_DG
    gemm_phase<EPI_RES>(p, l, (const bf16_t*)(p.ws + OFF_UBF), DFF, (const bf16_t*)(p.ws + OFF_WT2) + (size_t)l * 1024 * DFF, DFF, DFF, 8, 5, lds, 0.f);
    gsync(gbar);
#endif
    STOPAT(7)
  }
}

#ifndef MULTI_LAUNCH
#define MULTI_LAUNCH 0
#endif
__global__ void __launch_bounds__(256, 2) phase_kernel(Params p, int phase, int l) {
  __shared__ __attribute__((aligned(16))) char lds[LDS_BYTES];
  __shared__ int s_item;
  const bf16_t* hbf = (const bf16_t*)(p.ws + OFF_HBF);
  switch (phase) {
    case 0: phase0(p, lds, &s_item); break;
    case 1: norm_phase(p, l, 0); break;
    case 2: gemm_phase<EPI_IN>(p, l, hbf, 1024, (const bf16_t*)(p.ws + OFF_WTIN) + (size_t)l * 2048 * 1024, 1024, 1024, 16, 0, lds); break;
    case 3: mixer_phase(p, l, 0, lds, &s_item); break;
    case 8: mixer_phase(p, l, 1, lds, &s_item); break;
    case 4: gemm_phase<EPI_RES>(p, l, (const bf16_t*)(p.ws + OFF_MIX), 1024, (const bf16_t*)(p.ws + OFF_WTOUT) + (size_t)l * 1024 * 1024, 1024, 1024, 8, 2, lds); break;
    case 5: norm_phase(p, l, 1); break;
    case 6: gemm_phase<EPI_FFN>(p, l, hbf, 1024, (const bf16_t*)(p.ws + OFF_WT13) + (size_t)l * 5632 * 1024, 1024, 1024, 44, 0, lds); break;
    default: gemm_phase<EPI_RES>(p, l, (const bf16_t*)(p.ws + OFF_UBF), DFF, (const bf16_t*)(p.ws + OFF_WT2) + (size_t)l * 1024 * DFF, DFF, DFF, 8, 5, lds); break;
  }
}

extern "C" void kernel_launch(void* const* d_in, const int* in_sizes, int n_in, void* d_out, int out_size, void* d_ws, size_t ws_size,
                              hipStream_t stream) {
  static int grid_blocks = 0;
  if (!grid_blocks) {
    int dev = 0, cus = 0, per_cu = 0;
    hipGetDevice(&dev);
    hipDeviceGetAttribute(&cus, hipDeviceAttributeMultiprocessorCount, dev);
    hipOccupancyMaxActiveBlocksPerMultiprocessor(&per_cu, fwd_megakernel, 256, 0);
    if (per_cu > 2) per_cu = 2;
    if (per_cu < 1) per_cu = 1;
    grid_blocks = cus * per_cu;
  }
  Params p{};
  for (int i = 0; i < 31; ++i) p.in[i] = (const float*)d_in[i];
  p.out = (float*)d_out;
  p.ws = (char*)d_ws;
  (void)hipMemsetAsync((char*)d_ws + OFF_CTR, 0, CTL_BYTES, stream);
#if MULTI_LAUNCH
  hipLaunchKernelGGL(phase_kernel, dim3(512), dim3(256), 0, stream, p, 0, 0);
  for (int l = 0; l < 4; ++l)
    for (int ph = 1; ph <= 7; ++ph) hipLaunchKernelGGL(phase_kernel, dim3(512), dim3(256), 0, stream, p, ph, l);
  return;
#endif
  void* args[] = {&p};
  hipError_t e = hipLaunchCooperativeKernel((void*)fwd_megakernel, dim3(grid_blocks), dim3(256), args, 0, stream);
  if (e != hipSuccess) fprintf(stderr, "cooperative launch failed: %s (grid %d)\n", hipGetErrorString(e), grid_blocks);
}
```

```cpp
#include <hip/hip_runtime.h>
#include <hip/hip_cooperative_groups.h>
#include <stdint.h>
#include <cstdio>
namespace cg = cooperative_groups;

typedef __attribute__((ext_vector_type(8))) short bf16x8;
typedef __attribute__((ext_vector_type(16))) float f32x16;
typedef unsigned short bf16_t;
#define DI __device__ __forceinline__
#define MFMA32(a, b, c) __builtin_amdgcn_mfma_f32_32x32x16_bf16((a), (b), (c), 0, 0, 0)

#define NTOK 10240
#define NPROMPT 8192
#define DM 1024
#define DFF 2816
#define OUT_NK 10485760
#define OUT_NV 14680064
#define OUT_ST 18874368

constexpr size_t OFF_WTIN   = 0;
constexpr size_t OFF_WTOUT  = OFF_WTIN + 16777216;
constexpr size_t OFF_WT13   = OFF_WTOUT + 8388608;
constexpr size_t OFF_WT2    = OFF_WT13 + 46137344;
constexpr size_t OFF_MOD    = OFF_WT2 + 23068672;
constexpr size_t OFF_TAP256 = OFF_MOD + 294912;
constexpr size_t OFF_TAP1024 = OFF_TAP256 + 4194304;
constexpr size_t OFF_KCAT   = OFF_TAP1024 + 16777216;
constexpr size_t OFF_VTL    = OFF_KCAT + 2621440;
constexpr size_t OFF_HBF    = OFF_VTL + 2621440;
constexpr size_t OFF_QBF    = OFF_HBF + 20971520;
constexpr size_t OFF_KBF    = OFF_QBF + 10485760;
constexpr size_t OFF_VTP    = OFF_KBF + 2097152;
constexpr size_t OFF_PBUF   = OFF_VTP + 2097152;
constexpr size_t OFF_MIX    = OFF_PBUF + 52428800;
constexpr size_t OFF_UBF    = OFF_MIX + 20971520;
constexpr size_t OFF_ZBUF   = OFF_UBF + 57671680;
constexpr size_t OFF_CTR    = OFF_ZBUF + 10485760;
constexpr size_t OFF_PHY    = OFF_CTR + 16384;
constexpr size_t WS_TOTAL   = OFF_PHY + (size_t)64 * 10240 * 12 * 4;

struct Params {
  const float* in[31];
  float* out;
  char* ws;
};

#define LDS_BYTES 73728
#define LROW 144
#define LTILE (128 * 144)
#define LBUF (2 * LTILE)

DI bf16_t f2bf(float x) { unsigned u = __float_as_uint(x); u += 0x7fffu + ((u >> 16) & 1u); return (bf16_t)(u >> 16); }
DI unsigned pack2(float a, float b) { return (unsigned)f2bf(a) | ((unsigned)f2bf(b) << 16); }
DI size_t blk(int m, int k, int KTF) { return ((size_t)((m >> 7) * KTF + (k >> 6)) * 128 + (m & 127)) * 64 + (k & 63); }
DI int otid() { int t = threadIdx.x; asm volatile("" : "+v"(t)); return t; }
DI void sync_g() { asm volatile("s_waitcnt vmcnt(0)" ::: "memory"); __syncthreads(); }
#define CW_CNT(j) (64 * (1 + (j)))
#define CW_SUB(j) (64 * (17 + (j)))
#define CW_TOP (64 * 33)
#define CW_GEN (64 * 34)
#define CW_XGEN(j) (64 * (35 + (j)))
#define CTL_BYTES 16384
struct GBar { unsigned* w; unsigned x, nloc, nx, epoch; };
DI unsigned gb_ld(unsigned* p) { return __hip_atomic_load(p, __ATOMIC_RELAXED, __HIP_MEMORY_SCOPE_AGENT); }
DI unsigned gb_add(unsigned* p, unsigned v) { return __hip_atomic_fetch_add(p, v, __ATOMIC_RELAXED, __HIP_MEMORY_SCOPE_AGENT); }
DI void gsync1(GBar& g) {
  asm volatile("s_waitcnt vmcnt(0)" ::: "memory");
  __syncthreads();
  if (threadIdx.x == 0) {
    g.epoch++;
    const unsigned old = gb_add(&g.w[CW_SUB(g.x)], 1u);
    if (old + 1u == g.epoch * g.nloc) {
      __builtin_amdgcn_fence(__ATOMIC_RELEASE, "agent");
      asm volatile("s_waitcnt vmcnt(0)" ::: "memory");
      const unsigned old2 = gb_add(&g.w[CW_TOP], 1u);
      if (old2 + 1u == g.epoch * g.nx) (void)gb_add(&g.w[CW_GEN], 1u);
    }
    while (gb_ld(&g.w[CW_GEN]) < g.epoch) __builtin_amdgcn_s_sleep(1);
    __builtin_amdgcn_fence(__ATOMIC_ACQUIRE, "agent");
    asm volatile("s_waitcnt vmcnt(0)" ::: "memory");
  }
  __syncthreads();
}
DI float fast_sigmoid(float x) { return __builtin_amdgcn_rcpf(1.f + __expf(-x)); }
DI float sigmoidf_(float x) { return 1.f / (1.f + __expf(-x)); }

DI void p0_transpose(const float* __restrict__ src, int K, int N, int kt, int nt, bf16_t* __restrict__ dst, int mode) {
  const int tid = otid();
  const int n = tid & 63, c = nt * 64 + n, k0 = kt * 128 + (tid >> 6) * 32;
  float v[32];
#pragma unroll
  for (int j = 0; j < 32; ++j) v[j] = src[(size_t)(k0 + j) * N + c];
  int nrow;
  if (mode == 0) nrow = c;
  else nrow = nt * 128 + (n >> 5) * 64 + (mode - 1) * 32 + (n & 31);
  uint4* d = (uint4*)(dst + blk(nrow, k0, K >> 6));
#pragma unroll
  for (int q = 0; q < 4; ++q)
    d[q] = make_uint4(pack2(v[8 * q], v[8 * q + 1]), pack2(v[8 * q + 2], v[8 * q + 3]), pack2(v[8 * q + 4], v[8 * q + 5]), pack2(v[8 * q + 6], v[8 * q + 7]));
}

DI void p0_mod(const Params& p, int l, int cc, float* lds) {
  const int tid = otid();
  float* s = lds;
  float* red = lds + 3072;
  for (int idx = tid; idx < 3072; idx += 256) {
    int ci = idx >> 10, k = idx & 1023;
    float v = (ci == 0) ? p.in[6][k] : p.in[5][(ci - 1) * 1024 + k];
    s[idx] = v / (1.f + expf(-v));
  }
  __syncthreads();
  const int col = tid & 63, kg = tid >> 6;
  const float* W = p.in[7] + (size_t)l * 1024 * 6144 + cc * 64 + col;
  float a0 = 0.f, a1 = 0.f, a2 = 0.f;
#pragma unroll 16
  for (int k = kg * 256; k < kg * 256 + 256; ++k) {
    float w = W[(size_t)k * 6144];
    a0 += s[k] * w; a1 += s[1024 + k] * w; a2 += s[2048 + k] * w;
  }
  red[(kg * 3 + 0) * 64 + col] = a0; red[(kg * 3 + 1) * 64 + col] = a1; red[(kg * 3 + 2) * 64 + col] = a2;
  __syncthreads();
  if (tid < 192) {
    int ci = tid >> 6, c = tid & 63;
    float v = red[(0 * 3 + ci) * 64 + c] + red[(1 * 3 + ci) * 64 + c] + red[(2 * 3 + ci) * 64 + c] + red[(3 * 3 + ci) * 64 + c];
    v += p.in[8][l * 6144 + cc * 64 + c];
    float* mod = (float*)(p.ws + OFF_MOD);
    mod[(l * 3 + ci) * 6144 + cc * 64 + c] = v;
  }
  __syncthreads();
}

DI void p0_taps(const Params& p, int l, int g, float* lds) {
  const int tid = otid();
  float* zf = lds;
  float* h1 = lds + 320;
  float* h2 = lds + 832;
  const int tt0 = g * 8;
  const int L = (tt0 < 256) ? 256 : 1024;
  const int tbase = (tt0 < 256) ? tt0 : tt0 - 256;
  const float invL = 1.f / (float)L;
  for (int idx = tid; idx < 264; idx += 256) {
    int ti = idx / 33, f = idx % 33;
    float t = (float)(tbase + ti);
    float v;
    if (f == 0) v = t * invL;
    else {
      int bi = (f - 1) & 15;
      float band = 1e-4f + (float)bi * ((15.f - 1e-4f) / 15.f);
      float ph = t * band * invL;
      ph -= floorf(ph);
      float ang = 6.283185307179586f * ph;
      v = (f <= 16) ? cosf(ang) : -sinf(ang);
    }
    zf[ti * 40 + f] = v;
  }
  __syncthreads();
  const float* w1 = p.in[20] + l * 33 * 64;
  const float* b1 = p.in[21] + l * 64;
  const float* w2 = p.in[22] + l * 64 * 64;
  const float* b2 = p.in[23] + l * 64;
  const float* w3 = p.in[24] + (size_t)l * 64 * 1024;
  const float* b3 = p.in[25] + l * 1024;
  for (int idx = tid; idx < 512; idx += 256) {
    int ti = idx >> 6, j = idx & 63;
    float a = b1[j];
#pragma unroll 11
    for (int f = 0; f < 33; ++f) a += zf[ti * 40 + f] * w1[f * 64 + j];
    h1[ti * 64 + j] = sinf(a);
  }
  __syncthreads();
  for (int idx = tid; idx < 512; idx += 256) {
    int ti = idx >> 6, j = idx & 63;
    float a = b2[j];
#pragma unroll 16
    for (int f = 0; f < 64; ++f) a += h1[ti * 64 + f] * w2[f * 64 + j];
    h2[ti * 64 + j] = sinf(a);
  }
  __syncthreads();
  float acc[4][8];
#pragma unroll
  for (int q = 0; q < 4; ++q)
#pragma unroll
    for (int ti = 0; ti < 8; ++ti) acc[q][ti] = 0.f;
#pragma unroll 8
  for (int i = 0; i < 64; ++i) {
    float w[4];
#pragma unroll
    for (int q = 0; q < 4; ++q) w[q] = w3[i * 1024 + q * 256 + tid];
#pragma unroll
    for (int ti = 0; ti < 8; ++ti) {
      float hv = h2[ti * 64 + i];
#pragma unroll
      for (int q = 0; q < 4; ++q) acc[q][ti] += hv * w[q];
    }
  }
  const int ch = tid;
  const float d0 = -3.0701134573253945f, d1 = -15.350567286626973f;
  const float delta = d0 + (float)ch * ((d1 - d0) / 255.f);
  bf16_t* tapbase = (L == 256) ? (bf16_t*)(p.ws + OFF_TAP256) + (size_t)l * 2 * 256 * 512
                               : (bf16_t*)(p.ws + OFF_TAP1024) + (size_t)l * 2 * 256 * 2048;
#pragma unroll
  for (int q = 0; q < 4; ++q) {
    const int order = q >> 1, side = q & 1;
    const float bb = b3[q * 256 + ch];
#pragma unroll
    for (int ti = 0; ti < 8; ++ti) {
      int t = tbase + ti;
      float tn = (float)t * invL;
      float val = (acc[q][ti] + bb) * expf(tn * delta);
      int x;
      if (side == 0) x = L + t;
      else { if (t == 0) { x = 0; val = 0.f; } else x = L - t; }
      tapbase[((size_t)order * 256 + ch) * 2 * L + (2 * L - 1 - x)] = f2bf(val);
    }
  }
  __syncthreads();
}

DI int kf_off(int key, int d) { return ((((key >> 5) * 4 + (d >> 4)) * 64 + ((d >> 3) & 1) * 32 + (key & 31)) << 3) + (d & 7); }
DI int vf_off(int key, int d) { return (((((key >> 5) * 2 + ((key >> 4) & 1)) * 2 + (d >> 5)) * 64 + ((key >> 2) & 1) * 32 + (d & 31)) << 3) + (key & 3) + 4 * ((key >> 3) & 1); }
DI void p0_cache(const Params& p, int it) {
  const int tid = otid();
  bf16_t* kcat = (bf16_t*)(p.ws + OFF_KCAT);
  bf16_t* vtl = (bf16_t*)(p.ws + OFF_VTL);
  for (int e = tid; e < 4096; e += 256) {
    int rr = it * 32 + (e >> 7), c = e & 127;
    int s = rr & 255, bl = rr >> 8, l = bl & 3, b = bl >> 2;
    float kv = p.in[2][(size_t)rr * 128 + c];
    float vv = p.in[3][(size_t)rr * 128 + c];
    const int kvh = c >> 6, d = c & 63;
    const size_t sb = (size_t)((l * 2 + b) * 2 + kvh) * (1280 * 64);
    kcat[sb + kf_off(s, d)] = f2bf(kv);
    vtl[sb + vf_off(s, d)] = f2bf(vv);
  }
}

DI void phase0(const Params& p, char* lds, int* s_item) {
  const int NTAP = 640, NMOD = 384, NCACHE = 64, NTR = 5760;
  const int total = NTAP + NMOD + NCACHE + NTR;
  int* ctr = (int*)(p.ws + OFF_CTR) + 16;
  const int tid = otid();
  for (;;) {
    if (tid == 0) *s_item = atomicAdd(ctr, 1);
    __syncthreads();
    const int it = *s_item;
    __syncthreads();
    if (it >= total) break;
    int r = it;
    if (r < NTAP) { p0_taps(p, r / 160, r % 160, (float*)lds); continue; }
    r -= NTAP;
    if (r < NMOD) { p0_mod(p, r / 96, r % 96, (float*)lds); continue; }
    r -= NMOD;
    if (r < NCACHE) { p0_cache(p, r); continue; }
    r -= NCACHE;
    int l = r / 1440; r %= 1440;
    if (r < 256) p0_transpose(p.in[11] + (size_t)l * 1024 * 2048, 1024, 2048, r / 32, r % 32, (bf16_t*)(p.ws + OFF_WTIN) + (size_t)l * 2048 * 1024, 0);
    else if (r < 384) { r -= 256; p0_transpose(p.in[27] + (size_t)l * 1024 * 1024, 1024, 1024, r / 16, r % 16, (bf16_t*)(p.ws + OFF_WTOUT) + (size_t)l * 1024 * 1024, 0); }
    else if (r < 736) { r -= 384; p0_transpose(p.in[28] + (size_t)l * 1024 * 2816, 1024, 2816, r / 44, r % 44, (bf16_t*)(p.ws + OFF_WT13) + (size_t)l * 5632 * 1024, 1); }
    else if (r < 1088) { r -= 736; p0_transpose(p.in[29] + (size_t)l * 1024 * 2816, 1024, 2816, r / 44, r % 44, (bf16_t*)(p.ws + OFF_WT13) + (size_t)l * 5632 * 1024, 2); }
    else { r -= 1088; p0_transpose(p.in[30] + (size_t)l * 2816 * 1024, 2816, 1024, r / 16, r % 16, (bf16_t*)(p.ws + OFF_WT2) + (size_t)l * 1024 * 2816, 0); }
  }
}

DI void norm_phase(const Params& p, int l, int which) {
  float* xbuf = p.out;
  bf16_t* hbf = (bf16_t*)(p.ws + OFF_HBF);
  const float* mod = (const float*)(p.ws + OFF_MOD);
  const float* nw = p.in[which ? 10 : 9] + l * 1024;
  const int tid_ = otid(); const int wave = tid_ >> 6, lane = tid_ & 63;
  const bool first = (l == 0 && which == 0);
  constexpr int RB = 5;
  const int nwaves = gridDim.x * 4;
  for (int row0 = blockIdx.x * 4 + wave; row0 < NTOK; row0 += nwaves * RB) {
    float4 v[RB][4];
#pragma unroll
    for (int j = 0; j < RB; ++j) {
      const int row = row0 + j * nwaves;
      if (row < NTOK) {
        const float* src;
        if (first) src = (row < NPROMPT) ? p.in[0] + (size_t)row * 1024 : p.in[1] + (size_t)(row - NPROMPT) * 1024;
        else src = xbuf + (size_t)row * 1024;
#pragma unroll
        for (int i = 0; i < 4; ++i) v[j][i] = *(const float4*)(src + i * 256 + lane * 4);
      } else {
#pragma unroll
        for (int i = 0; i < 4; ++i) v[j][i] = make_float4(0.f, 0.f, 0.f, 0.f);
      }
    }
#pragma unroll
    for (int j = 0; j < RB; ++j) {
      const int row = row0 + j * nwaves;
      if (row >= NTOK) break;
      float ss = 0.f;
#pragma unroll
      for (int i = 0; i < 4; ++i) ss += v[j][i].x * v[j][i].x + v[j][i].y * v[j][i].y + v[j][i].z * v[j][i].z + v[j][i].w * v[j][i].w;
#pragma unroll
      for (int o = 32; o >= 1; o >>= 1) ss += __shfl_xor(ss, o);
      const float rstd = rsqrtf(ss * (1.f / 1024.f) + 1e-6f);
      const int ci = (row < NPROMPT) ? 0 : 1 + ((row - NPROMPT) >> 10);
      const float* sh = mod + ((l * 3 + ci) * 6 + (which ? 3 : 0)) * 1024;
      const float* sc = sh + 1024;
#pragma unroll
      for (int i = 0; i < 4; ++i) {
        const int col = i * 256 + lane * 4;
        const float4 w4 = *(const float4*)(nw + col), s4 = *(const float4*)(sc + col), h4 = *(const float4*)(sh + col);
        const float y0 = v[j][i].x * rstd * w4.x * (1.f + s4.x) + h4.x;
        const float y1 = v[j][i].y * rstd * w4.y * (1.f + s4.y) + h4.y;
        const float y2 = v[j][i].z * rstd * w4.z * (1.f + s4.z) + h4.z;
        const float y3 = v[j][i].w * rstd * w4.w * (1.f + s4.w) + h4.w;
        *(uint2*)(hbf + blk(row, col, 16)) = make_uint2(pack2(y0, y1), pack2(y2, y3));
        if (first) *(float4*)(xbuf + (size_t)row * 1024 + col) = v[j][i];
      }
    }
  }
}

enum { EPI_IN = 0, EPI_RES = 1, EPI_FFN = 2 };

DI void epi_in(const Params& p, int l, int m0, int nt, const f32x16 (&acc)[2][2], char* lds) {
  const int tid = otid(), lane = tid & 63, wave = tid >> 6;
  const int wm = wave >> 1, wn = wave & 1, r = lane & 31, h = lane >> 5;
  float* Ct = (float*)lds;
#pragma unroll
  for (int i = 0; i < 2; ++i)
#pragma unroll
    for (int j = 0; j < 2; ++j)
#pragma unroll
      for (int reg = 0; reg < 16; ++reg) {
        int row = wm * 64 + i * 32 + (reg & 3) + 8 * (reg >> 2) + 4 * h;
        int col = wn * 64 + j * 32 + r;
        Ct[row * 132 + col] = acc[i][j][reg];
      }
  __syncthreads();
  const bool lat = (m0 >= NPROMPT);
  if (nt < 5) {
    const int row = tid >> 1, hh = tid & 1;
    float* src = Ct + row * 132 + hh * 64;
    float ss = 0.f;
#pragma unroll
    for (int d = 0; d < 64; d += 4) {
      float4 t = *(const float4*)(src + d);
      ss += t.x * t.x + t.y * t.y + t.z * t.z + t.w * t.w;
    }
    const float rstd = rsqrtf(ss * (1.f / 64.f) + 1e-6f);
    const float* nw = (nt < 4 ? p.in[12] : p.in[13]) + l * 64;
    const float osc = (nt < 4) ? 0.125f : 1.f;
    const int m = m0 + row;
    int pos = 0;
    if (lat) {
      pos = (m - NPROMPT) & 1023;
      const float pr = (float)(pos >> 6), pc = (float)(pos & 63);
#pragma unroll 1
      for (int d = 0; d < 16; ++d) {
        const float f = exp2f(-(float)d * 0.8304820237218406f);
        const float ar = pr * f, ac = pc * f;
        const float sr = __sinf(ar), cr = __cosf(ar), sc_ = __sinf(ac), cc_ = __cosf(ac);
        float x1 = src[d] * rstd * nw[d], x2 = src[d + 16] * rstd * nw[d + 16];
        src[d] = (x1 * cr - x2 * sr) * osc; src[d + 16] = (x2 * cr + x1 * sr) * osc;
        x1 = src[32 + d] * rstd * nw[32 + d]; x2 = src[48 + d] * rstd * nw[48 + d];
        src[32 + d] = (x1 * cc_ - x2 * sc_) * osc; src[48 + d] = (x2 * cc_ + x1 * sc_) * osc;
      }
    } else {
#pragma unroll
      for (int d = 0; d < 64; d += 4) {
        float4 t = *(const float4*)(src + d);
        float4 w = *(const float4*)(nw + d);
        t.x *= rstd * w.x * osc; t.y *= rstd * w.y * osc; t.z *= rstd * w.z * osc; t.w *= rstd * w.w * osc;
        *(float4*)(src + d) = t;
      }
    }
    if (nt < 4) {
      bf16_t* dst = (bf16_t*)(p.ws + OFF_QBF) + (size_t)m * 512 + (nt * 2 + hh) * 64;
#pragma unroll
      for (int d = 0; d < 64; d += 8) {
        float4 t0 = *(const float4*)(src + d), t1 = *(const float4*)(src + d + 4);
        *(uint4*)(dst + d) = make_uint4(pack2(t0.x, t0.y), pack2(t0.z, t0.w), pack2(t1.x, t1.y), pack2(t1.z, t1.w));
      }
    } else {
      bf16_t* dst;
      int key;
      if (!lat) {
        const int b = m >> 8, s = m & 255;
        float* nk = p.out + OUT_NK + ((size_t)((b * 4 + l) * 256 + s)) * 128 + hh * 64;
#pragma unroll
        for (int d = 0; d < 64; d += 4) *(float4*)(nk + d) = *(const float4*)(src + d);
        dst = (bf16_t*)(p.ws + OFF_KBF) + (size_t)(b * 2 + hh) * (256 * 64);
        key = s;
      } else {
        const int b2 = (m - NPROMPT) >> 10;
        dst = (bf16_t*)(p.ws + OFF_KCAT) + (size_t)((l * 2 + b2) * 2 + hh) * (1280 * 64);
        key = 256 + pos;
      }
#pragma unroll
      for (int d = 0; d < 64; d += 8) {
        float4 t0 = *(const float4*)(src + d), t1 = *(const float4*)(src + d + 4);
        *(uint4*)(dst + kf_off(key, d)) = make_uint4(pack2(t0.x, t0.y), pack2(t0.z, t0.w), pack2(t1.x, t1.y), pack2(t1.z, t1.w));
      }
    }
  } else if (nt == 5) {
    if (!lat) {
      const int row = tid >> 1, hf = tid & 1;
      const int m = m0 + row, b = m >> 8, s = m & 255;
      float* nv = p.out + OUT_NV + ((size_t)((b * 4 + l) * 256 + s)) * 128 + hf * 64;
      const float* src = Ct + row * 132 + hf * 64;
#pragma unroll
      for (int d = 0; d < 64; d += 4) *(float4*)(nv + d) = *(const float4*)(src + d);
    }
    {
      const int col = tid & 127, rh = tid >> 7;
      const int kvh = col >> 6, d = col & 63;
      bf16_t* dst;
      int kstart;
      if (!lat) {
        const int b = m0 >> 8, s0 = m0 & 255;
        dst = (bf16_t*)(p.ws + OFF_VTP) + (size_t)(b * 2 + kvh) * (256 * 64);
        kstart = s0 + rh * 64;
      } else {
        const int b2 = (m0 - NPROMPT) >> 10, s0 = (m0 - NPROMPT) & 1023;
        dst = (bf16_t*)(p.ws + OFF_VTL) + (size_t)((l * 2 + b2) * 2 + kvh) * (1280 * 64);
        kstart = 256 + s0 + rh * 64;
      }
      const float* src = Ct + (rh * 64) * 132 + col;
#pragma unroll
      for (int g = 0; g < 8; ++g) {
        const int kk0 = (g >> 2) * 32 + ((g >> 1) & 1) * 16 + (g & 1) * 4;
        *(uint4*)(dst + vf_off(kstart + kk0, d)) =
            make_uint4(pack2(src[(kk0 + 0) * 132], src[(kk0 + 1) * 132]), pack2(src[(kk0 + 2) * 132], src[(kk0 + 3) * 132]),
                       pack2(src[(kk0 + 8) * 132], src[(kk0 + 9) * 132]), pack2(src[(kk0 + 10) * 132], src[(kk0 + 11) * 132]));
      }
    }
  } else if (nt < 10) {
    const int row = tid >> 1, hf = tid & 1;
    float* dst = (float*)(p.ws + OFF_PBUF) + (size_t)(m0 + row) * 1280 + (nt * 128 - 768) + hf * 64;
    const float* src = Ct + row * 132 + hf * 64;
#pragma unroll
    for (int d = 0; d < 64; d += 4) *(float4*)(dst + d) = *(const float4*)(src + d);
  } else {
    const int row = tid >> 1, hf = tid & 1;
    const int sidx = (nt - 10) >> 1, cg0 = (((nt - 10) & 1) * 128 + hf * 64) >> 2;
    float* dst = (float*)(p.ws + OFF_PHY) + ((size_t)cg0 * NTOK + (m0 + row)) * 12 + sidx * 4;
    const float* src = Ct + row * 132 + hf * 64;
#pragma unroll
    for (int g = 0; g < 16; ++g) *(float4*)(dst + (size_t)g * NTOK * 12) = *(const float4*)(src + 4 * g);
  }
  __syncthreads();
}

template <int EPI>
DI void gemm_phase(const Params& p, int l, const bf16_t* A, int lda, const bf16_t* BT, int ldb, int K, int NT,
                           int modpart, char* lds, float gscale = 1.f, int KS = 1) {
  const int tid = otid(), lane = tid & 63, wave = tid >> 6;
  const int wm = wave >> 1, wn = wave & 1, r = lane & 31, h = lane >> 5;
  const int ntiles = 80 * NT * KS;
  const int KT = K / (64 * KS);
  const int woff = (tid >> 3) * LROW + (tid & 7) * 16;
  for (int t = blockIdx.x; t < ntiles; t += gridDim.x) {
    const int ks = t / (80 * NT), tt = t - ks * (80 * NT);
    const int mt = tt % 80, nt = tt / 80;
    const int m0 = mt * 128, n0 = nt * 128;
    f32x16 acc[2][2];
#pragma unroll
    for (int i = 0; i < 2; ++i)
#pragma unroll
      for (int j = 0; j < 2; ++j)
#pragma unroll
        for (int e = 0; e < 16; ++e) acc[i][j][e] = 0.f;
    const bf16_t* Ag = A + ((size_t)mt * (K >> 6) + ks * KT) * 8192 + tid * 8;
    const bf16_t* Bg = BT + ((size_t)nt * (K >> 6) + ks * KT) * 8192 + tid * 8;
    uint4 ra[2][4], rb[2][4];
#pragma unroll
    for (int i = 0; i < 4; ++i) {
      ra[0][i] = *(const uint4*)(Ag + i * 2048);
      rb[0][i] = *(const uint4*)(Bg + i * 2048);
    }
#pragma unroll
    for (int i = 0; i < 4; ++i) {
      *(uint4*)(lds + woff + i * 32 * LROW) = ra[0][i];
      *(uint4*)(lds + LTILE + woff + i * 32 * LROW) = rb[0][i];
    }
#pragma unroll
    for (int i = 0; i < 4; ++i) {
      asm volatile("global_load_dwordx4 %0, %1, off" : "=v"(ra[1][i]) : "v"(Ag + i * 2048 + 8192) : "memory");
      asm volatile("global_load_dwordx4 %0, %1, off" : "=v"(rb[1][i]) : "v"(Bg + i * 2048 + 8192) : "memory");
    }
    __syncthreads();
    for (int kt2 = 0; kt2 < KT; kt2 += 2) {
#pragma unroll
      for (int u = 0; u < 2; ++u) {
        const int kt = kt2 + u;
        const char* cur = lds + u * LBUF;
        char* nxt = lds + (u ^ 1) * LBUF;
        const int kn = (kt + 2 < KT) ? kt + 2 : KT - 1;
        asm volatile("s_waitcnt vmcnt(0)" ::: "memory");
#pragma unroll
        for (int i = 0; i < 4; ++i) {
          asm volatile("global_load_dwordx4 %0, %1, off" : "=v"(ra[u][i]) : "v"(Ag + i * 2048 + (size_t)kn * 8192) : "memory");
          asm volatile("global_load_dwordx4 %0, %1, off" : "=v"(rb[u][i]) : "v"(Bg + i * 2048 + (size_t)kn * 8192) : "memory");
        }
        __builtin_amdgcn_s_setprio(1);
#pragma unroll
        for (int st = 0; st < 4; ++st) {
          bf16x8 a0 = *(const bf16x8*)(cur + (wm * 64 + r) * LROW + st * 32 + h * 16);
          bf16x8 a1 = *(const bf16x8*)(cur + (wm * 64 + 32 + r) * LROW + st * 32 + h * 16);
          bf16x8 b0 = *(const bf16x8*)(cur + LTILE + (wn * 64 + r) * LROW + st * 32 + h * 16);
          bf16x8 b1 = *(const bf16x8*)(cur + LTILE + (wn * 64 + 32 + r) * LROW + st * 32 + h * 16);
          acc[0][0] = MFMA32(a0, b0, acc[0][0]);
          acc[0][1] = MFMA32(a0, b1, acc[0][1]);
          acc[1][0] = MFMA32(a1, b0, acc[1][0]);
          acc[1][1] = MFMA32(a1, b1, acc[1][1]);
          *(uint4*)(nxt + woff + st * 32 * LROW) = ra[u ^ 1][st];
          *(uint4*)(nxt + LTILE + woff + st * 32 * LROW) = rb[u ^ 1][st];
        }
        __builtin_amdgcn_s_setprio(0);
        __syncthreads();
      }
    }
    asm volatile("s_waitcnt vmcnt(0)" ::: "memory");
#pragma unroll
    for (int i = 0; i < 4; ++i) {
      typedef unsigned u32x4_t __attribute__((ext_vector_type(4)));
      const u32x4_t t0 = {ra[0][i].x, ra[0][i].y, ra[0][i].z, ra[0][i].w}, t1 = {rb[0][i].x, rb[0][i].y, rb[0][i].z, rb[0][i].w};
      const u32x4_t t2 = {ra[1][i].x, ra[1][i].y, ra[1][i].z, ra[1][i].w}, t3 = {rb[1][i].x, rb[1][i].y, rb[1][i].z, rb[1][i].w};
      asm volatile("" :: "v"(t0), "v"(t1), "v"(t2), "v"(t3));
    }
    if (EPI == EPI_IN) {
      epi_in(p, l, m0, nt, acc, lds);
    } else if (EPI == EPI_RES) {
      const int ci = (m0 < NPROMPT) ? 0 : 1 + ((m0 - NPROMPT) >> 10);
      const float* gate = (const float*)(p.ws + OFF_MOD) + ((l * 3 + ci) * 6 + modpart) * 1024;
      float* xbuf = p.out;
      if (KS > 1) {
#pragma unroll
        for (int j = 0; j < 2; ++j) {
          const int n = n0 + wn * 64 + j * 32 + r;
          const float g = gate[n] * gscale;
#pragma unroll
          for (int i = 0; i < 2; ++i)
#pragma unroll
            for (int reg = 0; reg < 16; ++reg) {
              const int m = m0 + wm * 64 + i * 32 + (reg & 3) + 8 * (reg >> 2) + 4 * h;
              (void)__hip_atomic_fetch_add(xbuf + (size_t)m * 1024 + n, g * acc[i][j][reg], __ATOMIC_RELAXED, __HIP_MEMORY_SCOPE_AGENT);
            }
        }
      } else {
        float* Ct = (float*)lds;
#pragma unroll
        for (int i = 0; i < 2; ++i)
#pragma unroll
          for (int j = 0; j < 2; ++j)
#pragma unroll
            for (int reg = 0; reg < 16; ++reg)
              Ct[(wm * 64 + i * 32 + (reg & 3) + 8 * (reg >> 2) + 4 * h) * 132 + wn * 64 + j * 32 + r] = acc[i][j][reg];
        __syncthreads();
#pragma unroll
        for (int i = 0; i < 16; ++i) {
          const int c = tid + 256 * i, row = c >> 5, c4 = (c & 31) * 4;
          const float4 a = *(const float4*)(Ct + row * 132 + c4);
          const float4 g = *(const float4*)(gate + n0 + c4);
          float4* xp = (float4*)(xbuf + (size_t)(m0 + row) * 1024 + n0 + c4);
          float4 xv = *xp;
          xv.x += gscale * g.x * a.x; xv.y += gscale * g.y * a.y; xv.z += gscale * g.z * a.z; xv.w += gscale * g.w * a.w;
          *xp = xv;
        }
        __syncthreads();
      }
    } else {
      bf16_t* st = (bf16_t*)lds + (wm * 64 + 4 * h) * 72 + wn * 32 + r;
#pragma unroll
      for (int i = 0; i < 2; ++i)
#pragma unroll
        for (int reg = 0; reg < 16; ++reg) {
          const float a = acc[i][0][reg], b = acc[i][1][reg];
          st[(i * 32 + (reg & 3) + 8 * (reg >> 2)) * 72] = f2bf(a * fast_sigmoid(a) * b);
        }
      __syncthreads();
      {
        bf16_t* ub = (bf16_t*)(p.ws + OFF_UBF) + ((size_t)mt * 44 + nt) * 8192;
#pragma unroll
        for (int i = 0; i < 4; ++i) {
          const int c = tid + 256 * i;
          *(uint4*)(ub + c * 8) = *(const uint4*)((const bf16_t*)lds + (c >> 3) * 72 + (c & 7) * 8);
        }
      }
      __syncthreads();
    }
  }
}

DI void attn_wave(const bf16_t* __restrict__ q, const bf16_t* __restrict__ kp, const bf16_t* __restrict__ vt, int nkeys, bf16_t* __restrict__ mixb, int qtok, int head) {
  const int lane = otid() & 63, r = lane & 31, h = lane >> 5;
  bf16x8 qf[4];
#pragma unroll
  for (int st = 0; st < 4; ++st) qf[st] = *(const bf16x8*)(q + (size_t)r * 512 + st * 16 + h * 8);
  f32x16 O[2];
#pragma unroll
  for (int e = 0; e < 16; ++e) { O[0][e] = 0.f; O[1][e] = 0.f; }
  float m = -1e30f, lsum = 0.f;
  bf16x8 kfr[2][4];
#pragma unroll
  for (int sub = 0; sub < 2; ++sub)
#pragma unroll
    for (int st = 0; st < 4; ++st) kfr[sub][st] = *(const bf16x8*)(kp + (size_t)(((sub * 4 + st) * 64 + lane) << 3));
  for (int k0 = 0; k0 < nkeys; k0 += 64) {
    f32x16 S[2];
#pragma unroll
    for (int sub = 0; sub < 2; ++sub) {
#pragma unroll
      for (int e = 0; e < 16; ++e) S[sub][e] = 0.f;
#pragma unroll
      for (int st = 0; st < 4; ++st) S[sub] = MFMA32(kfr[sub][st], qf[st], S[sub]);
    }
    {
      const int kn = (k0 + 64 < nkeys) ? k0 + 64 : k0;
#pragma unroll
      for (int sub = 0; sub < 2; ++sub)
#pragma unroll
        for (int st = 0; st < 4; ++st) kfr[sub][st] = *(const bf16x8*)(kp + (size_t)(((((kn >> 5) + sub) * 4 + st) * 64 + lane) << 3));
    }
    bf16x8 vfr[2][2][2];
#pragma unroll
    for (int sub = 0; sub < 2; ++sub)
#pragma unroll
      for (int s2 = 0; s2 < 2; ++s2)
#pragma unroll
        for (int dt = 0; dt < 2; ++dt)
          vfr[sub][s2][dt] = *(const bf16x8*)(vt + (size_t)((((((k0 >> 5) + sub) * 2 + s2) * 2 + dt) * 64 + lane) << 3));
    float mx = m;
#pragma unroll
    for (int sub = 0; sub < 2; ++sub)
#pragma unroll
      for (int e = 0; e < 16; ++e) mx = fmaxf(mx, S[sub][e]);
    mx = fmaxf(mx, __shfl_xor(mx, 32));
    const float alpha = __expf(m - mx);
    m = mx;
    float ps = 0.f;
#pragma unroll
    for (int sub = 0; sub < 2; ++sub)
#pragma unroll
      for (int e = 0; e < 16; ++e) { float pv = __expf(S[sub][e] - mx); S[sub][e] = pv; ps += pv; }
    lsum = lsum * alpha + ps;
#pragma unroll
    for (int e = 0; e < 16; ++e) { O[0][e] *= alpha; O[1][e] *= alpha; }
#pragma unroll
    for (int sub = 0; sub < 2; ++sub)
#pragma unroll
      for (int s = 0; s < 2; ++s) {
        union { unsigned u[4]; bf16x8 v; } pf;
#pragma unroll
        for (int j = 0; j < 4; ++j) pf.u[j] = pack2(S[sub][8 * s + 2 * j], S[sub][8 * s + 2 * j + 1]);
#pragma unroll
        for (int dt = 0; dt < 2; ++dt) O[dt] = MFMA32(vfr[sub][s][dt], pf.v, O[dt]);
      }
  }
  lsum += __shfl_xor(lsum, 32);
  const float inv = 1.f / lsum;
  bf16_t* ob = mixb + ((size_t)(qtok >> 7) * 16 + head) * 8192 + ((qtok & 127) + r) * 64;
#pragma unroll
  for (int dt = 0; dt < 2; ++dt)
#pragma unroll
    for (int g = 0; g < 4; ++g) {
      const int d = dt * 32 + 8 * g + 4 * h;
      *(uint2*)(ob + d) = make_uint2(pack2(O[dt][4 * g] * inv, O[dt][4 * g + 1] * inv), pack2(O[dt][4 * g + 2] * inv, O[dt][4 * g + 3] * inv));
    }
}

DI float gelu_tanh(float x) { return 0.5f * x * (1.f + tanhf(0.7978845608028654f * (x + 0.044715f * x * x * x))); }

#ifndef PROBE_BAR
#define PROBE_BAR 0
#endif
DI void gsync(GBar& g) { gsync1(g); if (PROBE_BAR) { gsync1(g); gsync1(g); } }
DI float fast_gelu(float x) {
  const float u = 0.7978845608028654f * (x + 0.044715f * x * x * x);
  const float th = 1.f - 2.f * __builtin_amdgcn_rcpf(1.f + __expf(2.f * u));
  return 0.5f * x * (1.f + th);
}

DI void lru_gate_item(const Params& p, int l, int mt, int n, char* lds) {
  const int tid = otid(), lane = tid & 63, wave = tid >> 6, r = lane & 31, h = lane >> 5;
  float* XC = (float*)lds;
  bf16_t* Axc = (bf16_t*)(lds + 32768);
  const int m0 = mt * 128;
  const int L = (m0 < NPROMPT) ? 256 : 1024;
  const int tb = (m0 < NPROMPT) ? (m0 & 255) : ((m0 - NPROMPT) & 1023);
  const float* pbuf = (const float*)(p.ws + OFF_PBUF);
  float2* ab = (float2*)(p.ws + OFF_UBF);
  {
    const int ch = tid & 63, tq = tid >> 6, gch = n * 64 + ch;
    float cw[4];
#pragma unroll
    for (int k = 0; k < 4; ++k) cw[k] = p.in[14][(l * 4 + k) * 256 + gch];
    const float cb = p.in[15][l * 256 + gch];
    float x[35];
#pragma unroll
    for (int i = 0; i < 35; ++i) {
      const int ts = tb + tq * 32 + i - 2;
      x[i] = (ts >= 0 && ts < L) ? pbuf[(size_t)(m0 - tb + ts) * 1280 + gch] : 0.f;
    }
#pragma unroll
    for (int e = 0; e < 32; ++e) {
      const float xv = cb + cw[0] * x[e] + cw[1] * x[e + 1] + cw[2] * x[e + 2] + cw[3] * x[e + 3];
      XC[(tq * 32 + e) * 64 + ch] = xv;
      Axc[(tq * 32 + e) * 72 + ch] = f2bf(xv);
    }
  }
  __syncthreads();
  {
    const int dir = wave & 1, half = wave >> 1;
    bf16x8 wf[2][2][4];
    float gb[2][2], sp[2];
#pragma unroll
    for (int g = 0; g < 2; ++g) {
      const float* W = p.in[16] + ((size_t)((l * 2 + dir) * 2 + g) * 4 + n) * 4096;
#pragma unroll
      for (int ct = 0; ct < 2; ++ct) {
        const int j = r + 32 * ct;
        gb[g][ct] = p.in[17][((l * 2 + dir) * 2 + g) * 256 + n * 64 + j];
#pragma unroll
        for (int st = 0; st < 4; ++st) {
          const int i0 = 16 * st + 8 * h;
          union { unsigned u[4]; bf16x8 v; } f;
#pragma unroll
          for (int jj = 0; jj < 4; ++jj) f.u[jj] = pack2(W[(i0 + 2 * jj) * 64 + j], W[(i0 + 2 * jj + 1) * 64 + j]);
          wf[g][ct][st] = f.v;
        }
      }
    }
#pragma unroll
    for (int ct = 0; ct < 2; ++ct) sp[ct] = log1pf(expf(-p.in[18][(l * 2 + dir) * 256 + n * 64 + r + 32 * ct]));
#pragma unroll 1
    for (int rt = 0; rt < 2; ++rt) {
      f32x16 acc[2][2];
#pragma unroll
      for (int e = 0; e < 16; ++e) { acc[0][0][e] = 0.f; acc[0][1][e] = 0.f; acc[1][0][e] = 0.f; acc[1][1][e] = 0.f; }
#pragma unroll
      for (int st = 0; st < 4; ++st) {
        const bf16x8 af = *(const bf16x8*)(Axc + (half * 64 + rt * 32 + r) * 72 + 16 * st + 8 * h);
        acc[0][0] = MFMA32(af, wf[0][0][st], acc[0][0]);
        acc[0][1] = MFMA32(af, wf[0][1][st], acc[0][1]);
        acc[1][0] = MFMA32(af, wf[1][0][st], acc[1][0]);
        acc[1][1] = MFMA32(af, wf[1][1][st], acc[1][1]);
      }
#pragma unroll
      for (int ct = 0; ct < 2; ++ct)
#pragma unroll
        for (int reg = 0; reg < 16; ++reg) {
          const int tok = half * 64 + rt * 32 + (reg & 3) + 8 * (reg >> 2) + 4 * h;
          const int j = r + 32 * ct;
          const float rr = fast_sigmoid(acc[0][ct][reg] + gb[0][ct]);
          const float ii = fast_sigmoid(acc[1][ct][reg] + gb[1][ct]);
          const float xv = XC[tok * 64 + j];
          const float a = __expf(-8.f * rr * sp[ct]);
          const float bb = __builtin_sqrtf(fmaxf(fmaf(-a, a, 1.f), 0.f)) * (ii * xv);
          ab[((size_t)dir * NTOK + m0 + tok) * 256 + n * 64 + j] = make_float2(a, bb);
        }
    }
  }
  __syncthreads();
}

template <int CGS>
DI void lru_scan_item(const Params& p, int l, int bidx, int cbase, char* lds) {
  constexpr int NSEG = 256 / CGS;
  const int tid = otid();
  const bool lat = bidx >= 32;
  const int L = lat ? 1024 : 256;
  const int tok0 = lat ? NPROMPT + (bidx - 32) * 1024 : bidx * 256;
  const int ch = tid % CGS, sg = tid / CGS, gch = cbase + ch;
  const int SEGL = L / NSEG;
  float2* SEG = (float2*)lds;
  const float2* ab = (const float2*)(p.ws + OFF_UBF);
  float* hfbuf = (float*)(p.ws + OFF_UBF + 41943040);
  const float* pbuf = (const float*)(p.ws + OFF_PBUF);
  bf16_t* mix = (bf16_t*)(p.ws + OFF_MIX);
  const float2* abf = ab + ((size_t)0 * NTOK + tok0 + sg * SEGL) * 256 + gch;
  const float2* abb = ab + ((size_t)1 * NTOK + tok0 + sg * SEGL) * 256 + gch;
  {
    float A = 1.f, B = 0.f;
#pragma unroll 16
    for (int i = 0; i < SEGL; ++i) { const float2 v = abf[(size_t)i * 256]; B = v.x * B + v.y; A *= v.x; }
    SEG[(0 * NSEG + sg) * CGS + ch] = make_float2(A, B);
    A = 1.f; B = 0.f;
#pragma unroll 16
    for (int i = SEGL - 1; i >= 0; --i) { const float2 v = abb[(size_t)i * 256]; B = v.x * B + v.y; A *= v.x; }
    SEG[(1 * NSEG + sg) * CGS + ch] = make_float2(A, B);
  }
  __syncthreads();
  float hf = lat ? p.in[4][(((bidx - 32) * 4 + l) * 2 + 0) * 256 + gch] : 0.f;
  float hb = lat ? p.in[4][(((bidx - 32) * 4 + l) * 2 + 1) * 256 + gch] : 0.f;
  for (int q = 0; q < sg; ++q) { const float2 v = SEG[(0 * NSEG + q) * CGS + ch]; hf = v.x * hf + v.y; }
  for (int q = NSEG - 1; q > sg; --q) { const float2 v = SEG[(1 * NSEG + q) * CGS + ch]; hb = v.x * hb + v.y; }
  if (!lat) {
    if (sg == NSEG - 1) { const float2 v = SEG[(0 * NSEG + NSEG - 1) * CGS + ch]; p.out[OUT_ST + ((size_t)(bidx * 4 + l) * 2 + 0) * 256 + gch] = v.x * hf + v.y; }
    if (sg == 0) { const float2 v = SEG[(1 * NSEG + 0) * CGS + ch]; p.out[OUT_ST + ((size_t)(bidx * 4 + l) * 2 + 1) * 256 + gch] = v.x * hb + v.y; }
  }
  float* hfp = hfbuf + (size_t)(tok0 + sg * SEGL) * 256 + gch;
  for (int i0 = 0; i0 < SEGL; i0 += 16) {
    float2 v[16];
#pragma unroll
    for (int j = 0; j < 16; ++j) v[j] = abf[(size_t)(i0 + j) * 256];
#pragma unroll
    for (int j = 0; j < 16; ++j) { hf = v[j].x * hf + v[j].y; hfp[(size_t)(i0 + j) * 256] = hf; }
  }
  const float* lg = pbuf + (size_t)(tok0 + sg * SEGL) * 1280 + 256 + gch;
  bf16_t* mp = mix + blk(tok0 + sg * SEGL, 512 + gch, 16);
  for (int i0 = SEGL - 16; i0 >= 0; i0 -= 16) {
    float2 v[16];
    float gv[16], fv[16];
#pragma unroll
    for (int j = 0; j < 16; ++j) {
      v[j] = abb[(size_t)(i0 + j) * 256];
      gv[j] = lg[(size_t)(i0 + j) * 1280];
      fv[j] = hfp[(size_t)(i0 + j) * 256];
    }
#pragma unroll
    for (int j = 15; j >= 0; --j) {
      hb = v[j].x * hb + v[j].y;
      mp[(size_t)(i0 + j) * 64] = f2bf(fast_gelu(gv[j]) * (fv[j] + hb));
    }
  }
  __syncthreads();
}

DI bf16x8 ld16u(const bf16_t* p) { bf16x8 v; __builtin_memcpy(&v, p, 16); return v; }
typedef unsigned u32x4v __attribute__((ext_vector_type(4)));
DI bf16x8 ld16_shift(const bf16_t* p8, int ds2, int ds1, unsigned hb) {
  const u32x4v c0 = *(const u32x4v*)p8, c1 = *(const u32x4v*)(p8 + 8);
  unsigned t0 = ds2 ? c0[2] : c0[0], t1 = ds2 ? c0[3] : c0[1], t2 = ds2 ? c1[0] : c0[2], t3 = ds2 ? c1[1] : c0[3], t4 = ds2 ? c1[2] : c1[0], t5 = ds2 ? c1[3] : c1[1];
  unsigned u0 = ds1 ? t1 : t0, u1 = ds1 ? t2 : t1, u2 = ds1 ? t3 : t2, u3 = ds1 ? t4 : t3, u4 = ds1 ? t5 : t4;
  union { unsigned u[4]; bf16x8 v; } r;
  r.u[0] = __builtin_amdgcn_alignbyte(u1, u0, hb); r.u[1] = __builtin_amdgcn_alignbyte(u2, u1, hb);
  r.u[2] = __builtin_amdgcn_alignbyte(u3, u2, hb); r.u[3] = __builtin_amdgcn_alignbyte(u4, u3, hb);
  return r.v;
}
DI float bf2f(bf16_t v) { return __uint_as_float((unsigned)v << 16); }
DI float conv3_at(const float* __restrict__ pb, int t, int L, float w0, float w1, float w2) {
  float v = w1 * pb[(size_t)t * 1280];
  if (t > 0) v += w0 * pb[(size_t)(t - 1) * 1280];
  if (t < L - 1) v += w2 * pb[(size_t)(t + 1) * 1280];
  return v;
}

template <int L>
DI void hy_item(const Params& p, int l, int tokbase, int c0, char* lds) {
  constexpr int NB = L / 32, NQ = 32 / NB, PADLEN = (3 * NB - 2) * 32;
  const int tid = otid(), lane = tid & 63, wave = tid >> 6, h = lane >> 5;
  bf16_t* UP = (bf16_t*)lds;
  float* X1 = (float*)(lds + 24576);
  float* X2 = (float*)(lds + 24576 + 16384);
  const float* phy = (const float*)(p.ws + OFF_PHY) + (size_t)(c0 >> 2) * NTOK * 12;
  const float* hcw = p.in[19] + l * 3 * 768 + c0;
  for (int idx = tid; idx < 4 * NQ * 2 * (NB - 1) * 32; idx += 256) {
    const int e = idx % ((NB - 1) * 32), s2 = (idx / ((NB - 1) * 32)) & 1, sq = idx / (2 * (NB - 1) * 32);
    UP[sq * PADLEN + (s2 ? (2 * NB - 1) * 32 : 0) + e] = 0;
  }
  {
    float4 w[3][3];
#pragma unroll
    for (int k = 0; k < 3; ++k)
#pragma unroll
      for (int sidx = 0; sidx < 3; ++sidx) w[k][sidx] = *(const float4*)(hcw + k * 768 + sidx * 256);
    for (int pr = tid; pr < NQ * L; pr += 256) {
      const int q = pr / L, t = pr % L;
      const float* row = phy + (size_t)(tokbase + q * L + t) * 12;
      float4 o[3];
#pragma unroll
      for (int sidx = 0; sidx < 3; ++sidx) {
        const float4 m = *(const float4*)(row + sidx * 4);
        o[sidx] = make_float4(w[1][sidx].x * m.x, w[1][sidx].y * m.y, w[1][sidx].z * m.z, w[1][sidx].w * m.w);
        if (t > 0) {
          const float4 a = *(const float4*)(row - 12 + sidx * 4);
          o[sidx].x += w[0][sidx].x * a.x; o[sidx].y += w[0][sidx].y * a.y; o[sidx].z += w[0][sidx].z * a.z; o[sidx].w += w[0][sidx].w * a.w;
        }
        if (t < L - 1) {
          const float4 c = *(const float4*)(row + 12 + sidx * 4);
          o[sidx].x += w[2][sidx].x * c.x; o[sidx].y += w[2][sidx].y * c.y; o[sidx].z += w[2][sidx].z * c.z; o[sidx].w += w[2][sidx].w * c.w;
        }
      }
      const int ui = q * PADLEN + (NB - 1) * 32 + t;
      UP[(0 * NQ) * PADLEN + ui] = f2bf(o[0].x); UP[(1 * NQ) * PADLEN + ui] = f2bf(o[0].y);
      UP[(2 * NQ) * PADLEN + ui] = f2bf(o[0].z); UP[(3 * NQ) * PADLEN + ui] = f2bf(o[0].w);
      X1[0 * NQ * L + pr] = o[1].x; X1[1 * NQ * L + pr] = o[1].y; X1[2 * NQ * L + pr] = o[1].z; X1[3 * NQ * L + pr] = o[1].w;
      X2[0 * NQ * L + pr] = o[2].x; X2[1 * NQ * L + pr] = o[2].y; X2[2 * NQ * L + pr] = o[2].z; X2[3 * NQ * L + pr] = o[2].w;
    }
  }
  __syncthreads();
  {
    const int c = c0 + wave;
    const int col = lane & 31, q = col / NB, T = col % NB;
    bf16_t* U = UP + wave * NQ * PADLEN;
    const bf16_t* rv0 = ((L == 256) ? (const bf16_t*)(p.ws + OFF_TAP256) + (size_t)l * 2 * 256 * 512
                                    : (const bf16_t*)(p.ws + OFF_TAP1024) + (size_t)l * 2 * 256 * 2048) + (size_t)c * 2 * L;
    const bf16_t* rv1 = rv0 + (size_t)256 * 2 * L;
    const int aoff_u = L - 1 - (lane & 31) + 8 * h;
    const int ash = aoff_u & 7, aoff = aoff_u - ash;
    const int ds2 = (ash >> 2) & 1, ds1 = (ash >> 1) & 1; const unsigned hb = (ash & 1) * 2;
    const int boff = q * PADLEN + 32 * (T + NB - 1) + 8 * h;
    const int uo = q * PADLEN + (NB - 1) * 32 + 32 * T + 4 * h;
    const int xo = wave * NQ * L + q * L + 32 * T + 4 * h;
    const float skip0 = p.in[26][(l * 2 + 0) * 256 + c], skip1 = p.in[26][(l * 2 + 1) * 256 + c];
    f32x16 acc;
#pragma unroll
    for (int e = 0; e < 16; ++e) acc[e] = 0.f;
    f32x16 accB;
#pragma unroll
    for (int e = 0; e < 16; ++e) accB[e] = 0.f;
#pragma unroll 5
    for (int D = -(NB - 1); D <= NB - 1; ++D) {
      const int off = -32 * D;
      const bf16x8 a0 = ld16_shift(rv0 + aoff + off, ds2, ds1, hb), a1 = ld16_shift(rv0 + aoff + off + 16, ds2, ds1, hb);
      const bf16x8 b0 = *(const bf16x8*)(U + boff + off), b1 = *(const bf16x8*)(U + boff + off + 16);
      acc = MFMA32(a0, b0, acc);
      accB = MFMA32(a1, b1, accB);
    }
#pragma unroll
    for (int e = 0; e < 16; ++e) acc[e] += accB[e];
    float z[16];
#pragma unroll
    for (int g = 0; g < 4; ++g) {
      const uint2 vv = *(const uint2*)(U + uo + 8 * g);
      const float4 x1 = *(const float4*)(X1 + xo + 8 * g);
      z[4 * g + 0] = x1.x * (acc[4 * g + 0] + skip0 * __uint_as_float(vv.x << 16));
      z[4 * g + 1] = x1.y * (acc[4 * g + 1] + skip0 * __uint_as_float(vv.x & 0xffff0000u));
      z[4 * g + 2] = x1.z * (acc[4 * g + 2] + skip0 * __uint_as_float(vv.y << 16));
      z[4 * g + 3] = x1.w * (acc[4 * g + 3] + skip0 * __uint_as_float(vv.y & 0xffff0000u));
    }
    __builtin_amdgcn_wave_barrier();
#pragma unroll
    for (int g = 0; g < 4; ++g)
      *(uint2*)(U + uo + 8 * g) = make_uint2(pack2(z[4 * g], z[4 * g + 1]), pack2(z[4 * g + 2], z[4 * g + 3]));
    __builtin_amdgcn_wave_barrier();
#pragma unroll
    for (int e = 0; e < 16; ++e) acc[e] = 0.f;
#pragma unroll
    for (int e = 0; e < 16; ++e) accB[e] = 0.f;
#pragma unroll 5
    for (int D = -(NB - 1); D <= NB - 1; ++D) {
      const int off = -32 * D;
      const bf16x8 a0 = ld16_shift(rv1 + aoff + off, ds2, ds1, hb), a1 = ld16_shift(rv1 + aoff + off + 16, ds2, ds1, hb);
      const bf16x8 b0 = *(const bf16x8*)(U + boff + off), b1 = *(const bf16x8*)(U + boff + off + 16);
      acc = MFMA32(a0, b0, acc);
      accB = MFMA32(a1, b1, accB);
    }
#pragma unroll
    for (int e = 0; e < 16; ++e) acc[e] += accB[e];
    bf16_t* OUT = (bf16_t*)(lds + 57344) + (size_t)(q * L + 32 * T + 4 * h) * 4 + wave;
#pragma unroll
    for (int g = 0; g < 4; ++g) {
      const float4 x2 = *(const float4*)(X2 + xo + 8 * g);
      OUT[(8 * g + 0) * 4] = f2bf(x2.x * (acc[4 * g + 0] + skip1 * z[4 * g + 0]));
      OUT[(8 * g + 1) * 4] = f2bf(x2.y * (acc[4 * g + 1] + skip1 * z[4 * g + 1]));
      OUT[(8 * g + 2) * 4] = f2bf(x2.z * (acc[4 * g + 2] + skip1 * z[4 * g + 2]));
      OUT[(8 * g + 3) * 4] = f2bf(x2.w * (acc[4 * g + 3] + skip1 * z[4 * g + 3]));
    }
  }
  __syncthreads();
  {
    const uint2* OUTv = (const uint2*)(lds + 57344);
    bf16_t* mix = (bf16_t*)(p.ws + OFF_MIX);
    for (int idx = tid; idx < NQ * L; idx += 256) *(uint2*)(mix + blk(tokbase + idx, 768 + c0, 16)) = OUTv[idx];
  }
  __syncthreads();
}

DI void mixer_phase(const Params& p, int l, int sub, char* lds, int* s_item, int rep = 0) {
  const int tid = otid(), wave = tid >> 6;
  int* ctr = (int*)(p.ws + OFF_CTR) + l * 2 + sub + rep * 8;
  bf16_t* mix = (bf16_t*)(p.ws + OFF_MIX);
  const bf16_t* qbf = (const bf16_t*)(p.ws + OFF_QBF);
  const int nitems = sub ? 672 : 1088;
  for (;;) {
    if (tid == 0) *s_item = atomicAdd(ctr, 1);
    __syncthreads();
    const int it = *s_item;
    __syncthreads();
    if (it >= nitems) break;
    if (sub == 0) {
      if (it < 128) {
        const int j = it;
        hy_item<1024>(p, l, NPROMPT + (j >> 6) * 1024, (j & 63) * 4, lds);
      } else if (it < 256) {
        const int j = it - 128, b2 = j >> 6, head = (j >> 3) & 7, qb = j & 7, kvh = head >> 2;
        const int qtok = NPROMPT + b2 * 1024 + qb * 128 + wave * 32;
        attn_wave(qbf + (size_t)qtok * 512 + head * 64,
                  (const bf16_t*)(p.ws + OFF_KCAT) + (size_t)((l * 2 + b2) * 2 + kvh) * (1280 * 64),
                  (const bf16_t*)(p.ws + OFF_VTL) + (size_t)((l * 2 + b2) * 2 + kvh) * (1280 * 64), 1280,
                  mix, qtok, head);
      } else if (it < 576) {
        const int j = it - 256;
        lru_gate_item(p, l, j >> 2, j & 3, lds);
      } else {
        const int j = it - 576;
        hy_item<256>(p, l, (j >> 6) * 1024, (j & 63) * 4, lds);
      }
    } else {
      if (it < 32) {
        lru_scan_item<16>(p, l, 32 + (it >> 4), (it & 15) * 16, lds);
      } else if (it < 160) {
        const int j = it - 32;
        lru_scan_item<64>(p, l, j >> 2, (j & 3) * 64, lds);
      } else {
        const int j = it - 160, b = j >> 4, head = (j >> 1) & 7, qb = j & 1, kvh = head >> 2;
        const int qtok = b * 256 + qb * 128 + wave * 32;
        attn_wave(qbf + (size_t)qtok * 512 + head * 64,
                  (const bf16_t*)(p.ws + OFF_KBF) + (size_t)(b * 2 + kvh) * (256 * 64),
                  (const bf16_t*)(p.ws + OFF_VTP) + (size_t)(b * 2 + kvh) * (256 * 64), 256,
                  mix, qtok, head);
      }
    }
  }
}

#ifndef PROBE_P0
#define PROBE_P0 0
#endif
#ifndef PROBE_DG
#define PROBE_DG 0
#endif
#ifndef PROBE_MIX
#define PROBE_MIX 0
#endif
#ifndef PROBE_DUP
#define PROBE_DUP 0
#endif
#ifndef PHASE_SEL
#define PHASE_SEL -1
#endif
#define PSEL(k) (PHASE_SEL < 0 || PHASE_SEL == (k))
#ifndef STOP_P
#define STOP_P -1
#endif
#ifndef STOP_L
#define STOP_L 0
#endif
#define STOPAT(k) if (STOP_P == (k) && l == STOP_L) return;
__global__ void __launch_bounds__(256, 2) fwd_megakernel(Params p) {
  cg::grid_group grid = cg::this_grid();
  __shared__ __attribute__((aligned(16))) char lds[LDS_BYTES];
  __shared__ int s_item;
  GBar gbar;
  gbar.w = (unsigned*)(p.ws + OFF_CTR);
  gbar.x = (unsigned)__builtin_amdgcn_s_getreg((3 << 11) | 20) & 0xFu;
  gbar.epoch = 0; gbar.nloc = 1; gbar.nx = 1;
  if (threadIdx.x == 0) (void)gb_add(&gbar.w[CW_CNT(gbar.x)], 1u);
  grid.sync();
  if (threadIdx.x == 0) {
    unsigned cnt = 0, mine = 1;
    for (unsigned j = 0; j < 16; ++j) { const unsigned c = gb_ld(&gbar.w[CW_CNT(j)]); cnt += (c > 0u) ? 1u : 0u; if (j == gbar.x) mine = c; }
    gbar.nloc = mine; gbar.nx = cnt;
  }
  if (PSEL(0)) phase0(p, lds, &s_item);
  gsync(gbar);
#if PROBE_P0
#endif
  const bf16_t* hbf = (const bf16_t*)(p.ws + OFF_HBF);
  for (int l = 0; l < 4; ++l) {
    if (PSEL(1)) norm_phase(p, l, 0);
    gsync(gbar);
    STOPAT(1)
    if (PSEL(2)) gemm_phase<EPI_IN>(p, l, hbf, 1024, (const bf16_t*)(p.ws + OFF_WTIN) + (size_t)l * 2048 * 1024, 1024, 1024, 16, 0, lds);
    gsync(gbar);
#if PROBE_DUP
    gemm_phase<EPI_IN>(p, l, hbf, 1024, (const bf16_t*)(p.ws + OFF_WTIN) + (size_t)l * 2048 * 1024, 1024, 1024, 16, 0, lds);
    gsync(gbar);
#endif
    STOPAT(2)
    if (PSEL(3)) mixer_phase(p, l, 0, lds, &s_item);
    gsync(gbar);
    if (PSEL(3)) mixer_phase(p, l, 1, lds, &s_item);
    gsync(gbar);
#if PROBE_MIX
    mixer_phase(p, l, 0, lds, &s_item, 1);
    gsync(gbar);
    mixer_phase(p, l, 1, lds, &s_item, 1);
    gsync(gbar);
#endif
    STOPAT(3)
    if (PSEL(4)) gemm_phase<EPI_RES>(p, l, (const bf16_t*)(p.ws + OFF_MIX), 1024, (const bf16_t*)(p.ws + OFF_WTOUT) + (size_t)l * 1024 * 1024, 1024, 1024, 8, 2, lds, 1.f, 1);
    gsync(gbar);
#if PROBE_DG
    gemm_phase<EPI_RES>(p, l, (const bf16_t*)(p.ws + OFF_MIX), 1024, (const bf16_t*)(p.ws + OFF_WTOUT) + (size_t)l * 1024 * 1024, 1024, 1024, 8, 2, lds, 0.f);
    gsync(gbar);
#endif
    STOPAT(4)
    if (PSEL(1)) norm_phase(p, l, 1);
    gsync(gbar);
    STOPAT(5)
    if (PSEL(5)) gemm_phase<EPI_FFN>(p, l, hbf, 1024, (const bf16_t*)(p.ws + OFF_WT13) + (size_t)l * 5632 * 1024, 1024, 1024, 44, 0, lds);
    gsync(gbar);
#if PROBE_DUP
    gemm_phase<EPI_FFN>(p, l, hbf, 1024, (const bf16_t*)(p.ws + OFF_WT13) + (size_t)l * 5632 * 1024, 1024, 1024, 44, 0, lds);
    gsync(gbar);
#endif
    STOPAT(6)
    if (PSEL(4)) gemm_phase<EPI_RES>(p, l, (const bf16_t*)(p.ws + OFF_UBF), DFF, (const bf16_t*)(p.ws + OFF_WT2) + (size_t)l * 1024 * DFF, DFF, DFF, 8, 5, lds, 1.f, 1);
    gsync(gbar);
#if PROBE_DG
    gemm_phase<EPI_RES>(p, l, (const bf16_t*)(p.ws + OFF_UBF), DFF, (const bf16_t*)(p.ws + OFF_WT2) + (size_t)l * 1024 * DFF, DFF, DFF, 8, 5, lds, 0.f);
    gsync(gbar);
#endif
    STOPAT(7)
  }
}

#ifndef MULTI_LAUNCH
#define MULTI_LAUNCH 0
#endif
__global__ void __launch_bounds__(256, 2) phase_kernel(Params p, int phase, int l) {
  __shared__ __attribute__((aligned(16))) char lds[LDS_BYTES];
  __shared__ int s_item;
  const bf16_t* hbf = (const bf16_t*)(p.ws + OFF_HBF);
  switch (phase) {
    case 0: phase0(p, lds, &s_item); break;
    case 1: norm_phase(p, l, 0); break;
    case 2: gemm_phase<EPI_IN>(p, l, hbf, 1024, (const bf16_t*)(p.ws + OFF_WTIN) + (size_t)l * 2048 * 1024, 1024, 1024, 16, 0, lds); break;
    case 3: mixer_phase(p, l, 0, lds, &s_item); break;
    case 8: mixer_phase(p, l, 1, lds, &s_item); break;
    case 4: gemm_phase<EPI_RES>(p, l, (const bf16_t*)(p.ws + OFF_MIX), 1024, (const bf16_t*)(p.ws + OFF_WTOUT) + (size_t)l * 1024 * 1024, 1024, 1024, 8, 2, lds); break;
    case 5: norm_phase(p, l, 1); break;
    case 6: gemm_phase<EPI_FFN>(p, l, hbf, 1024, (const bf16_t*)(p.ws + OFF_WT13) + (size_t)l * 5632 * 1024, 1024, 1024, 44, 0, lds); break;
    default: gemm_phase<EPI_RES>(p, l, (const bf16_t*)(p.ws + OFF_UBF), DFF, (const bf16_t*)(p.ws + OFF_WT2) + (size_t)l * 1024 * DFF, DFF, DFF, 8, 5, lds); break;
  }
}

extern "C" void kernel_launch(void* const* d_in, const int* in_sizes, int n_in, void* d_out, int out_size, void* d_ws, size_t ws_size,
                              hipStream_t stream) {
  static int grid_blocks = 0;
  if (!grid_blocks) {
    int dev = 0, cus = 0, per_cu = 0;
    hipGetDevice(&dev);
    hipDeviceGetAttribute(&cus, hipDeviceAttributeMultiprocessorCount, dev);
    hipOccupancyMaxActiveBlocksPerMultiprocessor(&per_cu, fwd_megakernel, 256, 0);
    if (per_cu > 2) per_cu = 2;
    if (per_cu < 1) per_cu = 1;
    grid_blocks = cus * per_cu;
  }
  Params p{};
  for (int i = 0; i < 31; ++i) p.in[i] = (const float*)d_in[i];
  p.out = (float*)d_out;
  p.ws = (char*)d_ws;
  (void)hipMemsetAsync((char*)d_ws + OFF_CTR, 0, CTL_BYTES, stream);
#if MULTI_LAUNCH
  hipLaunchKernelGGL(phase_kernel, dim3(512), dim3(256), 0, stream, p, 0, 0);
  for (int l = 0; l < 4; ++l)
    for (int ph = 1; ph <= 7; ++ph) hipLaunchKernelGGL(phase_kernel, dim3(512), dim3(256), 0, stream, p, ph, l);
  return;
#endif
  void* args[] = {&p};
  hipError_t e = hipLaunchCooperativeKernel((void*)fwd_megakernel, dim3(grid_blocks), dim3(256), args, 0, stream);
  if (e != hipSuccess) fprintf(stderr, "cooperative launch failed: %s (grid %d)\n", hipGetErrorString(e), grid_blocks);
}
```

```cpp
#include <hip/hip_runtime.h>
#include <hip/hip_cooperative_groups.h>
#include <stdint.h>
#include <cstdio>
namespace cg = cooperative_groups;

typedef __attribute__((ext_vector_type(8))) short bf16x8;
typedef __attribute__((ext_vector_type(16))) float f32x16;
typedef unsigned short bf16_t;
#define DI __device__ __forceinline__
#define MFMA32(a, b, c) __builtin_amdgcn_mfma_f32_32x32x16_bf16((a), (b), (c), 0, 0, 0)

#define NTOK 10240
#define NPROMPT 8192
#define DM 1024
#define DFF 2816
#define OUT_NK 10485760
#define OUT_NV 14680064
#define OUT_ST 18874368

constexpr size_t OFF_WTIN   = 0;
constexpr size_t OFF_WTOUT  = OFF_WTIN + 16777216;
constexpr size_t OFF_WT13   = OFF_WTOUT + 8388608;
constexpr size_t OFF_WT2    = OFF_WT13 + 46137344;
constexpr size_t OFF_MOD    = OFF_WT2 + 23068672;
constexpr size_t OFF_TAP256 = OFF_MOD + 294912;
constexpr size_t OFF_TAP1024 = OFF_TAP256 + 4194304;
constexpr size_t OFF_KCAT   = OFF_TAP1024 + 16777216;
constexpr size_t OFF_VTL    = OFF_KCAT + 2621440;
constexpr size_t OFF_HBF    = OFF_VTL + 2621440;
constexpr size_t OFF_QBF    = OFF_HBF + 20971520;
constexpr size_t OFF_KBF    = OFF_QBF + 10485760;
constexpr size_t OFF_VTP    = OFF_KBF + 2097152;
constexpr size_t OFF_PBUF   = OFF_VTP + 2097152;
constexpr size_t OFF_MIX    = OFF_PBUF + 52428800;
constexpr size_t OFF_UBF    = OFF_MIX + 20971520;
constexpr size_t OFF_ZBUF   = OFF_UBF + 57671680;
constexpr size_t OFF_CTR    = OFF_ZBUF + 10485760;
constexpr size_t OFF_PHY    = OFF_CTR + 16384;
constexpr size_t WS_TOTAL   = OFF_PHY + (size_t)64 * 10240 * 12 * 4;

struct Params {
  const float* in[31];
  float* out;
  char* ws;
};

#define LDS_BYTES 73728
#define LROW 144
#define LTILE (128 * 144)
#define LBUF (2 * LTILE)

DI bf16_t f2bf(float x) { unsigned u = __float_as_uint(x); u += 0x7fffu + ((u >> 16) & 1u); return (bf16_t)(u >> 16); }
DI unsigned pack2(float a, float b) { return (unsigned)f2bf(a) | ((unsigned)f2bf(b) << 16); }
DI size_t blk(int m, int k, int KTF) { return ((size_t)((m >> 7) * KTF + (k >> 6)) * 128 + (m & 127)) * 64 + (k & 63); }
DI int otid() { int t = threadIdx.x; asm volatile("" : "+v"(t)); return t; }
DI void sync_g() { asm volatile("s_waitcnt vmcnt(0)" ::: "memory"); __syncthreads(); }
#define CW_CNT(j) (64 * (1 + (j)))
#define CW_SUB(j) (64 * (17 + (j)))
#define CW_TOP (64 * 33)
#define CW_GEN (64 * 34)
#define CW_XGEN(j) (64 * (35 + (j)))
#define CTL_BYTES 16384
struct GBar { unsigned* w; unsigned x, nloc, nx, epoch; };
DI unsigned gb_ld(unsigned* p) { return __hip_atomic_load(p, __ATOMIC_RELAXED, __HIP_MEMORY_SCOPE_AGENT); }
DI unsigned gb_add(unsigned* p, unsigned v) { return __hip_atomic_fetch_add(p, v, __ATOMIC_RELAXED, __HIP_MEMORY_SCOPE_AGENT); }
DI void gsync1(GBar& g) {
  asm volatile("s_waitcnt vmcnt(0)" ::: "memory");
  __syncthreads();
  if (threadIdx.x == 0) {
    if (g.nloc == 0u) {
      for (;;) {
        unsigned sum = 0, cnt = 0, mine = 1;
        for (unsigned j = 0; j < 16; ++j) { const unsigned c = gb_ld(&g.w[CW_CNT(j)]); sum += c; cnt += (c > 0u) ? 1u : 0u; if (j == g.x) mine = c; }
        if (sum == gridDim.x) { g.nloc = mine; g.nx = cnt; break; }
        __builtin_amdgcn_s_sleep(1);
      }
    }
    g.epoch++;
    const unsigned old = gb_add(&g.w[CW_SUB(g.x)], 1u);
    if (old + 1u == g.epoch * g.nloc) {
      __builtin_amdgcn_fence(__ATOMIC_RELEASE, "agent");
      asm volatile("s_waitcnt vmcnt(0)" ::: "memory");
      const unsigned old2 = gb_add(&g.w[CW_TOP], 1u);
      if (old2 + 1u == g.epoch * g.nx) (void)gb_add(&g.w[CW_GEN], 1u);
    }
    while (gb_ld(&g.w[CW_GEN]) < g.epoch) __builtin_amdgcn_s_sleep(1);
    __builtin_amdgcn_fence(__ATOMIC_ACQUIRE, "agent");
    asm volatile("s_waitcnt vmcnt(0)" ::: "memory");
  }
  __syncthreads();
}
DI float fast_sigmoid(float x) { return __builtin_amdgcn_rcpf(1.f + __expf(-x)); }
DI float sigmoidf_(float x) { return 1.f / (1.f + __expf(-x)); }

DI void p0_transpose(const float* __restrict__ src, int K, int N, int kt, int nt, bf16_t* __restrict__ dst, int mode) {
  const int tid = otid();
  const int n = tid & 63, c = nt * 64 + n, k0 = kt * 128 + (tid >> 6) * 32;
  float v[32];
#pragma unroll
  for (int j = 0; j < 32; ++j) v[j] = src[(size_t)(k0 + j) * N + c];
  int nrow;
  if (mode == 0) nrow = c;
  else nrow = nt * 128 + (n >> 5) * 64 + (mode - 1) * 32 + (n & 31);
  uint4* d = (uint4*)(dst + blk(nrow, k0, K >> 6));
#pragma unroll
  for (int q = 0; q < 4; ++q)
    d[q] = make_uint4(pack2(v[8 * q], v[8 * q + 1]), pack2(v[8 * q + 2], v[8 * q + 3]), pack2(v[8 * q + 4], v[8 * q + 5]), pack2(v[8 * q + 6], v[8 * q + 7]));
}

DI void p0_mod(const Params& p, int l, int cc, float* lds) {
  const int tid = otid();
  float* s = lds;
  float* red = lds + 3072;
  for (int idx = tid; idx < 3072; idx += 256) {
    int ci = idx >> 10, k = idx & 1023;
    float v = (ci == 0) ? p.in[6][k] : p.in[5][(ci - 1) * 1024 + k];
    s[idx] = v / (1.f + expf(-v));
  }
  __syncthreads();
  const int col = tid & 63, kg = tid >> 6;
  const float* W = p.in[7] + (size_t)l * 1024 * 6144 + cc * 64 + col;
  float a0 = 0.f, a1 = 0.f, a2 = 0.f;
#pragma unroll 16
  for (int k = kg * 256; k < kg * 256 + 256; ++k) {
    float w = W[(size_t)k * 6144];
    a0 += s[k] * w; a1 += s[1024 + k] * w; a2 += s[2048 + k] * w;
  }
  red[(kg * 3 + 0) * 64 + col] = a0; red[(kg * 3 + 1) * 64 + col] = a1; red[(kg * 3 + 2) * 64 + col] = a2;
  __syncthreads();
  if (tid < 192) {
    int ci = tid >> 6, c = tid & 63;
    float v = red[(0 * 3 + ci) * 64 + c] + red[(1 * 3 + ci) * 64 + c] + red[(2 * 3 + ci) * 64 + c] + red[(3 * 3 + ci) * 64 + c];
    v += p.in[8][l * 6144 + cc * 64 + c];
    float* mod = (float*)(p.ws + OFF_MOD);
    mod[(l * 3 + ci) * 6144 + cc * 64 + c] = v;
  }
  __syncthreads();
}

DI void p0_taps(const Params& p, int l, int g, float* lds) {
  const int tid = otid();
  float* zf = lds;
  float* h1 = lds + 320;
  float* h2 = lds + 832;
  const int tt0 = g * 8;
  const int L = (tt0 < 256) ? 256 : 1024;
  const int tbase = (tt0 < 256) ? tt0 : tt0 - 256;
  const float invL = 1.f / (float)L;
  for (int idx = tid; idx < 264; idx += 256) {
    int ti = idx / 33, f = idx % 33;
    float t = (float)(tbase + ti);
    float v;
    if (f == 0) v = t * invL;
    else {
      int bi = (f - 1) & 15;
      float band = 1e-4f + (float)bi * ((15.f - 1e-4f) / 15.f);
      float ph = t * band * invL;
      ph -= floorf(ph);
      float ang = 6.283185307179586f * ph;
      v = (f <= 16) ? cosf(ang) : -sinf(ang);
    }
    zf[ti * 40 + f] = v;
  }
  __syncthreads();
  const float* w1 = p.in[20] + l * 33 * 64;
  const float* b1 = p.in[21] + l * 64;
  const float* w2 = p.in[22] + l * 64 * 64;
  const float* b2 = p.in[23] + l * 64;
  const float* w3 = p.in[24] + (size_t)l * 64 * 1024;
  const float* b3 = p.in[25] + l * 1024;
  for (int idx = tid; idx < 512; idx += 256) {
    int ti = idx >> 6, j = idx & 63;
    float a = b1[j];
#pragma unroll 11
    for (int f = 0; f < 33; ++f) a += zf[ti * 40 + f] * w1[f * 64 + j];
    h1[ti * 64 + j] = sinf(a);
  }
  __syncthreads();
  for (int idx = tid; idx < 512; idx += 256) {
    int ti = idx >> 6, j = idx & 63;
    float a = b2[j];
#pragma unroll 16
    for (int f = 0; f < 64; ++f) a += h1[ti * 64 + f] * w2[f * 64 + j];
    h2[ti * 64 + j] = sinf(a);
  }
  __syncthreads();
  float acc[4][8];
#pragma unroll
  for (int q = 0; q < 4; ++q)
#pragma unroll
    for (int ti = 0; ti < 8; ++ti) acc[q][ti] = 0.f;
#pragma unroll 8
  for (int i = 0; i < 64; ++i) {
    float w[4];
#pragma unroll
    for (int q = 0; q < 4; ++q) w[q] = w3[i * 1024 + q * 256 + tid];
#pragma unroll
    for (int ti = 0; ti < 8; ++ti) {
      float hv = h2[ti * 64 + i];
#pragma unroll
      for (int q = 0; q < 4; ++q) acc[q][ti] += hv * w[q];
    }
  }
  const int ch = tid;
  const float d0 = -3.0701134573253945f, d1 = -15.350567286626973f;
  const float delta = d0 + (float)ch * ((d1 - d0) / 255.f);
  bf16_t* tapbase = (L == 256) ? (bf16_t*)(p.ws + OFF_TAP256) + (size_t)l * 2 * 256 * 512
                               : (bf16_t*)(p.ws + OFF_TAP1024) + (size_t)l * 2 * 256 * 2048;
#pragma unroll
  for (int q = 0; q < 4; ++q) {
    const int order = q >> 1, side = q & 1;
    const float bb = b3[q * 256 + ch];
#pragma unroll
    for (int ti = 0; ti < 8; ++ti) {
      int t = tbase + ti;
      float tn = (float)t * invL;
      float val = (acc[q][ti] + bb) * expf(tn * delta);
      int x;
      if (side == 0) x = L + t;
      else { if (t == 0) { x = 0; val = 0.f; } else x = L - t; }
      tapbase[((size_t)order * 256 + ch) * 2 * L + (2 * L - 1 - x)] = f2bf(val);
    }
  }
  __syncthreads();
}

DI int kf_off(int key, int d) { return ((((key >> 5) * 4 + (d >> 4)) * 64 + ((d >> 3) & 1) * 32 + (key & 31)) << 3) + (d & 7); }
DI int vf_off(int key, int d) { return (((((key >> 5) * 2 + ((key >> 4) & 1)) * 2 + (d >> 5)) * 64 + ((key >> 2) & 1) * 32 + (d & 31)) << 3) + (key & 3) + 4 * ((key >> 3) & 1); }
DI void p0_cache(const Params& p, int it) {
  const int tid = otid();
  bf16_t* kcat = (bf16_t*)(p.ws + OFF_KCAT);
  bf16_t* vtl = (bf16_t*)(p.ws + OFF_VTL);
  for (int e = tid; e < 4096; e += 256) {
    int rr = it * 32 + (e >> 7), c = e & 127;
    int s = rr & 255, bl = rr >> 8, l = bl & 3, b = bl >> 2;
    float kv = p.in[2][(size_t)rr * 128 + c];
    float vv = p.in[3][(size_t)rr * 128 + c];
    const int kvh = c >> 6, d = c & 63;
    const size_t sb = (size_t)((l * 2 + b) * 2 + kvh) * (1280 * 64);
    kcat[sb + kf_off(s, d)] = f2bf(kv);
    vtl[sb + vf_off(s, d)] = f2bf(vv);
  }
}

DI void phase0(const Params& p, char* lds, int* s_item) {
  const int NTAP = 640, NMOD = 384, NCACHE = 64, NTR = 5760;
  const int total = NTAP + NMOD + NCACHE + NTR;
  int* ctr = (int*)(p.ws + OFF_CTR) + 16;
  const int tid = otid();
  for (;;) {
    if (tid == 0) *s_item = atomicAdd(ctr, 1);
    __syncthreads();
    const int it = *s_item;
    __syncthreads();
    if (it >= total) break;
    int r = it;
    if (r < NTAP) { p0_taps(p, r / 160, r % 160, (float*)lds); continue; }
    r -= NTAP;
    if (r < NMOD) { p0_mod(p, r / 96, r % 96, (float*)lds); continue; }
    r -= NMOD;
    if (r < NCACHE) { p0_cache(p, r); continue; }
    r -= NCACHE;
    int l = r / 1440; r %= 1440;
    if (r < 256) p0_transpose(p.in[11] + (size_t)l * 1024 * 2048, 1024, 2048, r / 32, r % 32, (bf16_t*)(p.ws + OFF_WTIN) + (size_t)l * 2048 * 1024, 0);
    else if (r < 384) { r -= 256; p0_transpose(p.in[27] + (size_t)l * 1024 * 1024, 1024, 1024, r / 16, r % 16, (bf16_t*)(p.ws + OFF_WTOUT) + (size_t)l * 1024 * 1024, 0); }
    else if (r < 736) { r -= 384; p0_transpose(p.in[28] + (size_t)l * 1024 * 2816, 1024, 2816, r / 44, r % 44, (bf16_t*)(p.ws + OFF_WT13) + (size_t)l * 5632 * 1024, 1); }
    else if (r < 1088) { r -= 736; p0_transpose(p.in[29] + (size_t)l * 1024 * 2816, 1024, 2816, r / 44, r % 44, (bf16_t*)(p.ws + OFF_WT13) + (size_t)l * 5632 * 1024, 2); }
    else { r -= 1088; p0_transpose(p.in[30] + (size_t)l * 2816 * 1024, 2816, 1024, r / 16, r % 16, (bf16_t*)(p.ws + OFF_WT2) + (size_t)l * 1024 * 2816, 0); }
  }
}

DI void norm_phase(const Params& p, int l, int which) {
  float* xbuf = p.out;
  bf16_t* hbf = (bf16_t*)(p.ws + OFF_HBF);
  const float* mod = (const float*)(p.ws + OFF_MOD);
  const float* nw = p.in[which ? 10 : 9] + l * 1024;
  const int tid_ = otid(); const int wave = tid_ >> 6, lane = tid_ & 63;
  const bool first = (l == 0 && which == 0);
  constexpr int RB = 5;
  const int nwaves = gridDim.x * 4;
  for (int row0 = blockIdx.x * 4 + wave; row0 < NTOK; row0 += nwaves * RB) {
    float4 v[RB][4];
#pragma unroll
    for (int j = 0; j < RB; ++j) {
      const int row = row0 + j * nwaves;
      if (row < NTOK) {
        const float* src;
        if (first) src = (row < NPROMPT) ? p.in[0] + (size_t)row * 1024 : p.in[1] + (size_t)(row - NPROMPT) * 1024;
        else src = xbuf + (size_t)row * 1024;
#pragma unroll
        for (int i = 0; i < 4; ++i) v[j][i] = *(const float4*)(src + i * 256 + lane * 4);
      } else {
#pragma unroll
        for (int i = 0; i < 4; ++i) v[j][i] = make_float4(0.f, 0.f, 0.f, 0.f);
      }
    }
#pragma unroll
    for (int j = 0; j < RB; ++j) {
      const int row = row0 + j * nwaves;
      if (row >= NTOK) break;
      float ss = 0.f;
#pragma unroll
      for (int i = 0; i < 4; ++i) ss += v[j][i].x * v[j][i].x + v[j][i].y * v[j][i].y + v[j][i].z * v[j][i].z + v[j][i].w * v[j][i].w;
#pragma unroll
      for (int o = 32; o >= 1; o >>= 1) ss += __shfl_xor(ss, o);
      const float rstd = rsqrtf(ss * (1.f / 1024.f) + 1e-6f);
      const int ci = (row < NPROMPT) ? 0 : 1 + ((row - NPROMPT) >> 10);
      const float* sh = mod + ((l * 3 + ci) * 6 + (which ? 3 : 0)) * 1024;
      const float* sc = sh + 1024;
#pragma unroll
      for (int i = 0; i < 4; ++i) {
        const int col = i * 256 + lane * 4;
        const float4 w4 = *(const float4*)(nw + col), s4 = *(const float4*)(sc + col), h4 = *(const float4*)(sh + col);
        const float y0 = v[j][i].x * rstd * w4.x * (1.f + s4.x) + h4.x;
        const float y1 = v[j][i].y * rstd * w4.y * (1.f + s4.y) + h4.y;
        const float y2 = v[j][i].z * rstd * w4.z * (1.f + s4.z) + h4.z;
        const float y3 = v[j][i].w * rstd * w4.w * (1.f + s4.w) + h4.w;
        *(uint2*)(hbf + blk(row, col, 16)) = make_uint2(pack2(y0, y1), pack2(y2, y3));
        if (first) *(float4*)(xbuf + (size_t)row * 1024 + col) = v[j][i];
      }
    }
  }
}

enum { EPI_IN = 0, EPI_RES = 1, EPI_FFN = 2 };

DI void epi_in(const Params& p, int l, int m0, int nt, const f32x16 (&acc)[2][2], char* lds) {
  const int tid = otid(), lane = tid & 63, wave = tid >> 6;
  const int wm = wave >> 1, wn = wave & 1, r = lane & 31, h = lane >> 5;
  float* Ct = (float*)lds;
#pragma unroll
  for (int i = 0; i < 2; ++i)
#pragma unroll
    for (int j = 0; j < 2; ++j)
#pragma unroll
      for (int reg = 0; reg < 16; ++reg) {
        int row = wm * 64 + i * 32 + (reg & 3) + 8 * (reg >> 2) + 4 * h;
        int col = wn * 64 + j * 32 + r;
        Ct[row * 132 + col] = acc[i][j][reg];
      }
  __syncthreads();
  const bool lat = (m0 >= NPROMPT);
  if (nt < 5) {
    const int row = tid >> 1, hh = tid & 1;
    float* src = Ct + row * 132 + hh * 64;
    float ss = 0.f;
#pragma unroll
    for (int d = 0; d < 64; d += 4) {
      float4 t = *(const float4*)(src + d);
      ss += t.x * t.x + t.y * t.y + t.z * t.z + t.w * t.w;
    }
    const float rstd = rsqrtf(ss * (1.f / 64.f) + 1e-6f);
    const float* nw = (nt < 4 ? p.in[12] : p.in[13]) + l * 64;
    const float osc = (nt < 4) ? 0.125f : 1.f;
    const int m = m0 + row;
    int pos = 0;
    if (lat) {
      pos = (m - NPROMPT) & 1023;
      const float pr = (float)(pos >> 6), pc = (float)(pos & 63);
#pragma unroll 1
      for (int d = 0; d < 16; ++d) {
        const float f = exp2f(-(float)d * 0.8304820237218406f);
        const float ar = pr * f, ac = pc * f;
        const float sr = __sinf(ar), cr = __cosf(ar), sc_ = __sinf(ac), cc_ = __cosf(ac);
        float x1 = src[d] * rstd * nw[d], x2 = src[d + 16] * rstd * nw[d + 16];
        src[d] = (x1 * cr - x2 * sr) * osc; src[d + 16] = (x2 * cr + x1 * sr) * osc;
        x1 = src[32 + d] * rstd * nw[32 + d]; x2 = src[48 + d] * rstd * nw[48 + d];
        src[32 + d] = (x1 * cc_ - x2 * sc_) * osc; src[48 + d] = (x2 * cc_ + x1 * sc_) * osc;
      }
    } else {
#pragma unroll
      for (int d = 0; d < 64; d += 4) {
        float4 t = *(const float4*)(src + d);
        float4 w = *(const float4*)(nw + d);
        t.x *= rstd * w.x * osc; t.y *= rstd * w.y * osc; t.z *= rstd * w.z * osc; t.w *= rstd * w.w * osc;
        *(float4*)(src + d) = t;
      }
    }
    if (nt < 4) {
      bf16_t* dst = (bf16_t*)(p.ws + OFF_QBF) + (size_t)m * 512 + (nt * 2 + hh) * 64;
#pragma unroll
      for (int d = 0; d < 64; d += 8) {
        float4 t0 = *(const float4*)(src + d), t1 = *(const float4*)(src + d + 4);
        *(uint4*)(dst + d) = make_uint4(pack2(t0.x, t0.y), pack2(t0.z, t0.w), pack2(t1.x, t1.y), pack2(t1.z, t1.w));
      }
    } else {
      bf16_t* dst;
      int key;
      if (!lat) {
        const int b = m >> 8, s = m & 255;
        float* nk = p.out + OUT_NK + ((size_t)((b * 4 + l) * 256 + s)) * 128 + hh * 64;
#pragma unroll
        for (int d = 0; d < 64; d += 4) *(float4*)(nk + d) = *(const float4*)(src + d);
        dst = (bf16_t*)(p.ws + OFF_KBF) + (size_t)(b * 2 + hh) * (256 * 64);
        key = s;
      } else {
        const int b2 = (m - NPROMPT) >> 10;
        dst = (bf16_t*)(p.ws + OFF_KCAT) + (size_t)((l * 2 + b2) * 2 + hh) * (1280 * 64);
        key = 256 + pos;
      }
#pragma unroll
      for (int d = 0; d < 64; d += 8) {
        float4 t0 = *(const float4*)(src + d), t1 = *(const float4*)(src + d + 4);
        *(uint4*)(dst + kf_off(key, d)) = make_uint4(pack2(t0.x, t0.y), pack2(t0.z, t0.w), pack2(t1.x, t1.y), pack2(t1.z, t1.w));
      }
    }
  } else if (nt == 5) {
    if (!lat) {
      const int row = tid >> 1, hf = tid & 1;
      const int m = m0 + row, b = m >> 8, s = m & 255;
      float* nv = p.out + OUT_NV + ((size_t)((b * 4 + l) * 256 + s)) * 128 + hf * 64;
      const float* src = Ct + row * 132 + hf * 64;
#pragma unroll
      for (int d = 0; d < 64; d += 4) *(float4*)(nv + d) = *(const float4*)(src + d);
    }
    {
      const int col = tid & 127, rh = tid >> 7;
      const int kvh = col >> 6, d = col & 63;
      bf16_t* dst;
      int kstart;
      if (!lat) {
        const int b = m0 >> 8, s0 = m0 & 255;
        dst = (bf16_t*)(p.ws + OFF_VTP) + (size_t)(b * 2 + kvh) * (256 * 64);
        kstart = s0 + rh * 64;
      } else {
        const int b2 = (m0 - NPROMPT) >> 10, s0 = (m0 - NPROMPT) & 1023;
        dst = (bf16_t*)(p.ws + OFF_VTL) + (size_t)((l * 2 + b2) * 2 + kvh) * (1280 * 64);
        kstart = 256 + s0 + rh * 64;
      }
      const float* src = Ct + (rh * 64) * 132 + col;
#pragma unroll
      for (int g = 0; g < 8; ++g) {
        const int kk0 = (g >> 2) * 32 + ((g >> 1) & 1) * 16 + (g & 1) * 4;
        *(uint4*)(dst + vf_off(kstart + kk0, d)) =
            make_uint4(pack2(src[(kk0 + 0) * 132], src[(kk0 + 1) * 132]), pack2(src[(kk0 + 2) * 132], src[(kk0 + 3) * 132]),
                       pack2(src[(kk0 + 8) * 132], src[(kk0 + 9) * 132]), pack2(src[(kk0 + 10) * 132], src[(kk0 + 11) * 132]));
      }
    }
  } else if (nt < 10) {
    const int row = tid >> 1, hf = tid & 1;
    float* dst = (float*)(p.ws + OFF_PBUF) + (size_t)(m0 + row) * 1280 + (nt * 128 - 768) + hf * 64;
    const float* src = Ct + row * 132 + hf * 64;
#pragma unroll
    for (int d = 0; d < 64; d += 4) *(float4*)(dst + d) = *(const float4*)(src + d);
  } else {
    const int row = tid >> 1, hf = tid & 1;
    const int sidx = (nt - 10) >> 1, cg0 = (((nt - 10) & 1) * 128 + hf * 64) >> 2;
    float* dst = (float*)(p.ws + OFF_PHY) + ((size_t)cg0 * NTOK + (m0 + row)) * 12 + sidx * 4;
    const float* src = Ct + row * 132 + hf * 64;
#pragma unroll
    for (int g = 0; g < 16; ++g) *(float4*)(dst + (size_t)g * NTOK * 12) = *(const float4*)(src + 4 * g);
  }
  __syncthreads();
}

template <int EPI>
DI void gemm_phase(const Params& p, int l, const bf16_t* A, int lda, const bf16_t* BT, int ldb, int K, int NT,
                           int modpart, char* lds, float gscale = 1.f, int KS = 1) {
  const int tid = otid(), lane = tid & 63, wave = tid >> 6;
  const int wm = wave >> 1, wn = wave & 1, r = lane & 31, h = lane >> 5;
  const int ntiles = 80 * NT * KS;
  const int KT = K / (64 * KS);
  const int woff = (tid >> 3) * LROW + (tid & 7) * 16;
  for (int t = blockIdx.x; t < ntiles; t += gridDim.x) {
    const int ks = t / (80 * NT), tt = t - ks * (80 * NT);
    const int mt = tt % 80, nt = tt / 80;
    const int m0 = mt * 128, n0 = nt * 128;
    f32x16 acc[2][2];
#pragma unroll
    for (int i = 0; i < 2; ++i)
#pragma unroll
      for (int j = 0; j < 2; ++j)
#pragma unroll
        for (int e = 0; e < 16; ++e) acc[i][j][e] = 0.f;
    const bf16_t* Ag = A + ((size_t)mt * (K >> 6) + ks * KT) * 8192 + tid * 8;
    const bf16_t* Bg = BT + ((size_t)nt * (K >> 6) + ks * KT) * 8192 + tid * 8;
    uint4 ra[2][4], rb[2][4];
#pragma unroll
    for (int i = 0; i < 4; ++i) {
      ra[0][i] = *(const uint4*)(Ag + i * 2048);
      rb[0][i] = *(const uint4*)(Bg + i * 2048);
    }
#pragma unroll
    for (int i = 0; i < 4; ++i) {
      *(uint4*)(lds + woff + i * 32 * LROW) = ra[0][i];
      *(uint4*)(lds + LTILE + woff + i * 32 * LROW) = rb[0][i];
    }
#pragma unroll
    for (int i = 0; i < 4; ++i) {
      asm volatile("global_load_dwordx4 %0, %1, off" : "=v"(ra[1][i]) : "v"(Ag + i * 2048 + 8192) : "memory");
      asm volatile("global_load_dwordx4 %0, %1, off" : "=v"(rb[1][i]) : "v"(Bg + i * 2048 + 8192) : "memory");
    }
    __syncthreads();
    for (int kt2 = 0; kt2 < KT; kt2 += 2) {
#pragma unroll
      for (int u = 0; u < 2; ++u) {
        const int kt = kt2 + u;
        const char* cur = lds + u * LBUF;
        char* nxt = lds + (u ^ 1) * LBUF;
        const int kn = (kt + 2 < KT) ? kt + 2 : KT - 1;
        asm volatile("s_waitcnt vmcnt(0)" ::: "memory");
#pragma unroll
        for (int i = 0; i < 4; ++i) {
          asm volatile("global_load_dwordx4 %0, %1, off" : "=v"(ra[u][i]) : "v"(Ag + i * 2048 + (size_t)kn * 8192) : "memory");
          asm volatile("global_load_dwordx4 %0, %1, off" : "=v"(rb[u][i]) : "v"(Bg + i * 2048 + (size_t)kn * 8192) : "memory");
        }
        __builtin_amdgcn_s_setprio(1);
#pragma unroll
        for (int st = 0; st < 4; ++st) {
          bf16x8 a0 = *(const bf16x8*)(cur + (wm * 64 + r) * LROW + st * 32 + h * 16);
          bf16x8 a1 = *(const bf16x8*)(cur + (wm * 64 + 32 + r) * LROW + st * 32 + h * 16);
          bf16x8 b0 = *(const bf16x8*)(cur + LTILE + (wn * 64 + r) * LROW + st * 32 + h * 16);
          bf16x8 b1 = *(const bf16x8*)(cur + LTILE + (wn * 64 + 32 + r) * LROW + st * 32 + h * 16);
          acc[0][0] = MFMA32(a0, b0, acc[0][0]);
          acc[0][1] = MFMA32(a0, b1, acc[0][1]);
          acc[1][0] = MFMA32(a1, b0, acc[1][0]);
          acc[1][1] = MFMA32(a1, b1, acc[1][1]);
          *(uint4*)(nxt + woff + st * 32 * LROW) = ra[u ^ 1][st];
          *(uint4*)(nxt + LTILE + woff + st * 32 * LROW) = rb[u ^ 1][st];
        }
        __builtin_amdgcn_s_setprio(0);
        __syncthreads();
      }
    }
    asm volatile("s_waitcnt vmcnt(0)" ::: "memory");
#pragma unroll
    for (int i = 0; i < 4; ++i) {
      typedef unsigned u32x4_t __attribute__((ext_vector_type(4)));
      const u32x4_t t0 = {ra[0][i].x, ra[0][i].y, ra[0][i].z, ra[0][i].w}, t1 = {rb[0][i].x, rb[0][i].y, rb[0][i].z, rb[0][i].w};
      const u32x4_t t2 = {ra[1][i].x, ra[1][i].y, ra[1][i].z, ra[1][i].w}, t3 = {rb[1][i].x, rb[1][i].y, rb[1][i].z, rb[1][i].w};
      asm volatile("" :: "v"(t0), "v"(t1), "v"(t2), "v"(t3));
    }
    if (EPI == EPI_IN) {
      epi_in(p, l, m0, nt, acc, lds);
    } else if (EPI == EPI_RES) {
      const int ci = (m0 < NPROMPT) ? 0 : 1 + ((m0 - NPROMPT) >> 10);
      const float* gate = (const float*)(p.ws + OFF_MOD) + ((l * 3 + ci) * 6 + modpart) * 1024;
      float* xbuf = p.out;
      if (KS > 1) {
#pragma unroll
        for (int j = 0; j < 2; ++j) {
          const int n = n0 + wn * 64 + j * 32 + r;
          const float g = gate[n] * gscale;
#pragma unroll
          for (int i = 0; i < 2; ++i)
#pragma unroll
            for (int reg = 0; reg < 16; ++reg) {
              const int m = m0 + wm * 64 + i * 32 + (reg & 3) + 8 * (reg >> 2) + 4 * h;
              (void)__hip_atomic_fetch_add(xbuf + (size_t)m * 1024 + n, g * acc[i][j][reg], __ATOMIC_RELAXED, __HIP_MEMORY_SCOPE_AGENT);
            }
        }
      } else {
        float* Ct = (float*)lds;
#pragma unroll
        for (int i = 0; i < 2; ++i)
#pragma unroll
          for (int j = 0; j < 2; ++j)
#pragma unroll
            for (int reg = 0; reg < 16; ++reg)
              Ct[(wm * 64 + i * 32 + (reg & 3) + 8 * (reg >> 2) + 4 * h) * 132 + wn * 64 + j * 32 + r] = acc[i][j][reg];
        __syncthreads();
#pragma unroll
        for (int i = 0; i < 16; ++i) {
          const int c = tid + 256 * i, row = c >> 5, c4 = (c & 31) * 4;
          const float4 a = *(const float4*)(Ct + row * 132 + c4);
          const float4 g = *(const float4*)(gate + n0 + c4);
          float4* xp = (float4*)(xbuf + (size_t)(m0 + row) * 1024 + n0 + c4);
          float4 xv = *xp;
          xv.x += gscale * g.x * a.x; xv.y += gscale * g.y * a.y; xv.z += gscale * g.z * a.z; xv.w += gscale * g.w * a.w;
          *xp = xv;
        }
        __syncthreads();
      }
    } else {
      bf16_t* st = (bf16_t*)lds + (wm * 64 + 4 * h) * 72 + wn * 32 + r;
#pragma unroll
      for (int i = 0; i < 2; ++i)
#pragma unroll
        for (int reg = 0; reg < 16; ++reg) {
          const float a = acc[i][0][reg], b = acc[i][1][reg];
          st[(i * 32 + (reg & 3) + 8 * (reg >> 2)) * 72] = f2bf(a * fast_sigmoid(a) * b);
        }
      __syncthreads();
      {
        bf16_t* ub = (bf16_t*)(p.ws + OFF_UBF) + ((size_t)mt * 44 + nt) * 8192;
#pragma unroll
        for (int i = 0; i < 4; ++i) {
          const int c = tid + 256 * i;
          *(uint4*)(ub + c * 8) = *(const uint4*)((const bf16_t*)lds + (c >> 3) * 72 + (c & 7) * 8);
        }
      }
      __syncthreads();
    }
  }
}

DI void attn_wave(const bf16_t* __restrict__ q, const bf16_t* __restrict__ kp, const bf16_t* __restrict__ vt, int nkeys, bf16_t* __restrict__ mixb, int qtok, int head) {
  const int lane = otid() & 63, r = lane & 31, h = lane >> 5;
  bf16x8 qf[4];
#pragma unroll
  for (int st = 0; st < 4; ++st) qf[st] = *(const bf16x8*)(q + (size_t)r * 512 + st * 16 + h * 8);
  f32x16 O[2];
#pragma unroll
  for (int e = 0; e < 16; ++e) { O[0][e] = 0.f; O[1][e] = 0.f; }
  float m = -1e30f, lsum = 0.f;
  bf16x8 kfr[2][4];
#pragma unroll
  for (int sub = 0; sub < 2; ++sub)
#pragma unroll
    for (int st = 0; st < 4; ++st) kfr[sub][st] = *(const bf16x8*)(kp + (size_t)(((sub * 4 + st) * 64 + lane) << 3));
  for (int k0 = 0; k0 < nkeys; k0 += 64) {
    f32x16 S[2];
#pragma unroll
    for (int sub = 0; sub < 2; ++sub) {
#pragma unroll
      for (int e = 0; e < 16; ++e) S[sub][e] = 0.f;
#pragma unroll
      for (int st = 0; st < 4; ++st) S[sub] = MFMA32(kfr[sub][st], qf[st], S[sub]);
    }
    {
      const int kn = (k0 + 64 < nkeys) ? k0 + 64 : k0;
#pragma unroll
      for (int sub = 0; sub < 2; ++sub)
#pragma unroll
        for (int st = 0; st < 4; ++st) kfr[sub][st] = *(const bf16x8*)(kp + (size_t)(((((kn >> 5) + sub) * 4 + st) * 64 + lane) << 3));
    }
    bf16x8 vfr[2][2][2];
#pragma unroll
    for (int sub = 0; sub < 2; ++sub)
#pragma unroll
      for (int s2 = 0; s2 < 2; ++s2)
#pragma unroll
        for (int dt = 0; dt < 2; ++dt)
          vfr[sub][s2][dt] = *(const bf16x8*)(vt + (size_t)((((((k0 >> 5) + sub) * 2 + s2) * 2 + dt) * 64 + lane) << 3));
    float mx = m;
#pragma unroll
    for (int sub = 0; sub < 2; ++sub)
#pragma unroll
      for (int e = 0; e < 16; ++e) mx = fmaxf(mx, S[sub][e]);
    mx = fmaxf(mx, __shfl_xor(mx, 32));
    const float alpha = __expf(m - mx);
    m = mx;
    float ps = 0.f;
#pragma unroll
    for (int sub = 0; sub < 2; ++sub)
#pragma unroll
      for (int e = 0; e < 16; ++e) { float pv = __expf(S[sub][e] - mx); S[sub][e] = pv; ps += pv; }
    lsum = lsum * alpha + ps;
#pragma unroll
    for (int e = 0; e < 16; ++e) { O[0][e] *= alpha; O[1][e] *= alpha; }
#pragma unroll
    for (int sub = 0; sub < 2; ++sub)
#pragma unroll
      for (int s = 0; s < 2; ++s) {
        union { unsigned u[4]; bf16x8 v; } pf;
#pragma unroll
        for (int j = 0; j < 4; ++j) pf.u[j] = pack2(S[sub][8 * s + 2 * j], S[sub][8 * s + 2 * j + 1]);
#pragma unroll
        for (int dt = 0; dt < 2; ++dt) O[dt] = MFMA32(vfr[sub][s][dt], pf.v, O[dt]);
      }
  }
  lsum += __shfl_xor(lsum, 32);
  const float inv = 1.f / lsum;
  bf16_t* ob = mixb + ((size_t)(qtok >> 7) * 16 + head) * 8192 + ((qtok & 127) + r) * 64;
#pragma unroll
  for (int dt = 0; dt < 2; ++dt)
#pragma unroll
    for (int g = 0; g < 4; ++g) {
      const int d = dt * 32 + 8 * g + 4 * h;
      *(uint2*)(ob + d) = make_uint2(pack2(O[dt][4 * g] * inv, O[dt][4 * g + 1] * inv), pack2(O[dt][4 * g + 2] * inv, O[dt][4 * g + 3] * inv));
    }
}

DI float gelu_tanh(float x) { return 0.5f * x * (1.f + tanhf(0.7978845608028654f * (x + 0.044715f * x * x * x))); }

#ifndef PROBE_BAR
#define PROBE_BAR 0
#endif
DI void gsync(GBar& g) { gsync1(g); if (PROBE_BAR) { gsync1(g); gsync1(g); } }
DI float fast_gelu(float x) {
  const float u = 0.7978845608028654f * (x + 0.044715f * x * x * x);
  const float th = 1.f - 2.f * __builtin_amdgcn_rcpf(1.f + __expf(2.f * u));
  return 0.5f * x * (1.f + th);
}

DI void lru_gate_item(const Params& p, int l, int mt, int n, char* lds) {
  const int tid = otid(), lane = tid & 63, wave = tid >> 6, r = lane & 31, h = lane >> 5;
  float* XC = (float*)lds;
  bf16_t* Axc = (bf16_t*)(lds + 32768);
  const int m0 = mt * 128;
  const int L = (m0 < NPROMPT) ? 256 : 1024;
  const int tb = (m0 < NPROMPT) ? (m0 & 255) : ((m0 - NPROMPT) & 1023);
  const float* pbuf = (const float*)(p.ws + OFF_PBUF);
  float2* ab = (float2*)(p.ws + OFF_UBF);
  {
    const int ch = tid & 63, tq = tid >> 6, gch = n * 64 + ch;
    float cw[4];
#pragma unroll
    for (int k = 0; k < 4; ++k) cw[k] = p.in[14][(l * 4 + k) * 256 + gch];
    const float cb = p.in[15][l * 256 + gch];
    float x[35];
#pragma unroll
    for (int i = 0; i < 35; ++i) {
      const int ts = tb + tq * 32 + i - 2;
      x[i] = (ts >= 0 && ts < L) ? pbuf[(size_t)(m0 - tb + ts) * 1280 + gch] : 0.f;
    }
#pragma unroll
    for (int e = 0; e < 32; ++e) {
      const float xv = cb + cw[0] * x[e] + cw[1] * x[e + 1] + cw[2] * x[e + 2] + cw[3] * x[e + 3];
      XC[(tq * 32 + e) * 64 + ch] = xv;
      Axc[(tq * 32 + e) * 72 + ch] = f2bf(xv);
    }
  }
  __syncthreads();
  {
    const int dir = wave & 1, half = wave >> 1;
    bf16x8 wf[2][2][4];
    float gb[2][2], sp[2];
#pragma unroll
    for (int g = 0; g < 2; ++g) {
      const float* W = p.in[16] + ((size_t)((l * 2 + dir) * 2 + g) * 4 + n) * 4096;
#pragma unroll
      for (int ct = 0; ct < 2; ++ct) {
        const int j = r + 32 * ct;
        gb[g][ct] = p.in[17][((l * 2 + dir) * 2 + g) * 256 + n * 64 + j];
#pragma unroll
        for (int st = 0; st < 4; ++st) {
          const int i0 = 16 * st + 8 * h;
          union { unsigned u[4]; bf16x8 v; } f;
#pragma unroll
          for (int jj = 0; jj < 4; ++jj) f.u[jj] = pack2(W[(i0 + 2 * jj) * 64 + j], W[(i0 + 2 * jj + 1) * 64 + j]);
          wf[g][ct][st] = f.v;
        }
      }
    }
#pragma unroll
    for (int ct = 0; ct < 2; ++ct) sp[ct] = log1pf(expf(-p.in[18][(l * 2 + dir) * 256 + n * 64 + r + 32 * ct]));
#pragma unroll 1
    for (int rt = 0; rt < 2; ++rt) {
      f32x16 acc[2][2];
#pragma unroll
      for (int e = 0; e < 16; ++e) { acc[0][0][e] = 0.f; acc[0][1][e] = 0.f; acc[1][0][e] = 0.f; acc[1][1][e] = 0.f; }
#pragma unroll
      for (int st = 0; st < 4; ++st) {
        const bf16x8 af = *(const bf16x8*)(Axc + (half * 64 + rt * 32 + r) * 72 + 16 * st + 8 * h);
        acc[0][0] = MFMA32(af, wf[0][0][st], acc[0][0]);
        acc[0][1] = MFMA32(af, wf[0][1][st], acc[0][1]);
        acc[1][0] = MFMA32(af, wf[1][0][st], acc[1][0]);
        acc[1][1] = MFMA32(af, wf[1][1][st], acc[1][1]);
      }
#pragma unroll
      for (int ct = 0; ct < 2; ++ct)
#pragma unroll
        for (int reg = 0; reg < 16; ++reg) {
          const int tok = half * 64 + rt * 32 + (reg & 3) + 8 * (reg >> 2) + 4 * h;
          const int j = r + 32 * ct;
          const float rr = fast_sigmoid(acc[0][ct][reg] + gb[0][ct]);
          const float ii = fast_sigmoid(acc[1][ct][reg] + gb[1][ct]);
          const float xv = XC[tok * 64 + j];
          const float a = __expf(-8.f * rr * sp[ct]);
          const float bb = __builtin_sqrtf(fmaxf(fmaf(-a, a, 1.f), 0.f)) * (ii * xv);
          ab[((size_t)dir * NTOK + m0 + tok) * 256 + n * 64 + j] = make_float2(a, bb);
        }
    }
  }
  __syncthreads();
}

template <int CGS>
DI void lru_scan_item(const Params& p, int l, int bidx, int cbase, char* lds) {
  constexpr int NSEG = 256 / CGS;
  const int tid = otid();
  const bool lat = bidx >= 32;
  const int L = lat ? 1024 : 256;
  const int tok0 = lat ? NPROMPT + (bidx - 32) * 1024 : bidx * 256;
  const int ch = tid % CGS, sg = tid / CGS, gch = cbase + ch;
  const int SEGL = L / NSEG;
  float2* SEG = (float2*)lds;
  const float2* ab = (const float2*)(p.ws + OFF_UBF);
  float* hfbuf = (float*)(p.ws + OFF_UBF + 41943040);
  const float* pbuf = (const float*)(p.ws + OFF_PBUF);
  bf16_t* mix = (bf16_t*)(p.ws + OFF_MIX);
  const float2* abf = ab + ((size_t)0 * NTOK + tok0 + sg * SEGL) * 256 + gch;
  const float2* abb = ab + ((size_t)1 * NTOK + tok0 + sg * SEGL) * 256 + gch;
  {
    float A = 1.f, B = 0.f;
#pragma unroll 16
    for (int i = 0; i < SEGL; ++i) { const float2 v = abf[(size_t)i * 256]; B = v.x * B + v.y; A *= v.x; }
    SEG[(0 * NSEG + sg) * CGS + ch] = make_float2(A, B);
    A = 1.f; B = 0.f;
#pragma unroll 16
    for (int i = SEGL - 1; i >= 0; --i) { const float2 v = abb[(size_t)i * 256]; B = v.x * B + v.y; A *= v.x; }
    SEG[(1 * NSEG + sg) * CGS + ch] = make_float2(A, B);
  }
  __syncthreads();
  float hf = lat ? p.in[4][(((bidx - 32) * 4 + l) * 2 + 0) * 256 + gch] : 0.f;
  float hb = lat ? p.in[4][(((bidx - 32) * 4 + l) * 2 + 1) * 256 + gch] : 0.f;
  for (int q = 0; q < sg; ++q) { const float2 v = SEG[(0 * NSEG + q) * CGS + ch]; hf = v.x * hf + v.y; }
  for (int q = NSEG - 1; q > sg; --q) { const float2 v = SEG[(1 * NSEG + q) * CGS + ch]; hb = v.x * hb + v.y; }
  if (!lat) {
    if (sg == NSEG - 1) { const float2 v = SEG[(0 * NSEG + NSEG - 1) * CGS + ch]; p.out[OUT_ST + ((size_t)(bidx * 4 + l) * 2 + 0) * 256 + gch] = v.x * hf + v.y; }
    if (sg == 0) { const float2 v = SEG[(1 * NSEG + 0) * CGS + ch]; p.out[OUT_ST + ((size_t)(bidx * 4 + l) * 2 + 1) * 256 + gch] = v.x * hb + v.y; }
  }
  float* hfp = hfbuf + (size_t)(tok0 + sg * SEGL) * 256 + gch;
  for (int i0 = 0; i0 < SEGL; i0 += 16) {
    float2 v[16];
#pragma unroll
    for (int j = 0; j < 16; ++j) v[j] = abf[(size_t)(i0 + j) * 256];
#pragma unroll
    for (int j = 0; j < 16; ++j) { hf = v[j].x * hf + v[j].y; hfp[(size_t)(i0 + j) * 256] = hf; }
  }
  const float* lg = pbuf + (size_t)(tok0 + sg * SEGL) * 1280 + 256 + gch;
  bf16_t* mp = mix + blk(tok0 + sg * SEGL, 512 + gch, 16);
  for (int i0 = SEGL - 16; i0 >= 0; i0 -= 16) {
    float2 v[16];
    float gv[16], fv[16];
#pragma unroll
    for (int j = 0; j < 16; ++j) {
      v[j] = abb[(size_t)(i0 + j) * 256];
      gv[j] = lg[(size_t)(i0 + j) * 1280];
      fv[j] = hfp[(size_t)(i0 + j) * 256];
    }
#pragma unroll
    for (int j = 15; j >= 0; --j) {
      hb = v[j].x * hb + v[j].y;
      mp[(size_t)(i0 + j) * 64] = f2bf(fast_gelu(gv[j]) * (fv[j] + hb));
    }
  }
  __syncthreads();
}

DI bf16x8 ld16u(const bf16_t* p) { bf16x8 v; __builtin_memcpy(&v, p, 16); return v; }
typedef unsigned u32x4v __attribute__((ext_vector_type(4)));
DI bf16x8 ld16_shift(const bf16_t* p8, int ds2, int ds1, unsigned hb) {
  const u32x4v c0 = *(const u32x4v*)p8, c1 = *(const u32x4v*)(p8 + 8);
  unsigned t0 = ds2 ? c0[2] : c0[0], t1 = ds2 ? c0[3] : c0[1], t2 = ds2 ? c1[0] : c0[2], t3 = ds2 ? c1[1] : c0[3], t4 = ds2 ? c1[2] : c1[0], t5 = ds2 ? c1[3] : c1[1];
  unsigned u0 = ds1 ? t1 : t0, u1 = ds1 ? t2 : t1, u2 = ds1 ? t3 : t2, u3 = ds1 ? t4 : t3, u4 = ds1 ? t5 : t4;
  union { unsigned u[4]; bf16x8 v; } r;
  r.u[0] = __builtin_amdgcn_alignbyte(u1, u0, hb); r.u[1] = __builtin_amdgcn_alignbyte(u2, u1, hb);
  r.u[2] = __builtin_amdgcn_alignbyte(u3, u2, hb); r.u[3] = __builtin_amdgcn_alignbyte(u4, u3, hb);
  return r.v;
}
DI float bf2f(bf16_t v) { return __uint_as_float((unsigned)v << 16); }
DI float conv3_at(const float* __restrict__ pb, int t, int L, float w0, float w1, float w2) {
  float v = w1 * pb[(size_t)t * 1280];
  if (t > 0) v += w0 * pb[(size_t)(t - 1) * 1280];
  if (t < L - 1) v += w2 * pb[(size_t)(t + 1) * 1280];
  return v;
}

template <int L>
DI void hy_item(const Params& p, int l, int tokbase, int c0, char* lds) {
  constexpr int NB = L / 32, NQ = 32 / NB, PADLEN = (3 * NB - 2) * 32;
  const int tid = otid(), lane = tid & 63, wave = tid >> 6, h = lane >> 5;
  bf16_t* UP = (bf16_t*)lds;
  float* X1 = (float*)(lds + 24576);
  float* X2 = (float*)(lds + 24576 + 16384);
  const float* phy = (const float*)(p.ws + OFF_PHY) + (size_t)(c0 >> 2) * NTOK * 12;
  const float* hcw = p.in[19] + l * 3 * 768 + c0;
  for (int idx = tid; idx < 4 * NQ * 2 * (NB - 1) * 32; idx += 256) {
    const int e = idx % ((NB - 1) * 32), s2 = (idx / ((NB - 1) * 32)) & 1, sq = idx / (2 * (NB - 1) * 32);
    UP[sq * PADLEN + (s2 ? (2 * NB - 1) * 32 : 0) + e] = 0;
  }
  {
    float4 w[3][3];
#pragma unroll
    for (int k = 0; k < 3; ++k)
#pragma unroll
      for (int sidx = 0; sidx < 3; ++sidx) w[k][sidx] = *(const float4*)(hcw + k * 768 + sidx * 256);
    for (int pr = tid; pr < NQ * L; pr += 256) {
      const int q = pr / L, t = pr % L;
      const float* row = phy + (size_t)(tokbase + q * L + t) * 12;
      float4 o[3];
#pragma unroll
      for (int sidx = 0; sidx < 3; ++sidx) {
        const float4 m = *(const float4*)(row + sidx * 4);
        o[sidx] = make_float4(w[1][sidx].x * m.x, w[1][sidx].y * m.y, w[1][sidx].z * m.z, w[1][sidx].w * m.w);
        if (t > 0) {
          const float4 a = *(const float4*)(row - 12 + sidx * 4);
          o[sidx].x += w[0][sidx].x * a.x; o[sidx].y += w[0][sidx].y * a.y; o[sidx].z += w[0][sidx].z * a.z; o[sidx].w += w[0][sidx].w * a.w;
        }
        if (t < L - 1) {
          const float4 c = *(const float4*)(row + 12 + sidx * 4);
          o[sidx].x += w[2][sidx].x * c.x; o[sidx].y += w[2][sidx].y * c.y; o[sidx].z += w[2][sidx].z * c.z; o[sidx].w += w[2][sidx].w * c.w;
        }
      }
      const int ui = q * PADLEN + (NB - 1) * 32 + t;
      UP[(0 * NQ) * PADLEN + ui] = f2bf(o[0].x); UP[(1 * NQ) * PADLEN + ui] = f2bf(o[0].y);
      UP[(2 * NQ) * PADLEN + ui] = f2bf(o[0].z); UP[(3 * NQ) * PADLEN + ui] = f2bf(o[0].w);
      X1[0 * NQ * L + pr] = o[1].x; X1[1 * NQ * L + pr] = o[1].y; X1[2 * NQ * L + pr] = o[1].z; X1[3 * NQ * L + pr] = o[1].w;
      X2[0 * NQ * L + pr] = o[2].x; X2[1 * NQ * L + pr] = o[2].y; X2[2 * NQ * L + pr] = o[2].z; X2[3 * NQ * L + pr] = o[2].w;
    }
  }
  __syncthreads();
  {
    const int c = c0 + wave;
    const int col = lane & 31, q = col / NB, T = col % NB;
    bf16_t* U = UP + wave * NQ * PADLEN;
    const bf16_t* rv0 = ((L == 256) ? (const bf16_t*)(p.ws + OFF_TAP256) + (size_t)l * 2 * 256 * 512
                                    : (const bf16_t*)(p.ws + OFF_TAP1024) + (size_t)l * 2 * 256 * 2048) + (size_t)c * 2 * L;
    const bf16_t* rv1 = rv0 + (size_t)256 * 2 * L;
    const int aoff_u = L - 1 - (lane & 31) + 8 * h;
    const int ash = aoff_u & 7, aoff = aoff_u - ash;
    const int ds2 = (ash >> 2) & 1, ds1 = (ash >> 1) & 1; const unsigned hb = (ash & 1) * 2;
    const int boff = q * PADLEN + 32 * (T + NB - 1) + 8 * h;
    const int uo = q * PADLEN + (NB - 1) * 32 + 32 * T + 4 * h;
    const int xo = wave * NQ * L + q * L + 32 * T + 4 * h;
    const float skip0 = p.in[26][(l * 2 + 0) * 256 + c], skip1 = p.in[26][(l * 2 + 1) * 256 + c];
    f32x16 acc;
#pragma unroll
    for (int e = 0; e < 16; ++e) acc[e] = 0.f;
    f32x16 accB;
#pragma unroll
    for (int e = 0; e < 16; ++e) accB[e] = 0.f;
#pragma unroll 5
    for (int D = -(NB - 1); D <= NB - 1; ++D) {
      const int off = -32 * D;
      const bf16x8 a0 = ld16_shift(rv0 + aoff + off, ds2, ds1, hb), a1 = ld16_shift(rv0 + aoff + off + 16, ds2, ds1, hb);
      const bf16x8 b0 = *(const bf16x8*)(U + boff + off), b1 = *(const bf16x8*)(U + boff + off + 16);
      acc = MFMA32(a0, b0, acc);
      accB = MFMA32(a1, b1, accB);
    }
#pragma unroll
    for (int e = 0; e < 16; ++e) acc[e] += accB[e];
    float z[16];
#pragma unroll
    for (int g = 0; g < 4; ++g) {
      const uint2 vv = *(const uint2*)(U + uo + 8 * g);
      const float4 x1 = *(const float4*)(X1 + xo + 8 * g);
      z[4 * g + 0] = x1.x * (acc[4 * g + 0] + skip0 * __uint_as_float(vv.x << 16));
      z[4 * g + 1] = x1.y * (acc[4 * g + 1] + skip0 * __uint_as_float(vv.x & 0xffff0000u));
      z[4 * g + 2] = x1.z * (acc[4 * g + 2] + skip0 * __uint_as_float(vv.y << 16));
      z[4 * g + 3] = x1.w * (acc[4 * g + 3] + skip0 * __uint_as_float(vv.y & 0xffff0000u));
    }
    __builtin_amdgcn_wave_barrier();
#pragma unroll
    for (int g = 0; g < 4; ++g)
      *(uint2*)(U + uo + 8 * g) = make_uint2(pack2(z[4 * g], z[4 * g + 1]), pack2(z[4 * g + 2], z[4 * g + 3]));
    __builtin_amdgcn_wave_barrier();
#pragma unroll
    for (int e = 0; e < 16; ++e) acc[e] = 0.f;
#pragma unroll
    for (int e = 0; e < 16; ++e) accB[e] = 0.f;
#pragma unroll 5
    for (int D = -(NB - 1); D <= NB - 1; ++D) {
      const int off = -32 * D;
      const bf16x8 a0 = ld16_shift(rv1 + aoff + off, ds2, ds1, hb), a1 = ld16_shift(rv1 + aoff + off + 16, ds2, ds1, hb);
      const bf16x8 b0 = *(const bf16x8*)(U + boff + off), b1 = *(const bf16x8*)(U + boff + off + 16);
      acc = MFMA32(a0, b0, acc);
      accB = MFMA32(a1, b1, accB);
    }
#pragma unroll
    for (int e = 0; e < 16; ++e) acc[e] += accB[e];
    bf16_t* OUT = (bf16_t*)(lds + 57344) + (size_t)(q * L + 32 * T + 4 * h) * 4 + wave;
#pragma unroll
    for (int g = 0; g < 4; ++g) {
      const float4 x2 = *(const float4*)(X2 + xo + 8 * g);
      OUT[(8 * g + 0) * 4] = f2bf(x2.x * (acc[4 * g + 0] + skip1 * z[4 * g + 0]));
      OUT[(8 * g + 1) * 4] = f2bf(x2.y * (acc[4 * g + 1] + skip1 * z[4 * g + 1]));
      OUT[(8 * g + 2) * 4] = f2bf(x2.z * (acc[4 * g + 2] + skip1 * z[4 * g + 2]));
      OUT[(8 * g + 3) * 4] = f2bf(x2.w * (acc[4 * g + 3] + skip1 * z[4 * g + 3]));
    }
  }
  __syncthreads();
  {
    const uint2* OUTv = (const uint2*)(lds + 57344);
    bf16_t* mix = (bf16_t*)(p.ws + OFF_MIX);
    for (int idx = tid; idx < NQ * L; idx += 256) *(uint2*)(mix + blk(tokbase + idx, 768 + c0, 16)) = OUTv[idx];
  }
  __syncthreads();
}

DI void mixer_phase(const Params& p, int l, int sub, char* lds, int* s_item, int rep = 0) {
  const int tid = otid(), wave = tid >> 6;
  int* ctr = (int*)(p.ws + OFF_CTR) + l * 2 + sub + rep * 8;
  bf16_t* mix = (bf16_t*)(p.ws + OFF_MIX);
  const bf16_t* qbf = (const bf16_t*)(p.ws + OFF_QBF);
  const int nitems = sub ? 672 : 1088;
  for (;;) {
    if (tid == 0) *s_item = atomicAdd(ctr, 1);
    __syncthreads();
    const int it = *s_item;
    __syncthreads();
    if (it >= nitems) break;
    if (sub == 0) {
      if (it < 128) {
        const int j = it;
        hy_item<1024>(p, l, NPROMPT + (j >> 6) * 1024, (j & 63) * 4, lds);
      } else if (it < 256) {
        const int j = it - 128, b2 = j >> 6, head = (j >> 3) & 7, qb = j & 7, kvh = head >> 2;
        const int qtok = NPROMPT + b2 * 1024 + qb * 128 + wave * 32;
        attn_wave(qbf + (size_t)qtok * 512 + head * 64,
                  (const bf16_t*)(p.ws + OFF_KCAT) + (size_t)((l * 2 + b2) * 2 + kvh) * (1280 * 64),
                  (const bf16_t*)(p.ws + OFF_VTL) + (size_t)((l * 2 + b2) * 2 + kvh) * (1280 * 64), 1280,
                  mix, qtok, head);
      } else if (it < 576) {
        const int j = it - 256;
        lru_gate_item(p, l, j >> 2, j & 3, lds);
      } else {
        const int j = it - 576;
        hy_item<256>(p, l, (j >> 6) * 1024, (j & 63) * 4, lds);
      }
    } else {
      if (it < 32) {
        lru_scan_item<16>(p, l, 32 + (it >> 4), (it & 15) * 16, lds);
      } else if (it < 160) {
        const int j = it - 32;
        lru_scan_item<64>(p, l, j >> 2, (j & 3) * 64, lds);
      } else {
        const int j = it - 160, b = j >> 4, head = (j >> 1) & 7, qb = j & 1, kvh = head >> 2;
        const int qtok = b * 256 + qb * 128 + wave * 32;
        attn_wave(qbf + (size_t)qtok * 512 + head * 64,
                  (const bf16_t*)(p.ws + OFF_KBF) + (size_t)(b * 2 + kvh) * (256 * 64),
                  (const bf16_t*)(p.ws + OFF_VTP) + (size_t)(b * 2 + kvh) * (256 * 64), 256,
                  mix, qtok, head);
      }
    }
  }
}

#ifndef PROBE_P0
#define PROBE_P0 0
#endif
#ifndef PROBE_DG
#define PROBE_DG 0
#endif
#ifndef PROBE_MIX
#define PROBE_MIX 0
#endif
#ifndef PROBE_DUP
#define PROBE_DUP 0
#endif
#ifndef PHASE_SEL
#define PHASE_SEL -1
#endif
#define PSEL(k) (PHASE_SEL < 0 || PHASE_SEL == (k))
#ifndef STOP_P
#define STOP_P -1
#endif
#ifndef STOP_L
#define STOP_L 0
#endif
#define STOPAT(k) if (STOP_P == (k) && l == STOP_L) return;
__global__ void __launch_bounds__(256, 2) fwd_megakernel(Params p) {
  cg::grid_group grid = cg::this_grid();
  __shared__ __attribute__((aligned(16))) char lds[LDS_BYTES];
  __shared__ int s_item;
  GBar gbar;
  gbar.w = (unsigned*)(p.ws + OFF_CTR);
  gbar.x = (unsigned)__builtin_amdgcn_s_getreg((3 << 11) | 20) & 0xFu;
  gbar.epoch = 0; gbar.nloc = 1; gbar.nx = 1;
  if (threadIdx.x == 0) (void)gb_add(&gbar.w[CW_CNT(gbar.x)], 1u);
  if (p.ws == nullptr) grid.sync();
  gbar.nloc = 0;
  if (PSEL(0)) phase0(p, lds, &s_item);
  gsync(gbar);
#if PROBE_P0
#endif
  const bf16_t* hbf = (const bf16_t*)(p.ws + OFF_HBF);
  for (int l = 0; l < 4; ++l) {
    if (PSEL(1)) norm_phase(p, l, 0);
    gsync(gbar);
    STOPAT(1)
    if (PSEL(2)) gemm_phase<EPI_IN>(p, l, hbf, 1024, (const bf16_t*)(p.ws + OFF_WTIN) + (size_t)l * 2048 * 1024, 1024, 1024, 16, 0, lds);
    gsync(gbar);
#if PROBE_DUP
    gemm_phase<EPI_IN>(p, l, hbf, 1024, (const bf16_t*)(p.ws + OFF_WTIN) + (size_t)l * 2048 * 1024, 1024, 1024, 16, 0, lds);
    gsync(gbar);
#endif
    STOPAT(2)
    if (PSEL(3)) mixer_phase(p, l, 0, lds, &s_item);
    gsync(gbar);
    if (PSEL(3)) mixer_phase(p, l, 1, lds, &s_item);
    gsync(gbar);
#if PROBE_MIX
    mixer_phase(p, l, 0, lds, &s_item, 1);
    gsync(gbar);
    mixer_phase(p, l, 1, lds, &s_item, 1);
    gsync(gbar);
#endif
    STOPAT(3)
    if (PSEL(4)) gemm_phase<EPI_RES>(p, l, (const bf16_t*)(p.ws + OFF_MIX), 1024, (const bf16_t*)(p.ws + OFF_WTOUT) + (size_t)l * 1024 * 1024, 1024, 1024, 8, 2, lds, 1.f, 1);
    gsync(gbar);
#if PROBE_DG
    gemm_phase<EPI_RES>(p, l, (const bf16_t*)(p.ws + OFF_MIX), 1024, (const bf16_t*)(p.ws + OFF_WTOUT) + (size_t)l * 1024 * 1024, 1024, 1024, 8, 2, lds, 0.f);
    gsync(gbar);
#endif
    STOPAT(4)
    if (PSEL(1)) norm_phase(p, l, 1);
    gsync(gbar);
    STOPAT(5)
    if (PSEL(5)) gemm_phase<EPI_FFN>(p, l, hbf, 1024, (const bf16_t*)(p.ws + OFF_WT13) + (size_t)l * 5632 * 1024, 1024, 1024, 44, 0, lds);
    gsync(gbar);
#if PROBE_DUP
    gemm_phase<EPI_FFN>(p, l, hbf, 1024, (const bf16_t*)(p.ws + OFF_WT13) + (size_t)l * 5632 * 1024, 1024, 1024, 44, 0, lds);
    gsync(gbar);
#endif
    STOPAT(6)
    if (PSEL(4)) gemm_phase<EPI_RES>(p, l, (const bf16_t*)(p.ws + OFF_UBF), DFF, (const bf16_t*)(p.ws + OFF_WT2) + (size_t)l * 1024 * DFF, DFF, DFF, 8, 5, lds, 1.f, 1);
    gsync(gbar);
#if PROBE_DG
    gemm_phase<EPI_RES>(p, l, (const bf16_t*)(p.ws + OFF_UBF), DFF, (const bf16_t*)(p.ws + OFF_WT2) + (size_t)l * 1024 * DFF, DFF, DFF, 8, 5, lds, 0.f);
    gsync(gbar);
#endif
    STOPAT(7)
  }
}

#ifndef MULTI_LAUNCH
#define MULTI_LAUNCH 0
#endif
__global__ void __launch_bounds__(256, 2) phase_kernel(Params p, int phase, int l) {
  __shared__ __attribute__((aligned(16))) char lds[LDS_BYTES];
  __shared__ int s_item;
  const bf16_t* hbf = (const bf16_t*)(p.ws + OFF_HBF);
  switch (phase) {
    case 0: phase0(p, lds, &s_item); break;
    case 1: norm_phase(p, l, 0); break;
    case 2: gemm_phase<EPI_IN>(p, l, hbf, 1024, (const bf16_t*)(p.ws + OFF_WTIN) + (size_t)l * 2048 * 1024, 1024, 1024, 16, 0, lds); break;
    case 3: mixer_phase(p, l, 0, lds, &s_item); break;
    case 8: mixer_phase(p, l, 1, lds, &s_item); break;
    case 4: gemm_phase<EPI_RES>(p, l, (const bf16_t*)(p.ws + OFF_MIX), 1024, (const bf16_t*)(p.ws + OFF_WTOUT) + (size_t)l * 1024 * 1024, 1024, 1024, 8, 2, lds); break;
    case 5: norm_phase(p, l, 1); break;
    case 6: gemm_phase<EPI_FFN>(p, l, hbf, 1024, (const bf16_t*)(p.ws + OFF_WT13) + (size_t)l * 5632 * 1024, 1024, 1024, 44, 0, lds); break;
    default: gemm_phase<EPI_RES>(p, l, (const bf16_t*)(p.ws + OFF_UBF), DFF, (const bf16_t*)(p.ws + OFF_WT2) + (size_t)l * 1024 * DFF, DFF, DFF, 8, 5, lds); break;
  }
}

extern "C" void kernel_launch(void* const* d_in, const int* in_sizes, int n_in, void* d_out, int out_size, void* d_ws, size_t ws_size,
                              hipStream_t stream) {
  static int grid_blocks = 0;
  if (!grid_blocks) {
    int dev = 0, cus = 0, per_cu = 0;
    hipGetDevice(&dev);
    hipDeviceGetAttribute(&cus, hipDeviceAttributeMultiprocessorCount, dev);
    hipOccupancyMaxActiveBlocksPerMultiprocessor(&per_cu, fwd_megakernel, 256, 0);
    if (per_cu > 2) per_cu = 2;
    if (per_cu < 1) per_cu = 1;
    grid_blocks = cus * per_cu;
  }
  Params p{};
  for (int i = 0; i < 31; ++i) p.in[i] = (const float*)d_in[i];
  p.out = (float*)d_out;
  p.ws = (char*)d_ws;
  (void)hipMemsetAsync((char*)d_ws + OFF_CTR, 0, CTL_BYTES, stream);
#if MULTI_LAUNCH
  hipLaunchKernelGGL(phase_kernel, dim3(512), dim3(256), 0, stream, p, 0, 0);
  for (int l = 0; l < 4; ++l)
    for (int ph = 1; ph <= 7; ++ph) hipLaunchKernelGGL(phase_kernel, dim3(512), dim3(256), 0, stream, p, ph, l);
  return;
#endif
  void* args[] = {&p};
  hipError_t e = hipLaunchCooperativeKernel((void*)fwd_megakernel, dim3(grid_blocks), dim3(256), args, 0, stream);
  if (e != hipSuccess) fprintf(stderr, "cooperative launch failed: %s (grid %d)\n", hipGetErrorString(e), grid_blocks);
}
```

```cpp
#include <hip/hip_runtime.h>
#include <hip/hip_cooperative_groups.h>
#include <stdint.h>
#include <cstdio>
namespace cg = cooperative_groups;

typedef __attribute__((ext_vector_type(8))) short bf16x8;
typedef __attribute__((ext_vector_type(16))) float f32x16;
typedef unsigned short bf16_t;
#define DI __device__ __forceinline__
#define MFMA32(a, b, c) __builtin_amdgcn_mfma_f32_32x32x16_bf16((a), (b), (c), 0, 0, 0)

#define NTOK 10240
#define NPROMPT 8192
#define DM 1024
#define DFF 2816
#define OUT_NK 10485760
#define OUT_NV 14680064
#define OUT_ST 18874368

constexpr size_t OFF_WTIN   = 0;
constexpr size_t OFF_WTOUT  = OFF_WTIN + 16777216;
constexpr size_t OFF_WT13   = OFF_WTOUT + 8388608;
constexpr size_t OFF_WT2    = OFF_WT13 + 46137344;
constexpr size_t OFF_MOD    = OFF_WT2 + 23068672;
constexpr size_t OFF_TAP256 = OFF_MOD + 294912;
constexpr size_t OFF_TAP1024 = OFF_TAP256 + 4194304;
constexpr size_t OFF_KCAT   = OFF_TAP1024 + 16777216;
constexpr size_t OFF_VTL    = OFF_KCAT + 2621440;
constexpr size_t OFF_HBF    = OFF_VTL + 2621440;
constexpr size_t OFF_QBF    = OFF_HBF + 20971520;
constexpr size_t OFF_KBF    = OFF_QBF + 10485760;
constexpr size_t OFF_VTP    = OFF_KBF + 2097152;
constexpr size_t OFF_PBUF   = OFF_VTP + 2097152;
constexpr size_t OFF_MIX    = OFF_PBUF + 52428800;
constexpr size_t OFF_UBF    = OFF_MIX + 20971520;
constexpr size_t OFF_ZBUF   = OFF_UBF + 57671680;
constexpr size_t OFF_CTR    = OFF_ZBUF + 10485760;
constexpr size_t OFF_PHY    = OFF_CTR + 16384;
constexpr size_t WS_TOTAL   = OFF_PHY + (size_t)64 * 10240 * 12 * 4;

struct Params {
  const float* in[31];
  float* out;
  char* ws;
};

#define LDS_BYTES 73728
#define LROW 144
#define LTILE (128 * 144)
#define LBUF (2 * LTILE)

DI bf16_t f2bf(float x) { unsigned u = __float_as_uint(x); u += 0x7fffu + ((u >> 16) & 1u); return (bf16_t)(u >> 16); }
DI unsigned pack2(float a, float b) { return (unsigned)f2bf(a) | ((unsigned)f2bf(b) << 16); }
DI size_t blk(int m, int k, int KTF) { return ((size_t)((m >> 7) * KTF + (k >> 6)) * 128 + (m & 127)) * 64 + (k & 63); }
DI int otid() { int t = threadIdx.x; asm volatile("" : "+v"(t)); return t; }
DI void sync_g() { asm volatile("s_waitcnt vmcnt(0)" ::: "memory"); __syncthreads(); }
#define CW_CNT(j) (64 * (1 + (j)))
#define CW_SUB(j) (64 * (17 + (j)))
#define CW_TOP (64 * 33)
#define CW_GEN (64 * 34)
#define CW_XGEN(j) (64 * (35 + (j)))
#define CTL_BYTES 16384
struct GBar { unsigned* w; unsigned x, nloc, nx, epoch; };
DI unsigned gb_ld(unsigned* p) { return __hip_atomic_load(p, __ATOMIC_RELAXED, __HIP_MEMORY_SCOPE_AGENT); }
DI unsigned gb_add(unsigned* p, unsigned v) { return __hip_atomic_fetch_add(p, v, __ATOMIC_RELAXED, __HIP_MEMORY_SCOPE_AGENT); }
DI void gsync1(GBar& g) {
  asm volatile("s_waitcnt vmcnt(0)" ::: "memory");
  __syncthreads();
  if (threadIdx.x == 0) {
    if (g.nloc == 0u) {
      for (;;) {
        unsigned sum = 0, cnt = 0, mine = 1;
        for (unsigned j = 0; j < 16; ++j) { const unsigned c = gb_ld(&g.w[CW_CNT(j)]); sum += c; cnt += (c > 0u) ? 1u : 0u; if (j == g.x) mine = c; }
        if (sum == gridDim.x) { g.nloc = mine; g.nx = cnt; break; }
        __builtin_amdgcn_s_sleep(1);
      }
    }
    g.epoch++;
    const unsigned old = gb_add(&g.w[CW_SUB(g.x)], 1u);
    if (old + 1u == g.epoch * g.nloc) {
      __builtin_amdgcn_fence(__ATOMIC_RELEASE, "agent");
      asm volatile("s_waitcnt vmcnt(0)" ::: "memory");
      const unsigned old2 = gb_add(&g.w[CW_TOP], 1u);
      if (old2 + 1u == g.epoch * g.nx) (void)gb_add(&g.w[CW_GEN], 1u);
    }
    while (gb_ld(&g.w[CW_GEN]) < g.epoch) __builtin_amdgcn_s_sleep(1);
    __builtin_amdgcn_fence(__ATOMIC_ACQUIRE, "agent");
    asm volatile("s_waitcnt vmcnt(0)" ::: "memory");
  }
  __syncthreads();
}
DI float fast_sigmoid(float x) { return __builtin_amdgcn_rcpf(1.f + __expf(-x)); }
DI float sigmoidf_(float x) { return 1.f / (1.f + __expf(-x)); }

DI void p0_transpose(const float* __restrict__ src, int K, int N, int kt, int nt, bf16_t* __restrict__ dst, int mode) {
  const int tid = otid();
  const int n = tid & 63, c = nt * 64 + n, k0 = kt * 128 + (tid >> 6) * 32;
  float v[32];
#pragma unroll
  for (int j = 0; j < 32; ++j) v[j] = src[(size_t)(k0 + j) * N + c];
  int nrow;
  if (mode == 0) nrow = c;
  else nrow = nt * 128 + (n >> 5) * 64 + (mode - 1) * 32 + (n & 31);
  uint4* d = (uint4*)(dst + blk(nrow, k0, K >> 6));
#pragma unroll
  for (int q = 0; q < 4; ++q)
    d[q] = make_uint4(pack2(v[8 * q], v[8 * q + 1]), pack2(v[8 * q + 2], v[8 * q + 3]), pack2(v[8 * q + 4], v[8 * q + 5]), pack2(v[8 * q + 6], v[8 * q + 7]));
}

DI void p0_mod(const Params& p, int l, int cc, float* lds) {
  const int tid = otid();
  float* s = lds;
  float* red = lds + 3072;
  for (int idx = tid; idx < 3072; idx += 256) {
    int ci = idx >> 10, k = idx & 1023;
    float v = (ci == 0) ? p.in[6][k] : p.in[5][(ci - 1) * 1024 + k];
    s[idx] = v / (1.f + expf(-v));
  }
  __syncthreads();
  const int col = tid & 63, kg = tid >> 6;
  const float* W = p.in[7] + (size_t)l * 1024 * 6144 + cc * 64 + col;
  float a0 = 0.f, a1 = 0.f, a2 = 0.f;
#pragma unroll 16
  for (int k = kg * 256; k < kg * 256 + 256; ++k) {
    float w = W[(size_t)k * 6144];
    a0 += s[k] * w; a1 += s[1024 + k] * w; a2 += s[2048 + k] * w;
  }
  red[(kg * 3 + 0) * 64 + col] = a0; red[(kg * 3 + 1) * 64 + col] = a1; red[(kg * 3 + 2) * 64 + col] = a2;
  __syncthreads();
  if (tid < 192) {
    int ci = tid >> 6, c = tid & 63;
    float v = red[(0 * 3 + ci) * 64 + c] + red[(1 * 3 + ci) * 64 + c] + red[(2 * 3 + ci) * 64 + c] + red[(3 * 3 + ci) * 64 + c];
    v += p.in[8][l * 6144 + cc * 64 + c];
    float* mod = (float*)(p.ws + OFF_MOD);
    mod[(l * 3 + ci) * 6144 + cc * 64 + c] = v;
  }
  __syncthreads();
}

DI void p0_taps(const Params& p, int l, int g, float* lds) {
  const int tid = otid();
  float* zf = lds;
  float* h1 = lds + 320;
  float* h2 = lds + 832;
  const int tt0 = g * 8;
  const int L = (tt0 < 256) ? 256 : 1024;
  const int tbase = (tt0 < 256) ? tt0 : tt0 - 256;
  const float invL = 1.f / (float)L;
  for (int idx = tid; idx < 264; idx += 256) {
    int ti = idx / 33, f = idx % 33;
    float t = (float)(tbase + ti);
    float v;
    if (f == 0) v = t * invL;
    else {
      int bi = (f - 1) & 15;
      float band = 1e-4f + (float)bi * ((15.f - 1e-4f) / 15.f);
      float ph = t * band * invL;
      ph -= floorf(ph);
      float ang = 6.283185307179586f * ph;
      v = (f <= 16) ? cosf(ang) : -sinf(ang);
    }
    zf[ti * 40 + f] = v;
  }
  __syncthreads();
  const float* w1 = p.in[20] + l * 33 * 64;
  const float* b1 = p.in[21] + l * 64;
  const float* w2 = p.in[22] + l * 64 * 64;
  const float* b2 = p.in[23] + l * 64;
  const float* w3 = p.in[24] + (size_t)l * 64 * 1024;
  const float* b3 = p.in[25] + l * 1024;
  for (int idx = tid; idx < 512; idx += 256) {
    int ti = idx >> 6, j = idx & 63;
    float a = b1[j];
#pragma unroll 11
    for (int f = 0; f < 33; ++f) a += zf[ti * 40 + f] * w1[f * 64 + j];
    h1[ti * 64 + j] = sinf(a);
  }
  __syncthreads();
  for (int idx = tid; idx < 512; idx += 256) {
    int ti = idx >> 6, j = idx & 63;
    float a = b2[j];
#pragma unroll 16
    for (int f = 0; f < 64; ++f) a += h1[ti * 64 + f] * w2[f * 64 + j];
    h2[ti * 64 + j] = sinf(a);
  }
  __syncthreads();
  float acc[4][8];
#pragma unroll
  for (int q = 0; q < 4; ++q)
#pragma unroll
    for (int ti = 0; ti < 8; ++ti) acc[q][ti] = 0.f;
#pragma unroll 8
  for (int i = 0; i < 64; ++i) {
    float w[4];
#pragma unroll
    for (int q = 0; q < 4; ++q) w[q] = w3[i * 1024 + q * 256 + tid];
#pragma unroll
    for (int ti = 0; ti < 8; ++ti) {
      float hv = h2[ti * 64 + i];
#pragma unroll
      for (int q = 0; q < 4; ++q) acc[q][ti] += hv * w[q];
    }
  }
  const int ch = tid;
  const float d0 = -3.0701134573253945f, d1 = -15.350567286626973f;
  const float delta = d0 + (float)ch * ((d1 - d0) / 255.f);
  bf16_t* tapbase = (L == 256) ? (bf16_t*)(p.ws + OFF_TAP256) + (size_t)l * 2 * 256 * 512
                               : (bf16_t*)(p.ws + OFF_TAP1024) + (size_t)l * 2 * 256 * 2048;
#pragma unroll
  for (int q = 0; q < 4; ++q) {
    const int order = q >> 1, side = q & 1;
    const float bb = b3[q * 256 + ch];
#pragma unroll
    for (int ti = 0; ti < 8; ++ti) {
      int t = tbase + ti;
      float tn = (float)t * invL;
      float val = (acc[q][ti] + bb) * expf(tn * delta);
      int x;
      if (side == 0) x = L + t;
      else { if (t == 0) { x = 0; val = 0.f; } else x = L - t; }
      tapbase[((size_t)order * 256 + ch) * 2 * L + (2 * L - 1 - x)] = f2bf(val);
    }
  }
  __syncthreads();
}

DI int kf_off(int key, int d) { return ((((key >> 5) * 4 + (d >> 4)) * 64 + ((d >> 3) & 1) * 32 + (key & 31)) << 3) + (d & 7); }
DI int vf_off(int key, int d) { return (((((key >> 5) * 2 + ((key >> 4) & 1)) * 2 + (d >> 5)) * 64 + ((key >> 2) & 1) * 32 + (d & 31)) << 3) + (key & 3) + 4 * ((key >> 3) & 1); }
DI void p0_cache(const Params& p, int it) {
  const int tid = otid();
  bf16_t* kcat = (bf16_t*)(p.ws + OFF_KCAT);
  bf16_t* vtl = (bf16_t*)(p.ws + OFF_VTL);
  for (int e = tid; e < 4096; e += 256) {
    int rr = it * 32 + (e >> 7), c = e & 127;
    int s = rr & 255, bl = rr >> 8, l = bl & 3, b = bl >> 2;
    float kv = p.in[2][(size_t)rr * 128 + c];
    float vv = p.in[3][(size_t)rr * 128 + c];
    const int kvh = c >> 6, d = c & 63;
    const size_t sb = (size_t)((l * 2 + b) * 2 + kvh) * (1280 * 64);
    kcat[sb + kf_off(s, d)] = f2bf(kv);
    vtl[sb + vf_off(s, d)] = f2bf(vv);
  }
}

DI void phase0(const Params& p, char* lds, int* s_item) {
  const int NTAP = 640, NMOD = 384, NCACHE = 64, NTR = 5760;
  const int total = NTAP + NMOD + NCACHE + NTR;
  int* ctr = (int*)(p.ws + OFF_CTR) + 16;
  const int tid = otid();
  for (;;) {
    if (tid == 0) *s_item = atomicAdd(ctr, 1);
    __syncthreads();
    const int it = *s_item;
    __syncthreads();
    if (it >= total) break;
    int r = it;
    if (r < NTAP) { p0_taps(p, r / 160, r % 160, (float*)lds); continue; }
    r -= NTAP;
    if (r < NMOD) { p0_mod(p, r / 96, r % 96, (float*)lds); continue; }
    r -= NMOD;
    if (r < NCACHE) { p0_cache(p, r); continue; }
    r -= NCACHE;
    int l = r / 1440; r %= 1440;
    if (r < 256) p0_transpose(p.in[11] + (size_t)l * 1024 * 2048, 1024, 2048, r / 32, r % 32, (bf16_t*)(p.ws + OFF_WTIN) + (size_t)l * 2048 * 1024, 0);
    else if (r < 384) { r -= 256; p0_transpose(p.in[27] + (size_t)l * 1024 * 1024, 1024, 1024, r / 16, r % 16, (bf16_t*)(p.ws + OFF_WTOUT) + (size_t)l * 1024 * 1024, 0); }
    else if (r < 736) { r -= 384; p0_transpose(p.in[28] + (size_t)l * 1024 * 2816, 1024, 2816, r / 44, r % 44, (bf16_t*)(p.ws + OFF_WT13) + (size_t)l * 5632 * 1024, 1); }
    else if (r < 1088) { r -= 736; p0_transpose(p.in[29] + (size_t)l * 1024 * 2816, 1024, 2816, r / 44, r % 44, (bf16_t*)(p.ws + OFF_WT13) + (size_t)l * 5632 * 1024, 2); }
    else { r -= 1088; p0_transpose(p.in[30] + (size_t)l * 2816 * 1024, 2816, 1024, r / 16, r % 16, (bf16_t*)(p.ws + OFF_WT2) + (size_t)l * 1024 * 2816, 0); }
  }
}

DI void norm_phase(const Params& p, int l, int which) {
  float* xbuf = p.out;
  bf16_t* hbf = (bf16_t*)(p.ws + OFF_HBF);
  const float* mod = (const float*)(p.ws + OFF_MOD);
  const float* nw = p.in[which ? 10 : 9] + l * 1024;
  const int tid_ = otid(); const int wave = tid_ >> 6, lane = tid_ & 63;
  const bool first = (l == 0 && which == 0);
  constexpr int RB = 5;
  const int nwaves = gridDim.x * 4;
  for (int row0 = blockIdx.x * 4 + wave; row0 < NTOK; row0 += nwaves * RB) {
    float4 v[RB][4];
#pragma unroll
    for (int j = 0; j < RB; ++j) {
      const int row = row0 + j * nwaves;
      if (row < NTOK) {
        const float* src;
        if (first) src = (row < NPROMPT) ? p.in[0] + (size_t)row * 1024 : p.in[1] + (size_t)(row - NPROMPT) * 1024;
        else src = xbuf + (size_t)row * 1024;
#pragma unroll
        for (int i = 0; i < 4; ++i) v[j][i] = *(const float4*)(src + i * 256 + lane * 4);
      } else {
#pragma unroll
        for (int i = 0; i < 4; ++i) v[j][i] = make_float4(0.f, 0.f, 0.f, 0.f);
      }
    }
#pragma unroll
    for (int j = 0; j < RB; ++j) {
      const int row = row0 + j * nwaves;
      if (row >= NTOK) break;
      float ss = 0.f;
#pragma unroll
      for (int i = 0; i < 4; ++i) ss += v[j][i].x * v[j][i].x + v[j][i].y * v[j][i].y + v[j][i].z * v[j][i].z + v[j][i].w * v[j][i].w;
#pragma unroll
      for (int o = 32; o >= 1; o >>= 1) ss += __shfl_xor(ss, o);
      const float rstd = rsqrtf(ss * (1.f / 1024.f) + 1e-6f);
      const int ci = (row < NPROMPT) ? 0 : 1 + ((row - NPROMPT) >> 10);
      const float* sh = mod + ((l * 3 + ci) * 6 + (which ? 3 : 0)) * 1024;
      const float* sc = sh + 1024;
#pragma unroll
      for (int i = 0; i < 4; ++i) {
        const int col = i * 256 + lane * 4;
        const float4 w4 = *(const float4*)(nw + col), s4 = *(const float4*)(sc + col), h4 = *(const float4*)(sh + col);
        const float y0 = v[j][i].x * rstd * w4.x * (1.f + s4.x) + h4.x;
        const float y1 = v[j][i].y * rstd * w4.y * (1.f + s4.y) + h4.y;
        const float y2 = v[j][i].z * rstd * w4.z * (1.f + s4.z) + h4.z;
        const float y3 = v[j][i].w * rstd * w4.w * (1.f + s4.w) + h4.w;
        *(uint2*)(hbf + blk(row, col, 16)) = make_uint2(pack2(y0, y1), pack2(y2, y3));
        if (first) *(float4*)(xbuf + (size_t)row * 1024 + col) = v[j][i];
      }
    }
  }
}

enum { EPI_IN = 0, EPI_RES = 1, EPI_FFN = 2 };

DI void epi_in(const Params& p, int l, int m0, int nt, const f32x16 (&acc)[2][2], char* lds) {
  const int tid = otid(), lane = tid & 63, wave = tid >> 6;
  const int wm = wave >> 1, wn = wave & 1, r = lane & 31, h = lane >> 5;
  float* Ct = (float*)lds;
#pragma unroll
  for (int i = 0; i < 2; ++i)
#pragma unroll
    for (int j = 0; j < 2; ++j)
#pragma unroll
      for (int reg = 0; reg < 16; ++reg) {
        int row = wm * 64 + i * 32 + (reg & 3) + 8 * (reg >> 2) + 4 * h;
        int col = wn * 64 + j * 32 + r;
        Ct[row * 132 + col] = acc[i][j][reg];
      }
  __syncthreads();
  const bool lat = (m0 >= NPROMPT);
  if (nt < 5) {
    const int row = tid >> 1, hh = tid & 1;
    float* src = Ct + row * 132 + hh * 64;
    float ss = 0.f;
#pragma unroll
    for (int d = 0; d < 64; d += 4) {
      float4 t = *(const float4*)(src + d);
      ss += t.x * t.x + t.y * t.y + t.z * t.z + t.w * t.w;
    }
    const float rstd = rsqrtf(ss * (1.f / 64.f) + 1e-6f);
    const float* nw = (nt < 4 ? p.in[12] : p.in[13]) + l * 64;
    const float osc = (nt < 4) ? 0.125f : 1.f;
    const int m = m0 + row;
    int pos = 0;
    if (lat) {
      pos = (m - NPROMPT) & 1023;
      const float pr = (float)(pos >> 6), pc = (float)(pos & 63);
#pragma unroll 1
      for (int d = 0; d < 16; ++d) {
        const float f = exp2f(-(float)d * 0.8304820237218406f);
        const float ar = pr * f, ac = pc * f;
        const float sr = __sinf(ar), cr = __cosf(ar), sc_ = __sinf(ac), cc_ = __cosf(ac);
        float x1 = src[d] * rstd * nw[d], x2 = src[d + 16] * rstd * nw[d + 16];
        src[d] = (x1 * cr - x2 * sr) * osc; src[d + 16] = (x2 * cr + x1 * sr) * osc;
        x1 = src[32 + d] * rstd * nw[32 + d]; x2 = src[48 + d] * rstd * nw[48 + d];
        src[32 + d] = (x1 * cc_ - x2 * sc_) * osc; src[48 + d] = (x2 * cc_ + x1 * sc_) * osc;
      }
    } else {
#pragma unroll
      for (int d = 0; d < 64; d += 4) {
        float4 t = *(const float4*)(src + d);
        float4 w = *(const float4*)(nw + d);
        t.x *= rstd * w.x * osc; t.y *= rstd * w.y * osc; t.z *= rstd * w.z * osc; t.w *= rstd * w.w * osc;
        *(float4*)(src + d) = t;
      }
    }
    if (nt < 4) {
      bf16_t* dst = (bf16_t*)(p.ws + OFF_QBF) + (size_t)m * 512 + (nt * 2 + hh) * 64;
#pragma unroll
      for (int d = 0; d < 64; d += 8) {
        float4 t0 = *(const float4*)(src + d), t1 = *(const float4*)(src + d + 4);
        *(uint4*)(dst + d) = make_uint4(pack2(t0.x, t0.y), pack2(t0.z, t0.w), pack2(t1.x, t1.y), pack2(t1.z, t1.w));
      }
    } else {
      bf16_t* dst;
      int key;
      if (!lat) {
        const int b = m >> 8, s = m & 255;
        float* nk = p.out + OUT_NK + ((size_t)((b * 4 + l) * 256 + s)) * 128 + hh * 64;
#pragma unroll
        for (int d = 0; d < 64; d += 4) *(float4*)(nk + d) = *(const float4*)(src + d);
        dst = (bf16_t*)(p.ws + OFF_KBF) + (size_t)(b * 2 + hh) * (256 * 64);
        key = s;
      } else {
        const int b2 = (m - NPROMPT) >> 10;
        dst = (bf16_t*)(p.ws + OFF_KCAT) + (size_t)((l * 2 + b2) * 2 + hh) * (1280 * 64);
        key = 256 + pos;
      }
#pragma unroll
      for (int d = 0; d < 64; d += 8) {
        float4 t0 = *(const float4*)(src + d), t1 = *(const float4*)(src + d + 4);
        *(uint4*)(dst + kf_off(key, d)) = make_uint4(pack2(t0.x, t0.y), pack2(t0.z, t0.w), pack2(t1.x, t1.y), pack2(t1.z, t1.w));
      }
    }
  } else if (nt == 5) {
    if (!lat) {
      const int row = tid >> 1, hf = tid & 1;
      const int m = m0 + row, b = m >> 8, s = m & 255;
      float* nv = p.out + OUT_NV + ((size_t)((b * 4 + l) * 256 + s)) * 128 + hf * 64;
      const float* src = Ct + row * 132 + hf * 64;
#pragma unroll
      for (int d = 0; d < 64; d += 4) *(float4*)(nv + d) = *(const float4*)(src + d);
    }
    {
      const int col = tid & 127, rh = tid >> 7;
      const int kvh = col >> 6, d = col & 63;
      bf16_t* dst;
      int kstart;
      if (!lat) {
        const int b = m0 >> 8, s0 = m0 & 255;
        dst = (bf16_t*)(p.ws + OFF_VTP) + (size_t)(b * 2 + kvh) * (256 * 64);
        kstart = s0 + rh * 64;
      } else {
        const int b2 = (m0 - NPROMPT) >> 10, s0 = (m0 - NPROMPT) & 1023;
        dst = (bf16_t*)(p.ws + OFF_VTL) + (size_t)((l * 2 + b2) * 2 + kvh) * (1280 * 64);
        kstart = 256 + s0 + rh * 64;
      }
      const float* src = Ct + (rh * 64) * 132 + col;
#pragma unroll
      for (int g = 0; g < 8; ++g) {
        const int kk0 = (g >> 2) * 32 + ((g >> 1) & 1) * 16 + (g & 1) * 4;
        *(uint4*)(dst + vf_off(kstart + kk0, d)) =
            make_uint4(pack2(src[(kk0 + 0) * 132], src[(kk0 + 1) * 132]), pack2(src[(kk0 + 2) * 132], src[(kk0 + 3) * 132]),
                       pack2(src[(kk0 + 8) * 132], src[(kk0 + 9) * 132]), pack2(src[(kk0 + 10) * 132], src[(kk0 + 11) * 132]));
      }
    }
  } else if (nt < 10) {
    const int row = tid >> 1, hf = tid & 1;
    float* dst = (float*)(p.ws + OFF_PBUF) + (size_t)(m0 + row) * 1280 + (nt * 128 - 768) + hf * 64;
    const float* src = Ct + row * 132 + hf * 64;
#pragma unroll
    for (int d = 0; d < 64; d += 4) *(float4*)(dst + d) = *(const float4*)(src + d);
  } else {
    const int row = tid >> 1, hf = tid & 1;
    const int sidx = (nt - 10) >> 1, cg0 = (((nt - 10) & 1) * 128 + hf * 64) >> 2;
    float* dst = (float*)(p.ws + OFF_PHY) + ((size_t)cg0 * NTOK + (m0 + row)) * 12 + sidx * 4;
    const float* src = Ct + row * 132 + hf * 64;
#pragma unroll
    for (int g = 0; g < 16; ++g) *(float4*)(dst + (size_t)g * NTOK * 12) = *(const float4*)(src + 4 * g);
  }
  __syncthreads();
}

template <int EPI>
DI void gemm_phase(const Params& p, int l, const bf16_t* A, int lda, const bf16_t* BT, int ldb, int K, int NT,
                           int modpart, char* lds, float gscale = 1.f, int KS = 1) {
  const int tid = otid(), lane = tid & 63, wave = tid >> 6;
  const int wm = wave >> 1, wn = wave & 1, r = lane & 31, h = lane >> 5;
  const int ntiles = 80 * NT * KS;
  const int KT = K / (64 * KS);
  const int woff = (tid >> 3) * LROW + (tid & 7) * 16;
  for (int t = blockIdx.x; t < ntiles; t += gridDim.x) {
    const int ks = t / (80 * NT), tt = t - ks * (80 * NT);
    const int mt = tt % 80, nt = tt / 80;
    const int m0 = mt * 128, n0 = nt * 128;
    f32x16 acc[2][2];
#pragma unroll
    for (int i = 0; i < 2; ++i)
#pragma unroll
      for (int j = 0; j < 2; ++j)
#pragma unroll
        for (int e = 0; e < 16; ++e) acc[i][j][e] = 0.f;
    const bf16_t* Ag = A + ((size_t)mt * (K >> 6) + ks * KT) * 8192 + tid * 8;
    const bf16_t* Bg = BT + ((size_t)nt * (K >> 6) + ks * KT) * 8192 + tid * 8;
    uint4 ra[2][4], rb[2][4];
#pragma unroll
    for (int i = 0; i < 4; ++i) {
      ra[0][i] = *(const uint4*)(Ag + i * 2048);
      rb[0][i] = *(const uint4*)(Bg + i * 2048);
    }
#pragma unroll
    for (int i = 0; i < 4; ++i) {
      *(uint4*)(lds + woff + i * 32 * LROW) = ra[0][i];
      *(uint4*)(lds + LTILE + woff + i * 32 * LROW) = rb[0][i];
    }
#pragma unroll
    for (int i = 0; i < 4; ++i) {
      asm volatile("global_load_dwordx4 %0, %1, off" : "=v"(ra[1][i]) : "v"(Ag + i * 2048 + 8192) : "memory");
      asm volatile("global_load_dwordx4 %0, %1, off" : "=v"(rb[1][i]) : "v"(Bg + i * 2048 + 8192) : "memory");
    }
    __syncthreads();
    for (int kt2 = 0; kt2 < KT; kt2 += 2) {
#pragma unroll
      for (int u = 0; u < 2; ++u) {
        const int kt = kt2 + u;
        const char* cur = lds + u * LBUF;
        char* nxt = lds + (u ^ 1) * LBUF;
        const int kn = (kt + 2 < KT) ? kt + 2 : KT - 1;
        asm volatile("s_waitcnt vmcnt(0)" ::: "memory");
#pragma unroll
        for (int i = 0; i < 4; ++i) {
          asm volatile("global_load_dwordx4 %0, %1, off" : "=v"(ra[u][i]) : "v"(Ag + i * 2048 + (size_t)kn * 8192) : "memory");
          asm volatile("global_load_dwordx4 %0, %1, off" : "=v"(rb[u][i]) : "v"(Bg + i * 2048 + (size_t)kn * 8192) : "memory");
        }
        __builtin_amdgcn_s_setprio(3);
#pragma unroll
        for (int st = 0; st < 4; ++st) {
          bf16x8 a0 = *(const bf16x8*)(cur + (wm * 64 + r) * LROW + st * 32 + h * 16);
          bf16x8 a1 = *(const bf16x8*)(cur + (wm * 64 + 32 + r) * LROW + st * 32 + h * 16);
          bf16x8 b0 = *(const bf16x8*)(cur + LTILE + (wn * 64 + r) * LROW + st * 32 + h * 16);
          bf16x8 b1 = *(const bf16x8*)(cur + LTILE + (wn * 64 + 32 + r) * LROW + st * 32 + h * 16);
          acc[0][0] = MFMA32(a0, b0, acc[0][0]);
          acc[0][1] = MFMA32(a0, b1, acc[0][1]);
          acc[1][0] = MFMA32(a1, b0, acc[1][0]);
          acc[1][1] = MFMA32(a1, b1, acc[1][1]);
          *(uint4*)(nxt + woff + st * 32 * LROW) = ra[u ^ 1][st];
          *(uint4*)(nxt + LTILE + woff + st * 32 * LROW) = rb[u ^ 1][st];
        }
        __builtin_amdgcn_s_setprio(0);
        __syncthreads();
      }
    }
    asm volatile("s_waitcnt vmcnt(0)" ::: "memory");
#pragma unroll
    for (int i = 0; i < 4; ++i) {
      typedef unsigned u32x4_t __attribute__((ext_vector_type(4)));
      const u32x4_t t0 = {ra[0][i].x, ra[0][i].y, ra[0][i].z, ra[0][i].w}, t1 = {rb[0][i].x, rb[0][i].y, rb[0][i].z, rb[0][i].w};
      const u32x4_t t2 = {ra[1][i].x, ra[1][i].y, ra[1][i].z, ra[1][i].w}, t3 = {rb[1][i].x, rb[1][i].y, rb[1][i].z, rb[1][i].w};
      asm volatile("" :: "v"(t0), "v"(t1), "v"(t2), "v"(t3));
    }
    if (EPI == EPI_IN) {
      epi_in(p, l, m0, nt, acc, lds);
    } else if (EPI == EPI_RES) {
      const int ci = (m0 < NPROMPT) ? 0 : 1 + ((m0 - NPROMPT) >> 10);
      const float* gate = (const float*)(p.ws + OFF_MOD) + ((l * 3 + ci) * 6 + modpart) * 1024;
      float* xbuf = p.out;
      if (KS > 1) {
#pragma unroll
        for (int j = 0; j < 2; ++j) {
          const int n = n0 + wn * 64 + j * 32 + r;
          const float g = gate[n] * gscale;
#pragma unroll
          for (int i = 0; i < 2; ++i)
#pragma unroll
            for (int reg = 0; reg < 16; ++reg) {
              const int m = m0 + wm * 64 + i * 32 + (reg & 3) + 8 * (reg >> 2) + 4 * h;
              (void)__hip_atomic_fetch_add(xbuf + (size_t)m * 1024 + n, g * acc[i][j][reg], __ATOMIC_RELAXED, __HIP_MEMORY_SCOPE_AGENT);
            }
        }
      } else {
        float* Ct = (float*)lds;
#pragma unroll
        for (int i = 0; i < 2; ++i)
#pragma unroll
          for (int j = 0; j < 2; ++j)
#pragma unroll
            for (int reg = 0; reg < 16; ++reg)
              Ct[(wm * 64 + i * 32 + (reg & 3) + 8 * (reg >> 2) + 4 * h) * 132 + wn * 64 + j * 32 + r] = acc[i][j][reg];
        __syncthreads();
#pragma unroll
        for (int i = 0; i < 16; ++i) {
          const int c = tid + 256 * i, row = c >> 5, c4 = (c & 31) * 4;
          const float4 a = *(const float4*)(Ct + row * 132 + c4);
          const float4 g = *(const float4*)(gate + n0 + c4);
          float4* xp = (float4*)(xbuf + (size_t)(m0 + row) * 1024 + n0 + c4);
          float4 xv = *xp;
          xv.x += gscale * g.x * a.x; xv.y += gscale * g.y * a.y; xv.z += gscale * g.z * a.z; xv.w += gscale * g.w * a.w;
          *xp = xv;
        }
        __syncthreads();
      }
    } else {
      bf16_t* st = (bf16_t*)lds + (wm * 64 + 4 * h) * 72 + wn * 32 + r;
#pragma unroll
      for (int i = 0; i < 2; ++i)
#pragma unroll
        for (int reg = 0; reg < 16; ++reg) {
          const float a = acc[i][0][reg], b = acc[i][1][reg];
          st[(i * 32 + (reg & 3) + 8 * (reg >> 2)) * 72] = f2bf(a * fast_sigmoid(a) * b);
        }
      __syncthreads();
      {
        bf16_t* ub = (bf16_t*)(p.ws + OFF_UBF) + ((size_t)mt * 44 + nt) * 8192;
#pragma unroll
        for (int i = 0; i < 4; ++i) {
          const int c = tid + 256 * i;
          *(uint4*)(ub + c * 8) = *(const uint4*)((const bf16_t*)lds + (c >> 3) * 72 + (c & 7) * 8);
        }
      }
      __syncthreads();
    }
  }
}

DI void attn_wave(const bf16_t* __restrict__ q, const bf16_t* __restrict__ kp, const bf16_t* __restrict__ vt, int nkeys, bf16_t* __restrict__ mixb, int qtok, int head) {
  const int lane = otid() & 63, r = lane & 31, h = lane >> 5;
  bf16x8 qf[4];
#pragma unroll
  for (int st = 0; st < 4; ++st) qf[st] = *(const bf16x8*)(q + (size_t)r * 512 + st * 16 + h * 8);
  f32x16 O[2];
#pragma unroll
  for (int e = 0; e < 16; ++e) { O[0][e] = 0.f; O[1][e] = 0.f; }
  float m = -1e30f, lsum = 0.f;
  bf16x8 kfr[2][4];
#pragma unroll
  for (int sub = 0; sub < 2; ++sub)
#pragma unroll
    for (int st = 0; st < 4; ++st) kfr[sub][st] = *(const bf16x8*)(kp + (size_t)(((sub * 4 + st) * 64 + lane) << 3));
  for (int k0 = 0; k0 < nkeys; k0 += 64) {
    f32x16 S[2];
#pragma unroll
    for (int sub = 0; sub < 2; ++sub) {
#pragma unroll
      for (int e = 0; e < 16; ++e) S[sub][e] = 0.f;
#pragma unroll
      for (int st = 0; st < 4; ++st) S[sub] = MFMA32(kfr[sub][st], qf[st], S[sub]);
    }
    {
      const int kn = (k0 + 64 < nkeys) ? k0 + 64 : k0;
#pragma unroll
      for (int sub = 0; sub < 2; ++sub)
#pragma unroll
        for (int st = 0; st < 4; ++st) kfr[sub][st] = *(const bf16x8*)(kp + (size_t)(((((kn >> 5) + sub) * 4 + st) * 64 + lane) << 3));
    }
    bf16x8 vfr[2][2][2];
#pragma unroll
    for (int sub = 0; sub < 2; ++sub)
#pragma unroll
      for (int s2 = 0; s2 < 2; ++s2)
#pragma unroll
        for (int dt = 0; dt < 2; ++dt)
          vfr[sub][s2][dt] = *(const bf16x8*)(vt + (size_t)((((((k0 >> 5) + sub) * 2 + s2) * 2 + dt) * 64 + lane) << 3));
    float mx = m;
#pragma unroll
    for (int sub = 0; sub < 2; ++sub)
#pragma unroll
      for (int e = 0; e < 16; ++e) mx = fmaxf(mx, S[sub][e]);
    mx = fmaxf(mx, __shfl_xor(mx, 32));
    const float alpha = __expf(m - mx);
    m = mx;
    float ps = 0.f;
#pragma unroll
    for (int sub = 0; sub < 2; ++sub)
#pragma unroll
      for (int e = 0; e < 16; ++e) { float pv = __expf(S[sub][e] - mx); S[sub][e] = pv; ps += pv; }
    lsum = lsum * alpha + ps;
#pragma unroll
    for (int e = 0; e < 16; ++e) { O[0][e] *= alpha; O[1][e] *= alpha; }
#pragma unroll
    for (int sub = 0; sub < 2; ++sub)
#pragma unroll
      for (int s = 0; s < 2; ++s) {
        union { unsigned u[4]; bf16x8 v; } pf;
#pragma unroll
        for (int j = 0; j < 4; ++j) pf.u[j] = pack2(S[sub][8 * s + 2 * j], S[sub][8 * s + 2 * j + 1]);
#pragma unroll
        for (int dt = 0; dt < 2; ++dt) O[dt] = MFMA32(vfr[sub][s][dt], pf.v, O[dt]);
      }
  }
  lsum += __shfl_xor(lsum, 32);
  const float inv = 1.f / lsum;
  bf16_t* ob = mixb + ((size_t)(qtok >> 7) * 16 + head) * 8192 + ((qtok & 127) + r) * 64;
#pragma unroll
  for (int dt = 0; dt < 2; ++dt)
#pragma unroll
    for (int g = 0; g < 4; ++g) {
      const int d = dt * 32 + 8 * g + 4 * h;
      *(uint2*)(ob + d) = make_uint2(pack2(O[dt][4 * g] * inv, O[dt][4 * g + 1] * inv), pack2(O[dt][4 * g + 2] * inv, O[dt][4 * g + 3] * inv));
    }
}

DI float gelu_tanh(float x) { return 0.5f * x * (1.f + tanhf(0.7978845608028654f * (x + 0.044715f * x * x * x))); }

#ifndef PROBE_BAR
#define PROBE_BAR 0
#endif
DI void gsync(GBar& g) { gsync1(g); if (PROBE_BAR) { gsync1(g); gsync1(g); } }
DI float fast_gelu(float x) {
  const float u = 0.7978845608028654f * (x + 0.044715f * x * x * x);
  const float th = 1.f - 2.f * __builtin_amdgcn_rcpf(1.f + __expf(2.f * u));
  return 0.5f * x * (1.f + th);
}

DI void lru_gate_item(const Params& p, int l, int mt, int n, char* lds) {
  const int tid = otid(), lane = tid & 63, wave = tid >> 6, r = lane & 31, h = lane >> 5;
  float* XC = (float*)lds;
  bf16_t* Axc = (bf16_t*)(lds + 32768);
  const int m0 = mt * 128;
  const int L = (m0 < NPROMPT) ? 256 : 1024;
  const int tb = (m0 < NPROMPT) ? (m0 & 255) : ((m0 - NPROMPT) & 1023);
  const float* pbuf = (const float*)(p.ws + OFF_PBUF);
  float2* ab = (float2*)(p.ws + OFF_UBF);
  {
    const int ch = tid & 63, tq = tid >> 6, gch = n * 64 + ch;
    float cw[4];
#pragma unroll
    for (int k = 0; k < 4; ++k) cw[k] = p.in[14][(l * 4 + k) * 256 + gch];
    const float cb = p.in[15][l * 256 + gch];
    float x[35];
#pragma unroll
    for (int i = 0; i < 35; ++i) {
      const int ts = tb + tq * 32 + i - 2;
      x[i] = (ts >= 0 && ts < L) ? pbuf[(size_t)(m0 - tb + ts) * 1280 + gch] : 0.f;
    }
#pragma unroll
    for (int e = 0; e < 32; ++e) {
      const float xv = cb + cw[0] * x[e] + cw[1] * x[e + 1] + cw[2] * x[e + 2] + cw[3] * x[e + 3];
      XC[(tq * 32 + e) * 64 + ch] = xv;
      Axc[(tq * 32 + e) * 72 + ch] = f2bf(xv);
    }
  }
  __syncthreads();
  {
    const int dir = wave & 1, half = wave >> 1;
    bf16x8 wf[2][2][4];
    float gb[2][2], sp[2];
#pragma unroll
    for (int g = 0; g < 2; ++g) {
      const float* W = p.in[16] + ((size_t)((l * 2 + dir) * 2 + g) * 4 + n) * 4096;
#pragma unroll
      for (int ct = 0; ct < 2; ++ct) {
        const int j = r + 32 * ct;
        gb[g][ct] = p.in[17][((l * 2 + dir) * 2 + g) * 256 + n * 64 + j];
#pragma unroll
        for (int st = 0; st < 4; ++st) {
          const int i0 = 16 * st + 8 * h;
          union { unsigned u[4]; bf16x8 v; } f;
#pragma unroll
          for (int jj = 0; jj < 4; ++jj) f.u[jj] = pack2(W[(i0 + 2 * jj) * 64 + j], W[(i0 + 2 * jj + 1) * 64 + j]);
          wf[g][ct][st] = f.v;
        }
      }
    }
#pragma unroll
    for (int ct = 0; ct < 2; ++ct) sp[ct] = log1pf(expf(-p.in[18][(l * 2 + dir) * 256 + n * 64 + r + 32 * ct]));
#pragma unroll 1
    for (int rt = 0; rt < 2; ++rt) {
      f32x16 acc[2][2];
#pragma unroll
      for (int e = 0; e < 16; ++e) { acc[0][0][e] = 0.f; acc[0][1][e] = 0.f; acc[1][0][e] = 0.f; acc[1][1][e] = 0.f; }
#pragma unroll
      for (int st = 0; st < 4; ++st) {
        const bf16x8 af = *(const bf16x8*)(Axc + (half * 64 + rt * 32 + r) * 72 + 16 * st + 8 * h);
        acc[0][0] = MFMA32(af, wf[0][0][st], acc[0][0]);
        acc[0][1] = MFMA32(af, wf[0][1][st], acc[0][1]);
        acc[1][0] = MFMA32(af, wf[1][0][st], acc[1][0]);
        acc[1][1] = MFMA32(af, wf[1][1][st], acc[1][1]);
      }
#pragma unroll
      for (int ct = 0; ct < 2; ++ct)
#pragma unroll
        for (int reg = 0; reg < 16; ++reg) {
          const int tok = half * 64 + rt * 32 + (reg & 3) + 8 * (reg >> 2) + 4 * h;
          const int j = r + 32 * ct;
          const float rr = fast_sigmoid(acc[0][ct][reg] + gb[0][ct]);
          const float ii = fast_sigmoid(acc[1][ct][reg] + gb[1][ct]);
          const float xv = XC[tok * 64 + j];
          const float a = __expf(-8.f * rr * sp[ct]);
          const float bb = __builtin_sqrtf(fmaxf(fmaf(-a, a, 1.f), 0.f)) * (ii * xv);
          ab[((size_t)dir * NTOK + m0 + tok) * 256 + n * 64 + j] = make_float2(a, bb);
        }
    }
  }
  __syncthreads();
}

template <int CGS>
DI void lru_scan_item(const Params& p, int l, int bidx, int cbase, char* lds) {
  constexpr int NSEG = 256 / CGS;
  const int tid = otid();
  const bool lat = bidx >= 32;
  const int L = lat ? 1024 : 256;
  const int tok0 = lat ? NPROMPT + (bidx - 32) * 1024 : bidx * 256;
  const int ch = tid % CGS, sg = tid / CGS, gch = cbase + ch;
  const int SEGL = L / NSEG;
  float2* SEG = (float2*)lds;
  const float2* ab = (const float2*)(p.ws + OFF_UBF);
  float* hfbuf = (float*)(p.ws + OFF_UBF + 41943040);
  const float* pbuf = (const float*)(p.ws + OFF_PBUF);
  bf16_t* mix = (bf16_t*)(p.ws + OFF_MIX);
  const float2* abf = ab + ((size_t)0 * NTOK + tok0 + sg * SEGL) * 256 + gch;
  const float2* abb = ab + ((size_t)1 * NTOK + tok0 + sg * SEGL) * 256 + gch;
  {
    float A = 1.f, B = 0.f;
#pragma unroll 16
    for (int i = 0; i < SEGL; ++i) { const float2 v = abf[(size_t)i * 256]; B = v.x * B + v.y; A *= v.x; }
    SEG[(0 * NSEG + sg) * CGS + ch] = make_float2(A, B);
    A = 1.f; B = 0.f;
#pragma unroll 16
    for (int i = SEGL - 1; i >= 0; --i) { const float2 v = abb[(size_t)i * 256]; B = v.x * B + v.y; A *= v.x; }
    SEG[(1 * NSEG + sg) * CGS + ch] = make_float2(A, B);
  }
  __syncthreads();
  float hf = lat ? p.in[4][(((bidx - 32) * 4 + l) * 2 + 0) * 256 + gch] : 0.f;
  float hb = lat ? p.in[4][(((bidx - 32) * 4 + l) * 2 + 1) * 256 + gch] : 0.f;
  for (int q = 0; q < sg; ++q) { const float2 v = SEG[(0 * NSEG + q) * CGS + ch]; hf = v.x * hf + v.y; }
  for (int q = NSEG - 1; q > sg; --q) { const float2 v = SEG[(1 * NSEG + q) * CGS + ch]; hb = v.x * hb + v.y; }
  if (!lat) {
    if (sg == NSEG - 1) { const float2 v = SEG[(0 * NSEG + NSEG - 1) * CGS + ch]; p.out[OUT_ST + ((size_t)(bidx * 4 + l) * 2 + 0) * 256 + gch] = v.x * hf + v.y; }
    if (sg == 0) { const float2 v = SEG[(1 * NSEG + 0) * CGS + ch]; p.out[OUT_ST + ((size_t)(bidx * 4 + l) * 2 + 1) * 256 + gch] = v.x * hb + v.y; }
  }
  float* hfp = hfbuf + (size_t)(tok0 + sg * SEGL) * 256 + gch;
  for (int i0 = 0; i0 < SEGL; i0 += 16) {
    float2 v[16];
#pragma unroll
    for (int j = 0; j < 16; ++j) v[j] = abf[(size_t)(i0 + j) * 256];
#pragma unroll
    for (int j = 0; j < 16; ++j) { hf = v[j].x * hf + v[j].y; hfp[(size_t)(i0 + j) * 256] = hf; }
  }
  const float* lg = pbuf + (size_t)(tok0 + sg * SEGL) * 1280 + 256 + gch;
  bf16_t* mp = mix + blk(tok0 + sg * SEGL, 512 + gch, 16);
  for (int i0 = SEGL - 16; i0 >= 0; i0 -= 16) {
    float2 v[16];
    float gv[16], fv[16];
#pragma unroll
    for (int j = 0; j < 16; ++j) {
      v[j] = abb[(size_t)(i0 + j) * 256];
      gv[j] = lg[(size_t)(i0 + j) * 1280];
      fv[j] = hfp[(size_t)(i0 + j) * 256];
    }
#pragma unroll
    for (int j = 15; j >= 0; --j) {
      hb = v[j].x * hb + v[j].y;
      mp[(size_t)(i0 + j) * 64] = f2bf(fast_gelu(gv[j]) * (fv[j] + hb));
    }
  }
  __syncthreads();
}

DI bf16x8 ld16u(const bf16_t* p) { bf16x8 v; __builtin_memcpy(&v, p, 16); return v; }
typedef unsigned u32x4v __attribute__((ext_vector_type(4)));
DI bf16x8 ld16_shift(const bf16_t* p8, int ds2, int ds1, unsigned hb) {
  const u32x4v c0 = *(const u32x4v*)p8, c1 = *(const u32x4v*)(p8 + 8);
  unsigned t0 = ds2 ? c0[2] : c0[0], t1 = ds2 ? c0[3] : c0[1], t2 = ds2 ? c1[0] : c0[2], t3 = ds2 ? c1[1] : c0[3], t4 = ds2 ? c1[2] : c1[0], t5 = ds2 ? c1[3] : c1[1];
  unsigned u0 = ds1 ? t1 : t0, u1 = ds1 ? t2 : t1, u2 = ds1 ? t3 : t2, u3 = ds1 ? t4 : t3, u4 = ds1 ? t5 : t4;
  union { unsigned u[4]; bf16x8 v; } r;
  r.u[0] = __builtin_amdgcn_alignbyte(u1, u0, hb); r.u[1] = __builtin_amdgcn_alignbyte(u2, u1, hb);
  r.u[2] = __builtin_amdgcn_alignbyte(u3, u2, hb); r.u[3] = __builtin_amdgcn_alignbyte(u4, u3, hb);
  return r.v;
}
DI float bf2f(bf16_t v) { return __uint_as_float((unsigned)v << 16); }
DI float conv3_at(const float* __restrict__ pb, int t, int L, float w0, float w1, float w2) {
  float v = w1 * pb[(size_t)t * 1280];
  if (t > 0) v += w0 * pb[(size_t)(t - 1) * 1280];
  if (t < L - 1) v += w2 * pb[(size_t)(t + 1) * 1280];
  return v;
}

template <int L>
DI void hy_item(const Params& p, int l, int tokbase, int c0, char* lds) {
  constexpr int NB = L / 32, NQ = 32 / NB, PADLEN = (3 * NB - 2) * 32;
  const int tid = otid(), lane = tid & 63, wave = tid >> 6, h = lane >> 5;
  bf16_t* UP = (bf16_t*)lds;
  float* X1 = (float*)(lds + 24576);
  float* X2 = (float*)(lds + 24576 + 16384);
  const float* phy = (const float*)(p.ws + OFF_PHY) + (size_t)(c0 >> 2) * NTOK * 12;
  const float* hcw = p.in[19] + l * 3 * 768 + c0;
  for (int idx = tid; idx < 4 * NQ * 2 * (NB - 1) * 32; idx += 256) {
    const int e = idx % ((NB - 1) * 32), s2 = (idx / ((NB - 1) * 32)) & 1, sq = idx / (2 * (NB - 1) * 32);
    UP[sq * PADLEN + (s2 ? (2 * NB - 1) * 32 : 0) + e] = 0;
  }
  {
    float4 w[3][3];
#pragma unroll
    for (int k = 0; k < 3; ++k)
#pragma unroll
      for (int sidx = 0; sidx < 3; ++sidx) w[k][sidx] = *(const float4*)(hcw + k * 768 + sidx * 256);
    for (int pr = tid; pr < NQ * L; pr += 256) {
      const int q = pr / L, t = pr % L;
      const float* row = phy + (size_t)(tokbase + q * L + t) * 12;
      float4 o[3];
#pragma unroll
      for (int sidx = 0; sidx < 3; ++sidx) {
        const float4 m = *(const float4*)(row + sidx * 4);
        o[sidx] = make_float4(w[1][sidx].x * m.x, w[1][sidx].y * m.y, w[1][sidx].z * m.z, w[1][sidx].w * m.w);
        if (t > 0) {
          const float4 a = *(const float4*)(row - 12 + sidx * 4);
          o[sidx].x += w[0][sidx].x * a.x; o[sidx].y += w[0][sidx].y * a.y; o[sidx].z += w[0][sidx].z * a.z; o[sidx].w += w[0][sidx].w * a.w;
        }
        if (t < L - 1) {
          const float4 c = *(const float4*)(row + 12 + sidx * 4);
          o[sidx].x += w[2][sidx].x * c.x; o[sidx].y += w[2][sidx].y * c.y; o[sidx].z += w[2][sidx].z * c.z; o[sidx].w += w[2][sidx].w * c.w;
        }
      }
      const int ui = q * PADLEN + (NB - 1) * 32 + t;
      UP[(0 * NQ) * PADLEN + ui] = f2bf(o[0].x); UP[(1 * NQ) * PADLEN + ui] = f2bf(o[0].y);
      UP[(2 * NQ) * PADLEN + ui] = f2bf(o[0].z); UP[(3 * NQ) * PADLEN + ui] = f2bf(o[0].w);
      X1[0 * NQ * L + pr] = o[1].x; X1[1 * NQ * L + pr] = o[1].y; X1[2 * NQ * L + pr] = o[1].z; X1[3 * NQ * L + pr] = o[1].w;
      X2[0 * NQ * L + pr] = o[2].x; X2[1 * NQ * L + pr] = o[2].y; X2[2 * NQ * L + pr] = o[2].z; X2[3 * NQ * L + pr] = o[2].w;
    }
  }
  __syncthreads();
  {
    const int c = c0 + wave;
    const int col = lane & 31, q = col / NB, T = col % NB;
    bf16_t* U = UP + wave * NQ * PADLEN;
    const bf16_t* rv0 = ((L == 256) ? (const bf16_t*)(p.ws + OFF_TAP256) + (size_t)l * 2 * 256 * 512
                                    : (const bf16_t*)(p.ws + OFF_TAP1024) + (size_t)l * 2 * 256 * 2048) + (size_t)c * 2 * L;
    const bf16_t* rv1 = rv0 + (size_t)256 * 2 * L;
    const int aoff_u = L - 1 - (lane & 31) + 8 * h;
    const int ash = aoff_u & 7, aoff = aoff_u - ash;
    const int ds2 = (ash >> 2) & 1, ds1 = (ash >> 1) & 1; const unsigned hb = (ash & 1) * 2;
    const int boff = q * PADLEN + 32 * (T + NB - 1) + 8 * h;
    const int uo = q * PADLEN + (NB - 1) * 32 + 32 * T + 4 * h;
    const int xo = wave * NQ * L + q * L + 32 * T + 4 * h;
    const float skip0 = p.in[26][(l * 2 + 0) * 256 + c], skip1 = p.in[26][(l * 2 + 1) * 256 + c];
    f32x16 acc;
#pragma unroll
    for (int e = 0; e < 16; ++e) acc[e] = 0.f;
    f32x16 accB;
#pragma unroll
    for (int e = 0; e < 16; ++e) accB[e] = 0.f;
#pragma unroll 5
    for (int D = -(NB - 1); D <= NB - 1; ++D) {
      const int off = -32 * D;
      const bf16x8 a0 = ld16_shift(rv0 + aoff + off, ds2, ds1, hb), a1 = ld16_shift(rv0 + aoff + off + 16, ds2, ds1, hb);
      const bf16x8 b0 = *(const bf16x8*)(U + boff + off), b1 = *(const bf16x8*)(U + boff + off + 16);
      acc = MFMA32(a0, b0, acc);
      accB = MFMA32(a1, b1, accB);
    }
#pragma unroll
    for (int e = 0; e < 16; ++e) acc[e] += accB[e];
    float z[16];
#pragma unroll
    for (int g = 0; g < 4; ++g) {
      const uint2 vv = *(const uint2*)(U + uo + 8 * g);
      const float4 x1 = *(const float4*)(X1 + xo + 8 * g);
      z[4 * g + 0] = x1.x * (acc[4 * g + 0] + skip0 * __uint_as_float(vv.x << 16));
      z[4 * g + 1] = x1.y * (acc[4 * g + 1] + skip0 * __uint_as_float(vv.x & 0xffff0000u));
      z[4 * g + 2] = x1.z * (acc[4 * g + 2] + skip0 * __uint_as_float(vv.y << 16));
      z[4 * g + 3] = x1.w * (acc[4 * g + 3] + skip0 * __uint_as_float(vv.y & 0xffff0000u));
    }
    __builtin_amdgcn_wave_barrier();
#pragma unroll
    for (int g = 0; g < 4; ++g)
      *(uint2*)(U + uo + 8 * g) = make_uint2(pack2(z[4 * g], z[4 * g + 1]), pack2(z[4 * g + 2], z[4 * g + 3]));
    __builtin_amdgcn_wave_barrier();
#pragma unroll
    for (int e = 0; e < 16; ++e) acc[e] = 0.f;
#pragma unroll
    for (int e = 0; e < 16; ++e) accB[e] = 0.f;
#pragma unroll 5
    for (int D = -(NB - 1); D <= NB - 1; ++D) {
      const int off = -32 * D;
      const bf16x8 a0 = ld16_shift(rv1 + aoff + off, ds2, ds1, hb), a1 = ld16_shift(rv1 + aoff + off + 16, ds2, ds1, hb);
      const bf16x8 b0 = *(const bf16x8*)(U + boff + off), b1 = *(const bf16x8*)(U + boff + off + 16);
      acc = MFMA32(a0, b0, acc);
      accB = MFMA32(a1, b1, accB);
    }
#pragma unroll
    for (int e = 0; e < 16; ++e) acc[e] += accB[e];
    bf16_t* OUT = (bf16_t*)(lds + 57344) + (size_t)(q * L + 32 * T + 4 * h) * 4 + wave;
#pragma unroll
    for (int g = 0; g < 4; ++g) {
      const float4 x2 = *(const float4*)(X2 + xo + 8 * g);
      OUT[(8 * g + 0) * 4] = f2bf(x2.x * (acc[4 * g + 0] + skip1 * z[4 * g + 0]));
      OUT[(8 * g + 1) * 4] = f2bf(x2.y * (acc[4 * g + 1] + skip1 * z[4 * g + 1]));
      OUT[(8 * g + 2) * 4] = f2bf(x2.z * (acc[4 * g + 2] + skip1 * z[4 * g + 2]));
      OUT[(8 * g + 3) * 4] = f2bf(x2.w * (acc[4 * g + 3] + skip1 * z[4 * g + 3]));
    }
  }
  __syncthreads();
  {
    const uint2* OUTv = (const uint2*)(lds + 57344);
    bf16_t* mix = (bf16_t*)(p.ws + OFF_MIX);
    for (int idx = tid; idx < NQ * L; idx += 256) *(uint2*)(mix + blk(tokbase + idx, 768 + c0, 16)) = OUTv[idx];
  }
  __syncthreads();
}

DI void mixer_phase(const Params& p, int l, int sub, char* lds, int* s_item, int rep = 0) {
  const int tid = otid(), wave = tid >> 6;
  int* ctr = (int*)(p.ws + OFF_CTR) + l * 2 + sub + rep * 8;
  bf16_t* mix = (bf16_t*)(p.ws + OFF_MIX);
  const bf16_t* qbf = (const bf16_t*)(p.ws + OFF_QBF);
  const int nitems = sub ? 672 : 1088;
  for (;;) {
    if (tid == 0) *s_item = atomicAdd(ctr, 1);
    __syncthreads();
    const int it = *s_item;
    __syncthreads();
    if (it >= nitems) break;
    if (sub == 0) {
      if (it < 128) {
        const int j = it;
        hy_item<1024>(p, l, NPROMPT + (j >> 6) * 1024, (j & 63) * 4, lds);
      } else if (it < 256) {
        const int j = it - 128, b2 = j >> 6, head = (j >> 3) & 7, qb = j & 7, kvh = head >> 2;
        const int qtok = NPROMPT + b2 * 1024 + qb * 128 + wave * 32;
        attn_wave(qbf + (size_t)qtok * 512 + head * 64,
                  (const bf16_t*)(p.ws + OFF_KCAT) + (size_t)((l * 2 + b2) * 2 + kvh) * (1280 * 64),
                  (const bf16_t*)(p.ws + OFF_VTL) + (size_t)((l * 2 + b2) * 2 + kvh) * (1280 * 64), 1280,
                  mix, qtok, head);
      } else if (it < 576) {
        const int j = it - 256;
        lru_gate_item(p, l, j >> 2, j & 3, lds);
      } else {
        const int j = it - 576;
        hy_item<256>(p, l, (j >> 6) * 1024, (j & 63) * 4, lds);
      }
    } else {
      if (it < 32) {
        lru_scan_item<16>(p, l, 32 + (it >> 4), (it & 15) * 16, lds);
      } else if (it < 160) {
        const int j = it - 32;
        lru_scan_item<64>(p, l, j >> 2, (j & 3) * 64, lds);
      } else {
        const int j = it - 160, b = j >> 4, head = (j >> 1) & 7, qb = j & 1, kvh = head >> 2;
        const int qtok = b * 256 + qb * 128 + wave * 32;
        attn_wave(qbf + (size_t)qtok * 512 + head * 64,
                  (const bf16_t*)(p.ws + OFF_KBF) + (size_t)(b * 2 + kvh) * (256 * 64),
                  (const bf16_t*)(p.ws + OFF_VTP) + (size_t)(b * 2 + kvh) * (256 * 64), 256,
                  mix, qtok, head);
      }
    }
  }
}

#ifndef PROBE_P0
#define PROBE_P0 0
#endif
#ifndef PROBE_DG
#define PROBE_DG 0
#endif
#ifndef PROBE_MIX
#define PROBE_MIX 0
#endif
#ifndef PROBE_DUP
#define PROBE_DUP 0
#endif
#ifndef PHASE_SEL
#define PHASE_SEL -1
#endif
#define PSEL(k) (PHASE_SEL < 0 || PHASE_SEL == (k))
#ifndef STOP_P
#define STOP_P -1
#endif
#ifndef STOP_L
#define STOP_L 0
#endif
#define STOPAT(k) if (STOP_P == (k) && l == STOP_L) return;
__global__ void __launch_bounds__(256, 2) fwd_megakernel(Params p) {
  cg::grid_group grid = cg::this_grid();
  __shared__ __attribute__((aligned(16))) char lds[LDS_BYTES];
  __shared__ int s_item;
  GBar gbar;
  gbar.w = (unsigned*)(p.ws + OFF_CTR);
  gbar.x = (unsigned)__builtin_amdgcn_s_getreg((3 << 11) | 20) & 0xFu;
  gbar.epoch = 0; gbar.nloc = 1; gbar.nx = 1;
  if (threadIdx.x == 0) (void)gb_add(&gbar.w[CW_CNT(gbar.x)], 1u);
  if (p.ws == nullptr) grid.sync();
  gbar.nloc = 0;
  if (PSEL(0)) phase0(p, lds, &s_item);
  gsync(gbar);
#if PROBE_P0
#endif
  const bf16_t* hbf = (const bf16_t*)(p.ws + OFF_HBF);
  for (int l = 0; l < 4; ++l) {
    if (PSEL(1)) norm_phase(p, l, 0);
    gsync(gbar);
    STOPAT(1)
    if (PSEL(2)) gemm_phase<EPI_IN>(p, l, hbf, 1024, (const bf16_t*)(p.ws + OFF_WTIN) + (size_t)l * 2048 * 1024, 1024, 1024, 16, 0, lds);
    gsync(gbar);
#if PROBE_DUP
    gemm_phase<EPI_IN>(p, l, hbf, 1024, (const bf16_t*)(p.ws + OFF_WTIN) + (size_t)l * 2048 * 1024, 1024, 1024, 16, 0, lds);
    gsync(gbar);
#endif
    STOPAT(2)
    if (PSEL(3)) mixer_phase(p, l, 0, lds, &s_item);
    gsync(gbar);
    if (PSEL(3)) mixer_phase(p, l, 1, lds, &s_item);
    gsync(gbar);
#if PROBE_MIX
    mixer_phase(p, l, 0, lds, &s_item, 1);
    gsync(gbar);
    mixer_phase(p, l, 1, lds, &s_item, 1);
    gsync(gbar);
#endif
    STOPAT(3)
    if (PSEL(4)) gemm_phase<EPI_RES>(p, l, (const bf16_t*)(p.ws + OFF_MIX), 1024, (const bf16_t*)(p.ws + OFF_WTOUT) + (size_t)l * 1024 * 1024, 1024, 1024, 8, 2, lds, 1.f, 1);
    gsync(gbar);
#if PROBE_DG
    gemm_phase<EPI_RES>(p, l, (const bf16_t*)(p.ws + OFF_MIX), 1024, (const bf16_t*)(p.ws + OFF_WTOUT) + (size_t)l * 1024 * 1024, 1024, 1024, 8, 2, lds, 0.f);
    gsync(gbar);
#endif
    STOPAT(4)
    if (PSEL(1)) norm_phase(p, l, 1);
    gsync(gbar);
    STOPAT(5)
    if (PSEL(5)) gemm_phase<EPI_FFN>(p, l, hbf, 1024, (const bf16_t*)(p.ws + OFF_WT13) + (size_t)l * 5632 * 1024, 1024, 1024, 44, 0, lds);
    gsync(gbar);
#if PROBE_DUP
    gemm_phase<EPI_FFN>(p, l, hbf, 1024, (const bf16_t*)(p.ws + OFF_WT13) + (size_t)l * 5632 * 1024, 1024, 1024, 44, 0, lds);
    gsync(gbar);
#endif
    STOPAT(6)
    if (PSEL(4)) gemm_phase<EPI_RES>(p, l, (const bf16_t*)(p.ws + OFF_UBF), DFF, (const bf16_t*)(p.ws + OFF_WT2) + (size_t)l * 1024 * DFF, DFF, DFF, 8, 5, lds, 1.f, 1);
    if (l < 3) gsync(gbar);
#if PROBE_DG
    gemm_phase<EPI_RES>(p, l, (const bf16_t*)(p.ws + OFF_UBF), DFF, (const bf16_t*)(p.ws + OFF_WT2) + (size_t)l * 1024 * DFF, DFF, DFF, 8, 5, lds, 0.f);
    gsync(gbar);
#endif
    STOPAT(7)
  }
}

#ifndef MULTI_LAUNCH
#define MULTI_LAUNCH 0
#endif
__global__ void __launch_bounds__(256, 2) phase_kernel(Params p, int phase, int l) {
  __shared__ __attribute__((aligned(16))) char lds[LDS_BYTES];
  __shared__ int s_item;
  const bf16_t* hbf = (const bf16_t*)(p.ws + OFF_HBF);
  switch (phase) {
    case 0: phase0(p, lds, &s_item); break;
    case 1: norm_phase(p, l, 0); break;
    case 2: gemm_phase<EPI_IN>(p, l, hbf, 1024, (const bf16_t*)(p.ws + OFF_WTIN) + (size_t)l * 2048 * 1024, 1024, 1024, 16, 0, lds); break;
    case 3: mixer_phase(p, l, 0, lds, &s_item); break;
    case 8: mixer_phase(p, l, 1, lds, &s_item); break;
    case 4: gemm_phase<EPI_RES>(p, l, (const bf16_t*)(p.ws + OFF_MIX), 1024, (const bf16_t*)(p.ws + OFF_WTOUT) + (size_t)l * 1024 * 1024, 1024, 1024, 8, 2, lds); break;
    case 5: norm_phase(p, l, 1); break;
    case 6: gemm_phase<EPI_FFN>(p, l, hbf, 1024, (const bf16_t*)(p.ws + OFF_WT13) + (size_t)l * 5632 * 1024, 1024, 1024, 44, 0, lds); break;
    default: gemm_phase<EPI_RES>(p, l, (const bf16_t*)(p.ws + OFF_UBF), DFF, (const bf16_t*)(p.ws + OFF_WT2) + (size_t)l * 1024 * DFF, DFF, DFF, 8, 5, lds); break;
  }
}

extern "C" void kernel_launch(void* const* d_in, const int* in_sizes, int n_in, void* d_out, int out_size, void* d_ws, size_t ws_size,
                              hipStream_t stream) {
  static int grid_blocks = 0;
  if (!grid_blocks) {
    int dev = 0, cus = 0, per_cu = 0;
    hipGetDevice(&dev);
    hipDeviceGetAttribute(&cus, hipDeviceAttributeMultiprocessorCount, dev);
    hipOccupancyMaxActiveBlocksPerMultiprocessor(&per_cu, fwd_megakernel, 256, 0);
    if (per_cu > 2) per_cu = 2;
    if (per_cu < 1) per_cu = 1;
    grid_blocks = cus * per_cu;
  }
  Params p{};
  for (int i = 0; i < 31; ++i) p.in[i] = (const float*)d_in[i];
  p.out = (float*)d_out;
  p.ws = (char*)d_ws;
  (void)hipMemsetAsync((char*)d_ws + OFF_CTR, 0, CTL_BYTES, stream);
#if MULTI_LAUNCH
  hipLaunchKernelGGL(phase_kernel, dim3(512), dim3(256), 0, stream, p, 0, 0);
  for (int l = 0; l < 4; ++l)
    for (int ph = 1; ph <= 7; ++ph) hipLaunchKernelGGL(phase_kernel, dim3(512), dim3(256), 0, stream, p, ph, l);
  return;
#endif
  void* args[] = {&p};
  hipError_t e = hipLaunchCooperativeKernel((void*)fwd_megakernel, dim3(grid_blocks), dim3(256), args, 0, stream);
  if (e != hipSuccess) fprintf(stderr, "cooperative launch failed: %s (grid %d)\n", hipGetErrorString(e), grid_blocks);
}
```

```cpp
#include <hip/hip_runtime.h>
#include <hip/hip_cooperative_groups.h>
#include <stdint.h>
#include <cstdio>
namespace cg = cooperative_groups;

typedef __attribute__((ext_vector_type(8))) short bf16x8;
typedef __attribute__((ext_vector_type(16))) float f32x16;
typedef unsigned short bf16_t;
#define DI __device__ __forceinline__
#define MFMA32(a, b, c) __builtin_amdgcn_mfma_f32_32x32x16_bf16((a), (b), (c), 0, 0, 0)

#define NTOK 10240
#define NPROMPT 8192
#define DM 1024
#define DFF 2816
#define OUT_NK 10485760
#define OUT_NV 14680064
#define OUT_ST 18874368

constexpr size_t OFF_WTIN   = 0;
constexpr size_t OFF_WTOUT  = OFF_WTIN + 16777216;
constexpr size_t OFF_WT13   = OFF_WTOUT + 8388608;
constexpr size_t OFF_WT2    = OFF_WT13 + 46137344;
constexpr size_t OFF_MOD    = OFF_WT2 + 23068672;
constexpr size_t OFF_TAP256 = OFF_MOD + 294912;
constexpr size_t OFF_TAP1024 = OFF_TAP256 + 4194304;
constexpr size_t OFF_KCAT   = OFF_TAP1024 + 16777216;
constexpr size_t OFF_VTL    = OFF_KCAT + 2621440;
constexpr size_t OFF_HBF    = OFF_VTL + 2621440;
constexpr size_t OFF_QBF    = OFF_HBF + 20971520;
constexpr size_t OFF_KBF    = OFF_QBF + 10485760;
constexpr size_t OFF_VTP    = OFF_KBF + 2097152;
constexpr size_t OFF_PBUF   = OFF_VTP + 2097152;
constexpr size_t OFF_MIX    = OFF_PBUF + 52428800;
constexpr size_t OFF_UBF    = OFF_MIX + 20971520;
constexpr size_t OFF_ZBUF   = OFF_UBF + 57671680;
constexpr size_t OFF_CTR    = OFF_ZBUF + 10485760;
constexpr size_t OFF_PHY    = OFF_CTR + 16384;
constexpr size_t WS_TOTAL   = OFF_PHY + (size_t)64 * 10240 * 12 * 4;

struct Params {
  const float* in[31];
  float* out;
  char* ws;
};

#define LDS_BYTES 73728
#define LROW 144
#define LTILE (128 * 144)
#define LBUF (2 * LTILE)

DI bf16_t f2bf(float x) { unsigned u = __float_as_uint(x); u += 0x7fffu + ((u >> 16) & 1u); return (bf16_t)(u >> 16); }
DI unsigned pack2(float a, float b) { return (unsigned)f2bf(a) | ((unsigned)f2bf(b) << 16); }
DI size_t blk(int m, int k, int KTF) { return ((size_t)((m >> 7) * KTF + (k >> 6)) * 128 + (m & 127)) * 64 + (k & 63); }
DI int otid() { int t = threadIdx.x; asm volatile("" : "+v"(t)); return t; }
DI void sync_g() { asm volatile("s_waitcnt vmcnt(0)" ::: "memory"); __syncthreads(); }
#define CW_CNT(j) (64 * (1 + (j)))
#define CW_SUB(j) (64 * (17 + (j)))
#define CW_TOP (64 * 33)
#define CW_GEN (64 * 34)
#define CW_XGEN(j) (64 * (35 + (j)))
#define CTL_BYTES 16384
struct GBar { unsigned* w; unsigned x, nloc, nx, epoch; };
DI unsigned gb_ld(unsigned* p) { return __hip_atomic_load(p, __ATOMIC_RELAXED, __HIP_MEMORY_SCOPE_AGENT); }
DI unsigned gb_add(unsigned* p, unsigned v) { return __hip_atomic_fetch_add(p, v, __ATOMIC_RELAXED, __HIP_MEMORY_SCOPE_AGENT); }
DI void gsync1(GBar& g) {
  asm volatile("s_waitcnt vmcnt(0)" ::: "memory");
  __syncthreads();
  if (threadIdx.x == 0) {
    if (g.nloc == 0u) {
      for (;;) {
        unsigned sum = 0, cnt = 0, mine = 1;
        for (unsigned j = 0; j < 16; ++j) { const unsigned c = gb_ld(&g.w[CW_CNT(j)]); sum += c; cnt += (c > 0u) ? 1u : 0u; if (j == g.x) mine = c; }
        if (sum == gridDim.x) { g.nloc = mine; g.nx = cnt; break; }
        __builtin_amdgcn_s_sleep(1);
      }
    }
    g.epoch++;
    const unsigned old = gb_add(&g.w[CW_SUB(g.x)], 1u);
    if (old + 1u == g.epoch * g.nloc) {
      __builtin_amdgcn_fence(__ATOMIC_RELEASE, "agent");
      asm volatile("s_waitcnt vmcnt(0)" ::: "memory");
      const unsigned old2 = gb_add(&g.w[CW_TOP], 1u);
      if (old2 + 1u == g.epoch * g.nx) (void)gb_add(&g.w[CW_GEN], 1u);
    }
    while (gb_ld(&g.w[CW_GEN]) < g.epoch) __builtin_amdgcn_s_sleep(1);
    __builtin_amdgcn_fence(__ATOMIC_ACQUIRE, "agent");
    asm volatile("s_waitcnt vmcnt(0)" ::: "memory");
  }
  __syncthreads();
}
DI float fast_sigmoid(float x) { return __builtin_amdgcn_rcpf(1.f + __expf(-x)); }
DI float sigmoidf_(float x) { return 1.f / (1.f + __expf(-x)); }

DI void p0_transpose(const float* __restrict__ src, int K, int N, int kt, int nt, bf16_t* __restrict__ dst, int mode) {
  const int tid = otid();
  const int n = tid & 63, c = nt * 64 + n, k0 = kt * 128 + (tid >> 6) * 32;
  float v[32];
#pragma unroll
  for (int j = 0; j < 32; ++j) v[j] = src[(size_t)(k0 + j) * N + c];
  int nrow;
  if (mode == 0) nrow = c;
  else nrow = nt * 128 + (n >> 5) * 64 + (mode - 1) * 32 + (n & 31);
  uint4* d = (uint4*)(dst + blk(nrow, k0, K >> 6));
#pragma unroll
  for (int q = 0; q < 4; ++q)
    d[q] = make_uint4(pack2(v[8 * q], v[8 * q + 1]), pack2(v[8 * q + 2], v[8 * q + 3]), pack2(v[8 * q + 4], v[8 * q + 5]), pack2(v[8 * q + 6], v[8 * q + 7]));
}

DI void p0_mod(const Params& p, int l, int cc, float* lds) {
  const int tid = otid();
  float* s = lds;
  float* red = lds + 3072;
  for (int idx = tid; idx < 3072; idx += 256) {
    int ci = idx >> 10, k = idx & 1023;
    float v = (ci == 0) ? p.in[6][k] : p.in[5][(ci - 1) * 1024 + k];
    s[idx] = v / (1.f + expf(-v));
  }
  __syncthreads();
  const int col = tid & 63, kg = tid >> 6;
  const float* W = p.in[7] + (size_t)l * 1024 * 6144 + cc * 64 + col;
  float a0 = 0.f, a1 = 0.f, a2 = 0.f;
#pragma unroll 16
  for (int k = kg * 256; k < kg * 256 + 256; ++k) {
    float w = W[(size_t)k * 6144];
    a0 += s[k] * w; a1 += s[1024 + k] * w; a2 += s[2048 + k] * w;
  }
  red[(kg * 3 + 0) * 64 + col] = a0; red[(kg * 3 + 1) * 64 + col] = a1; red[(kg * 3 + 2) * 64 + col] = a2;
  __syncthreads();
  if (tid < 192) {
    int ci = tid >> 6, c = tid & 63;
    float v = red[(0 * 3 + ci) * 64 + c] + red[(1 * 3 + ci) * 64 + c] + red[(2 * 3 + ci) * 64 + c] + red[(3 * 3 + ci) * 64 + c];
    v += p.in[8][l * 6144 + cc * 64 + c];
    float* mod = (float*)(p.ws + OFF_MOD);
    mod[(l * 3 + ci) * 6144 + cc * 64 + c] = v;
  }
  __syncthreads();
}

DI void p0_taps(const Params& p, int l, int g, float* lds) {
  const int tid = otid();
  float* zf = lds;
  float* h1 = lds + 320;
  float* h2 = lds + 832;
  const int tt0 = g * 8;
  const int L = (tt0 < 256) ? 256 : 1024;
  const int tbase = (tt0 < 256) ? tt0 : tt0 - 256;
  const float invL = 1.f / (float)L;
  for (int idx = tid; idx < 264; idx += 256) {
    int ti = idx / 33, f = idx % 33;
    float t = (float)(tbase + ti);
    float v;
    if (f == 0) v = t * invL;
    else {
      int bi = (f - 1) & 15;
      float band = 1e-4f + (float)bi * ((15.f - 1e-4f) / 15.f);
      float ph = t * band * invL;
      ph -= floorf(ph);
      float ang = 6.283185307179586f * ph;
      v = (f <= 16) ? cosf(ang) : -sinf(ang);
    }
    zf[ti * 40 + f] = v;
  }
  __syncthreads();
  const float* w1 = p.in[20] + l * 33 * 64;
  const float* b1 = p.in[21] + l * 64;
  const float* w2 = p.in[22] + l * 64 * 64;
  const float* b2 = p.in[23] + l * 64;
  const float* w3 = p.in[24] + (size_t)l * 64 * 1024;
  const float* b3 = p.in[25] + l * 1024;
  for (int idx = tid; idx < 512; idx += 256) {
    int ti = idx >> 6, j = idx & 63;
    float a = b1[j];
#pragma unroll 11
    for (int f = 0; f < 33; ++f) a += zf[ti * 40 + f] * w1[f * 64 + j];
    h1[ti * 64 + j] = sinf(a);
  }
  __syncthreads();
  for (int idx = tid; idx < 512; idx += 256) {
    int ti = idx >> 6, j = idx & 63;
    float a = b2[j];
#pragma unroll 16
    for (int f = 0; f < 64; ++f) a += h1[ti * 64 + f] * w2[f * 64 + j];
    h2[ti * 64 + j] = sinf(a);
  }
  __syncthreads();
  float acc[4][8];
#pragma unroll
  for (int q = 0; q < 4; ++q)
#pragma unroll
    for (int ti = 0; ti < 8; ++ti) acc[q][ti] = 0.f;
#pragma unroll 8
  for (int i = 0; i < 64; ++i) {
    float w[4];
#pragma unroll
    for (int q = 0; q < 4; ++q) w[q] = w3[i * 1024 + q * 256 + tid];
#pragma unroll
    for (int ti = 0; ti < 8; ++ti) {
      float hv = h2[ti * 64 + i];
#pragma unroll
      for (int q = 0; q < 4; ++q) acc[q][ti] += hv * w[q];
    }
  }
  const int ch = tid;
  const float d0 = -3.0701134573253945f, d1 = -15.350567286626973f;
  const float delta = d0 + (float)ch * ((d1 - d0) / 255.f);
  bf16_t* tapbase = (L == 256) ? (bf16_t*)(p.ws + OFF_TAP256) + (size_t)l * 2 * 256 * 512
                               : (bf16_t*)(p.ws + OFF_TAP1024) + (size_t)l * 2 * 256 * 2048;
#pragma unroll
  for (int q = 0; q < 4; ++q) {
    const int order = q >> 1, side = q & 1;
    const float bb = b3[q * 256 + ch];
#pragma unroll
    for (int ti = 0; ti < 8; ++ti) {
      int t = tbase + ti;
      float tn = (float)t * invL;
      float val = (acc[q][ti] + bb) * expf(tn * delta);
      int x;
      if (side == 0) x = L + t;
      else { if (t == 0) { x = 0; val = 0.f; } else x = L - t; }
      tapbase[((size_t)order * 256 + ch) * 2 * L + (2 * L - 1 - x)] = f2bf(val);
    }
  }
  __syncthreads();
}

DI int kf_off(int key, int d) { return ((((key >> 5) * 4 + (d >> 4)) * 64 + ((d >> 3) & 1) * 32 + (key & 31)) << 3) + (d & 7); }
DI int vf_off(int key, int d) { return (((((key >> 5) * 2 + ((key >> 4) & 1)) * 2 + (d >> 5)) * 64 + ((key >> 2) & 1) * 32 + (d & 31)) << 3) + (key & 3) + 4 * ((key >> 3) & 1); }
DI void p0_cache(const Params& p, int it) {
  const int tid = otid();
  bf16_t* kcat = (bf16_t*)(p.ws + OFF_KCAT);
  bf16_t* vtl = (bf16_t*)(p.ws + OFF_VTL);
  for (int e = tid; e < 4096; e += 256) {
    int rr = it * 32 + (e >> 7), c = e & 127;
    int s = rr & 255, bl = rr >> 8, l = bl & 3, b = bl >> 2;
    float kv = p.in[2][(size_t)rr * 128 + c];
    float vv = p.in[3][(size_t)rr * 128 + c];
    const int kvh = c >> 6, d = c & 63;
    const size_t sb = (size_t)((l * 2 + b) * 2 + kvh) * (1280 * 64);
    kcat[sb + kf_off(s, d)] = f2bf(kv);
    vtl[sb + vf_off(s, d)] = f2bf(vv);
  }
}

DI void phase0(const Params& p, char* lds, int* s_item) {
  const int NTAP = 640, NMOD = 384, NCACHE = 64, NTR = 5760;
  const int total = NTAP + NMOD + NCACHE + NTR;
  int* ctr = (int*)(p.ws + OFF_CTR) + 16;
  const int tid = otid();
  for (;;) {
    if (tid == 0) *s_item = atomicAdd(ctr, 1);
    __syncthreads();
    const int it = *s_item;
    __syncthreads();
    if (it >= total) break;
    int r = it;
    if (r < NTAP) { p0_taps(p, r / 160, r % 160, (float*)lds); continue; }
    r -= NTAP;
    if (r < NMOD) { p0_mod(p, r / 96, r % 96, (float*)lds); continue; }
    r -= NMOD;
    if (r < NCACHE) { p0_cache(p, r); continue; }
    r -= NCACHE;
    int l = r / 1440; r %= 1440;
    if (r < 256) p0_transpose(p.in[11] + (size_t)l * 1024 * 2048, 1024, 2048, r / 32, r % 32, (bf16_t*)(p.ws + OFF_WTIN) + (size_t)l * 2048 * 1024, 0);
    else if (r < 384) { r -= 256; p0_transpose(p.in[27] + (size_t)l * 1024 * 1024, 1024, 1024, r / 16, r % 16, (bf16_t*)(p.ws + OFF_WTOUT) + (size_t)l * 1024 * 1024, 0); }
    else if (r < 736) { r -= 384; p0_transpose(p.in[28] + (size_t)l * 1024 * 2816, 1024, 2816, r / 44, r % 44, (bf16_t*)(p.ws + OFF_WT13) + (size_t)l * 5632 * 1024, 1); }
    else if (r < 1088) { r -= 736; p0_transpose(p.in[29] + (size_t)l * 1024 * 2816, 1024, 2816, r / 44, r % 44, (bf16_t*)(p.ws + OFF_WT13) + (size_t)l * 5632 * 1024, 2); }
    else { r -= 1088; p0_transpose(p.in[30] + (size_t)l * 2816 * 1024, 2816, 1024, r / 16, r % 16, (bf16_t*)(p.ws + OFF_WT2) + (size_t)l * 1024 * 2816, 0); }
  }
}

DI void norm_phase(const Params& p, int l, int which) {
  float* xbuf = p.out;
  bf16_t* hbf = (bf16_t*)(p.ws + OFF_HBF);
  const float* mod = (const float*)(p.ws + OFF_MOD);
  const float* nw = p.in[which ? 10 : 9] + l * 1024;
  const int tid_ = otid(); const int wave = tid_ >> 6, lane = tid_ & 63;
  const bool first = (l == 0 && which == 0);
  constexpr int RB = 5;
  const int nwaves = gridDim.x * 4;
  for (int row0 = blockIdx.x * 4 + wave; row0 < NTOK; row0 += nwaves * RB) {
    float4 v[RB][4];
#pragma unroll
    for (int j = 0; j < RB; ++j) {
      const int row = row0 + j * nwaves;
      if (row < NTOK) {
        const float* src;
        if (first) src = (row < NPROMPT) ? p.in[0] + (size_t)row * 1024 : p.in[1] + (size_t)(row - NPROMPT) * 1024;
        else src = xbuf + (size_t)row * 1024;
#pragma unroll
        for (int i = 0; i < 4; ++i) v[j][i] = *(const float4*)(src + i * 256 + lane * 4);
      } else {
#pragma unroll
        for (int i = 0; i < 4; ++i) v[j][i] = make_float4(0.f, 0.f, 0.f, 0.f);
      }
    }
#pragma unroll
    for (int j = 0; j < RB; ++j) {
      const int row = row0 + j * nwaves;
      if (row >= NTOK) break;
      float ss = 0.f;
#pragma unroll
      for (int i = 0; i < 4; ++i) ss += v[j][i].x * v[j][i].x + v[j][i].y * v[j][i].y + v[j][i].z * v[j][i].z + v[j][i].w * v[j][i].w;
#pragma unroll
      for (int o = 32; o >= 1; o >>= 1) ss += __shfl_xor(ss, o);
      const float rstd = rsqrtf(ss * (1.f / 1024.f) + 1e-6f);
      const int ci = (row < NPROMPT) ? 0 : 1 + ((row - NPROMPT) >> 10);
      const float* sh = mod + ((l * 3 + ci) * 6 + (which ? 3 : 0)) * 1024;
      const float* sc = sh + 1024;
#pragma unroll
      for (int i = 0; i < 4; ++i) {
        const int col = i * 256 + lane * 4;
        const float4 w4 = *(const float4*)(nw + col), s4 = *(const float4*)(sc + col), h4 = *(const float4*)(sh + col);
        const float y0 = v[j][i].x * rstd * w4.x * (1.f + s4.x) + h4.x;
        const float y1 = v[j][i].y * rstd * w4.y * (1.f + s4.y) + h4.y;
        const float y2 = v[j][i].z * rstd * w4.z * (1.f + s4.z) + h4.z;
        const float y3 = v[j][i].w * rstd * w4.w * (1.f + s4.w) + h4.w;
        *(uint2*)(hbf + blk(row, col, 16)) = make_uint2(pack2(y0, y1), pack2(y2, y3));
        if (first) *(float4*)(xbuf + (size_t)row * 1024 + col) = v[j][i];
      }
    }
  }
}

enum { EPI_IN = 0, EPI_RES = 1, EPI_FFN = 2 };

DI void epi_in(const Params& p, int l, int m0, int nt, const f32x16 (&acc)[2][2], char* lds) {
  const int tid = otid(), lane = tid & 63, wave = tid >> 6;
  const int wm = wave >> 1, wn = wave & 1, r = lane & 31, h = lane >> 5;
  float* Ct = (float*)lds;
#pragma unroll
  for (int i = 0; i < 2; ++i)
#pragma unroll
    for (int j = 0; j < 2; ++j)
#pragma unroll
      for (int reg = 0; reg < 16; ++reg) {
        int row = wm * 64 + i * 32 + (reg & 3) + 8 * (reg >> 2) + 4 * h;
        int col = wn * 64 + j * 32 + r;
        Ct[row * 132 + col] = acc[i][j][reg];
      }
  __syncthreads();
  const bool lat = (m0 >= NPROMPT);
  if (nt < 5) {
    const int row = tid >> 1, hh = tid & 1;
    float* src = Ct + row * 132 + hh * 64;
    float ss = 0.f;
#pragma unroll
    for (int d = 0; d < 64; d += 4) {
      float4 t = *(const float4*)(src + d);
      ss += t.x * t.x + t.y * t.y + t.z * t.z + t.w * t.w;
    }
    const float rstd = rsqrtf(ss * (1.f / 64.f) + 1e-6f);
    const float* nw = (nt < 4 ? p.in[12] : p.in[13]) + l * 64;
    const float osc = (nt < 4) ? 0.125f : 1.f;
    const int m = m0 + row;
    int pos = 0;
    if (lat) {
      pos = (m - NPROMPT) & 1023;
      const float pr = (float)(pos >> 6), pc = (float)(pos & 63);
#pragma unroll 1
      for (int d = 0; d < 16; ++d) {
        const float f = exp2f(-(float)d * 0.8304820237218406f);
        const float ar = pr * f, ac = pc * f;
        const float sr = __sinf(ar), cr = __cosf(ar), sc_ = __sinf(ac), cc_ = __cosf(ac);
        float x1 = src[d] * rstd * nw[d], x2 = src[d + 16] * rstd * nw[d + 16];
        src[d] = (x1 * cr - x2 * sr) * osc; src[d + 16] = (x2 * cr + x1 * sr) * osc;
        x1 = src[32 + d] * rstd * nw[32 + d]; x2 = src[48 + d] * rstd * nw[48 + d];
        src[32 + d] = (x1 * cc_ - x2 * sc_) * osc; src[48 + d] = (x2 * cc_ + x1 * sc_) * osc;
      }
    } else {
#pragma unroll
      for (int d = 0; d < 64; d += 4) {
        float4 t = *(const float4*)(src + d);
        float4 w = *(const float4*)(nw + d);
        t.x *= rstd * w.x * osc; t.y *= rstd * w.y * osc; t.z *= rstd * w.z * osc; t.w *= rstd * w.w * osc;
        *(float4*)(src + d) = t;
      }
    }
    if (nt < 4) {
      bf16_t* dst = (bf16_t*)(p.ws + OFF_QBF) + (size_t)m * 512 + (nt * 2 + hh) * 64;
#pragma unroll
      for (int d = 0; d < 64; d += 8) {
        float4 t0 = *(const float4*)(src + d), t1 = *(const float4*)(src + d + 4);
        *(uint4*)(dst + d) = make_uint4(pack2(t0.x, t0.y), pack2(t0.z, t0.w), pack2(t1.x, t1.y), pack2(t1.z, t1.w));
      }
    } else {
      bf16_t* dst;
      int key;
      if (!lat) {
        const int b = m >> 8, s = m & 255;
        float* nk = p.out + OUT_NK + ((size_t)((b * 4 + l) * 256 + s)) * 128 + hh * 64;
#pragma unroll
        for (int d = 0; d < 64; d += 4) *(float4*)(nk + d) = *(const float4*)(src + d);
        dst = (bf16_t*)(p.ws + OFF_KBF) + (size_t)(b * 2 + hh) * (256 * 64);
        key = s;
      } else {
        const int b2 = (m - NPROMPT) >> 10;
        dst = (bf16_t*)(p.ws + OFF_KCAT) + (size_t)((l * 2 + b2) * 2 + hh) * (1280 * 64);
        key = 256 + pos;
      }
#pragma unroll
      for (int d = 0; d < 64; d += 8) {
        float4 t0 = *(const float4*)(src + d), t1 = *(const float4*)(src + d + 4);
        *(uint4*)(dst + kf_off(key, d)) = make_uint4(pack2(t0.x, t0.y), pack2(t0.z, t0.w), pack2(t1.x, t1.y), pack2(t1.z, t1.w));
      }
    }
  } else if (nt == 5) {
    if (!lat) {
      const int row = tid >> 1, hf = tid & 1;
      const int m = m0 + row, b = m >> 8, s = m & 255;
      float* nv = p.out + OUT_NV + ((size_t)((b * 4 + l) * 256 + s)) * 128 + hf * 64;
      const float* src = Ct + row * 132 + hf * 64;
#pragma unroll
      for (int d = 0; d < 64; d += 4) *(float4*)(nv + d) = *(const float4*)(src + d);
    }
    {
      const int col = tid & 127, rh = tid >> 7;
      const int kvh = col >> 6, d = col & 63;
      bf16_t* dst;
      int kstart;
      if (!lat) {
        const int b = m0 >> 8, s0 = m0 & 255;
        dst = (bf16_t*)(p.ws + OFF_VTP) + (size_t)(b * 2 + kvh) * (256 * 64);
        kstart = s0 + rh * 64;
      } else {
        const int b2 = (m0 - NPROMPT) >> 10, s0 = (m0 - NPROMPT) & 1023;
        dst = (bf16_t*)(p.ws + OFF_VTL) + (size_t)((l * 2 + b2) * 2 + kvh) * (1280 * 64);
        kstart = 256 + s0 + rh * 64;
      }
      const float* src = Ct + (rh * 64) * 132 + col;
#pragma unroll
      for (int g = 0; g < 8; ++g) {
        const int kk0 = (g >> 2) * 32 + ((g >> 1) & 1) * 16 + (g & 1) * 4;
        *(uint4*)(dst + vf_off(kstart + kk0, d)) =
            make_uint4(pack2(src[(kk0 + 0) * 132], src[(kk0 + 1) * 132]), pack2(src[(kk0 + 2) * 132], src[(kk0 + 3) * 132]),
                       pack2(src[(kk0 + 8) * 132], src[(kk0 + 9) * 132]), pack2(src[(kk0 + 10) * 132], src[(kk0 + 11) * 132]));
      }
    }
  } else if (nt < 10) {
    const int row = tid >> 1, hf = tid & 1;
    float* dst = (float*)(p.ws + OFF_PBUF) + (size_t)(m0 + row) * 1280 + (nt * 128 - 768) + hf * 64;
    const float* src = Ct + row * 132 + hf * 64;
#pragma unroll
    for (int d = 0; d < 64; d += 4) *(float4*)(dst + d) = *(const float4*)(src + d);
  } else {
    const int row = tid >> 1, hf = tid & 1;
    const int sidx = (nt - 10) >> 1, cg0 = (((nt - 10) & 1) * 128 + hf * 64) >> 2;
    float* dst = (float*)(p.ws + OFF_PHY) + ((size_t)cg0 * NTOK + (m0 + row)) * 12 + sidx * 4;
    const float* src = Ct + row * 132 + hf * 64;
#pragma unroll
    for (int g = 0; g < 16; ++g) *(float4*)(dst + (size_t)g * NTOK * 12) = *(const float4*)(src + 4 * g);
  }
  __syncthreads();
}

template <int EPI>
DI void gemm_phase(const Params& p, int l, const bf16_t* A, int lda, const bf16_t* BT, int ldb, int K, int NT,
                           int modpart, char* lds, float gscale = 1.f, int KS = 1, bool HYB = false) {
  const int tid = otid(), lane = tid & 63, wave = tid >> 6;
  const int wm = wave >> 1, wn = wave & 1, r = lane & 31, h = lane >> 5;
  const int base_tiles = 80 * NT;
  const int nwhole = HYB ? (base_tiles / (int)gridDim.x) * (int)gridDim.x : base_tiles;
  const int ntiles = HYB ? nwhole + (base_tiles - nwhole) * 2 : base_tiles * KS;
  const int woff = (tid >> 3) * LROW + (tid & 7) * 16;
  for (int t = blockIdx.x; t < ntiles; t += gridDim.x) {
    int ks, tt, KT; bool atom;
    if (HYB) {
      if (t < nwhole) { ks = 0; tt = t; KT = K >> 6; atom = false; }
      else { const int j = t - nwhole; tt = nwhole + (j >> 1); ks = j & 1; KT = K >> 7; atom = true; }
    } else { ks = t / base_tiles; tt = t - ks * base_tiles; KT = K / (64 * KS); atom = KS > 1; }
    const int mt = tt % 80, nt = tt / 80;
    const int m0 = mt * 128, n0 = nt * 128;
    f32x16 acc[2][2];
#pragma unroll
    for (int i = 0; i < 2; ++i)
#pragma unroll
      for (int j = 0; j < 2; ++j)
#pragma unroll
        for (int e = 0; e < 16; ++e) acc[i][j][e] = 0.f;
    const bf16_t* Ag = A + ((size_t)mt * (K >> 6) + ks * KT) * 8192 + tid * 8;
    const bf16_t* Bg = BT + ((size_t)nt * (K >> 6) + ks * KT) * 8192 + tid * 8;
    uint4 ra[2][4], rb[2][4];
#pragma unroll
    for (int i = 0; i < 4; ++i) {
      ra[0][i] = *(const uint4*)(Ag + i * 2048);
      rb[0][i] = *(const uint4*)(Bg + i * 2048);
    }
#pragma unroll
    for (int i = 0; i < 4; ++i) {
      *(uint4*)(lds + woff + i * 32 * LROW) = ra[0][i];
      *(uint4*)(lds + LTILE + woff + i * 32 * LROW) = rb[0][i];
    }
#pragma unroll
    for (int i = 0; i < 4; ++i) {
      asm volatile("global_load_dwordx4 %0, %1, off" : "=v"(ra[1][i]) : "v"(Ag + i * 2048 + 8192) : "memory");
      asm volatile("global_load_dwordx4 %0, %1, off" : "=v"(rb[1][i]) : "v"(Bg + i * 2048 + 8192) : "memory");
    }
    __syncthreads();
    for (int kt2 = 0; kt2 < KT; kt2 += 2) {
#pragma unroll
      for (int u = 0; u < 2; ++u) {
        const int kt = kt2 + u;
        const char* cur = lds + u * LBUF;
        char* nxt = lds + (u ^ 1) * LBUF;
        const int kn = (kt + 2 < KT) ? kt + 2 : KT - 1;
        asm volatile("s_waitcnt vmcnt(0)" ::: "memory");
#pragma unroll
        for (int i = 0; i < 4; ++i) {
          asm volatile("global_load_dwordx4 %0, %1, off" : "=v"(ra[u][i]) : "v"(Ag + i * 2048 + (size_t)kn * 8192) : "memory");
          asm volatile("global_load_dwordx4 %0, %1, off" : "=v"(rb[u][i]) : "v"(Bg + i * 2048 + (size_t)kn * 8192) : "memory");
        }
        __builtin_amdgcn_s_setprio(3);
#pragma unroll
        for (int st = 0; st < 4; ++st) {
          bf16x8 a0 = *(const bf16x8*)(cur + (wm * 64 + r) * LROW + st * 32 + h * 16);
          bf16x8 a1 = *(const bf16x8*)(cur + (wm * 64 + 32 + r) * LROW + st * 32 + h * 16);
          bf16x8 b0 = *(const bf16x8*)(cur + LTILE + (wn * 64 + r) * LROW + st * 32 + h * 16);
          bf16x8 b1 = *(const bf16x8*)(cur + LTILE + (wn * 64 + 32 + r) * LROW + st * 32 + h * 16);
          acc[0][0] = MFMA32(a0, b0, acc[0][0]);
          acc[0][1] = MFMA32(a0, b1, acc[0][1]);
          acc[1][0] = MFMA32(a1, b0, acc[1][0]);
          acc[1][1] = MFMA32(a1, b1, acc[1][1]);
          *(uint4*)(nxt + woff + st * 32 * LROW) = ra[u ^ 1][st];
          *(uint4*)(nxt + LTILE + woff + st * 32 * LROW) = rb[u ^ 1][st];
        }
        __builtin_amdgcn_s_setprio(0);
        __syncthreads();
      }
    }
    asm volatile("s_waitcnt vmcnt(0)" ::: "memory");
#pragma unroll
    for (int i = 0; i < 4; ++i) {
      typedef unsigned u32x4_t __attribute__((ext_vector_type(4)));
      const u32x4_t t0 = {ra[0][i].x, ra[0][i].y, ra[0][i].z, ra[0][i].w}, t1 = {rb[0][i].x, rb[0][i].y, rb[0][i].z, rb[0][i].w};
      const u32x4_t t2 = {ra[1][i].x, ra[1][i].y, ra[1][i].z, ra[1][i].w}, t3 = {rb[1][i].x, rb[1][i].y, rb[1][i].z, rb[1][i].w};
      asm volatile("" :: "v"(t0), "v"(t1), "v"(t2), "v"(t3));
    }
    if (EPI == EPI_IN) {
      epi_in(p, l, m0, nt, acc, lds);
    } else if (EPI == EPI_RES) {
      const int ci = (m0 < NPROMPT) ? 0 : 1 + ((m0 - NPROMPT) >> 10);
      const float* gate = (const float*)(p.ws + OFF_MOD) + ((l * 3 + ci) * 6 + modpart) * 1024;
      float* xbuf = p.out;
      if (atom) {
#pragma unroll
        for (int j = 0; j < 2; ++j) {
          const int n = n0 + wn * 64 + j * 32 + r;
          const float g = gate[n] * gscale;
#pragma unroll
          for (int i = 0; i < 2; ++i)
#pragma unroll
            for (int reg = 0; reg < 16; ++reg) {
              const int m = m0 + wm * 64 + i * 32 + (reg & 3) + 8 * (reg >> 2) + 4 * h;
              (void)__hip_atomic_fetch_add(xbuf + (size_t)m * 1024 + n, g * acc[i][j][reg], __ATOMIC_RELAXED, __HIP_MEMORY_SCOPE_AGENT);
            }
        }
      } else {
        float* Ct = (float*)lds;
#pragma unroll
        for (int i = 0; i < 2; ++i)
#pragma unroll
          for (int j = 0; j < 2; ++j)
#pragma unroll
            for (int reg = 0; reg < 16; ++reg)
              Ct[(wm * 64 + i * 32 + (reg & 3) + 8 * (reg >> 2) + 4 * h) * 132 + wn * 64 + j * 32 + r] = acc[i][j][reg];
        __syncthreads();
#pragma unroll
        for (int i = 0; i < 16; ++i) {
          const int c = tid + 256 * i, row = c >> 5, c4 = (c & 31) * 4;
          const float4 a = *(const float4*)(Ct + row * 132 + c4);
          const float4 g = *(const float4*)(gate + n0 + c4);
          float4* xp = (float4*)(xbuf + (size_t)(m0 + row) * 1024 + n0 + c4);
          float4 xv = *xp;
          xv.x += gscale * g.x * a.x; xv.y += gscale * g.y * a.y; xv.z += gscale * g.z * a.z; xv.w += gscale * g.w * a.w;
          *xp = xv;
        }
        __syncthreads();
      }
    } else {
      bf16_t* st = (bf16_t*)lds + (wm * 64 + 4 * h) * 72 + wn * 32 + r;
#pragma unroll
      for (int i = 0; i < 2; ++i)
#pragma unroll
        for (int reg = 0; reg < 16; ++reg) {
          const float a = acc[i][0][reg], b = acc[i][1][reg];
          st[(i * 32 + (reg & 3) + 8 * (reg >> 2)) * 72] = f2bf(a * fast_sigmoid(a) * b);
        }
      __syncthreads();
      {
        bf16_t* ub = (bf16_t*)(p.ws + OFF_UBF) + ((size_t)mt * 44 + nt) * 8192;
#pragma unroll
        for (int i = 0; i < 4; ++i) {
          const int c = tid + 256 * i;
          *(uint4*)(ub + c * 8) = *(const uint4*)((const bf16_t*)lds + (c >> 3) * 72 + (c & 7) * 8);
        }
      }
      __syncthreads();
    }
  }
}

DI void attn_wave(const bf16_t* __restrict__ q, const bf16_t* __restrict__ kp, const bf16_t* __restrict__ vt, int nkeys, bf16_t* __restrict__ mixb, int qtok, int head) {
  const int lane = otid() & 63, r = lane & 31, h = lane >> 5;
  bf16x8 qf[4];
#pragma unroll
  for (int st = 0; st < 4; ++st) qf[st] = *(const bf16x8*)(q + (size_t)r * 512 + st * 16 + h * 8);
  f32x16 O[2];
#pragma unroll
  for (int e = 0; e < 16; ++e) { O[0][e] = 0.f; O[1][e] = 0.f; }
  float m = -1e30f, lsum = 0.f;
  bf16x8 kfr[2][4];
#pragma unroll
  for (int sub = 0; sub < 2; ++sub)
#pragma unroll
    for (int st = 0; st < 4; ++st) kfr[sub][st] = *(const bf16x8*)(kp + (size_t)(((sub * 4 + st) * 64 + lane) << 3));
  for (int k0 = 0; k0 < nkeys; k0 += 64) {
    f32x16 S[2];
#pragma unroll
    for (int sub = 0; sub < 2; ++sub) {
#pragma unroll
      for (int e = 0; e < 16; ++e) S[sub][e] = 0.f;
#pragma unroll
      for (int st = 0; st < 4; ++st) S[sub] = MFMA32(kfr[sub][st], qf[st], S[sub]);
    }
    {
      const int kn = (k0 + 64 < nkeys) ? k0 + 64 : k0;
#pragma unroll
      for (int sub = 0; sub < 2; ++sub)
#pragma unroll
        for (int st = 0; st < 4; ++st) kfr[sub][st] = *(const bf16x8*)(kp + (size_t)(((((kn >> 5) + sub) * 4 + st) * 64 + lane) << 3));
    }
    bf16x8 vfr[2][2][2];
#pragma unroll
    for (int sub = 0; sub < 2; ++sub)
#pragma unroll
      for (int s2 = 0; s2 < 2; ++s2)
#pragma unroll
        for (int dt = 0; dt < 2; ++dt)
          vfr[sub][s2][dt] = *(const bf16x8*)(vt + (size_t)((((((k0 >> 5) + sub) * 2 + s2) * 2 + dt) * 64 + lane) << 3));
    float mx = m;
#pragma unroll
    for (int sub = 0; sub < 2; ++sub)
#pragma unroll
      for (int e = 0; e < 16; ++e) mx = fmaxf(mx, S[sub][e]);
    mx = fmaxf(mx, __shfl_xor(mx, 32));
    const float alpha = __expf(m - mx);
    m = mx;
    float ps = 0.f;
#pragma unroll
    for (int sub = 0; sub < 2; ++sub)
#pragma unroll
      for (int e = 0; e < 16; ++e) { float pv = __expf(S[sub][e] - mx); S[sub][e] = pv; ps += pv; }
    lsum = lsum * alpha + ps;
#pragma unroll
    for (int e = 0; e < 16; ++e) { O[0][e] *= alpha; O[1][e] *= alpha; }
#pragma unroll
    for (int sub = 0; sub < 2; ++sub)
#pragma unroll
      for (int s = 0; s < 2; ++s) {
        union { unsigned u[4]; bf16x8 v; } pf;
#pragma unroll
        for (int j = 0; j < 4; ++j) pf.u[j] = pack2(S[sub][8 * s + 2 * j], S[sub][8 * s + 2 * j + 1]);
#pragma unroll
        for (int dt = 0; dt < 2; ++dt) O[dt] = MFMA32(vfr[sub][s][dt], pf.v, O[dt]);
      }
  }
  lsum += __shfl_xor(lsum, 32);
  const float inv = 1.f / lsum;
  bf16_t* ob = mixb + ((size_t)(qtok >> 7) * 16 + head) * 8192 + ((qtok & 127) + r) * 64;
#pragma unroll
  for (int dt = 0; dt < 2; ++dt)
#pragma unroll
    for (int g = 0; g < 4; ++g) {
      const int d = dt * 32 + 8 * g + 4 * h;
      *(uint2*)(ob + d) = make_uint2(pack2(O[dt][4 * g] * inv, O[dt][4 * g + 1] * inv), pack2(O[dt][4 * g + 2] * inv, O[dt][4 * g + 3] * inv));
    }
}

DI float gelu_tanh(float x) { return 0.5f * x * (1.f + tanhf(0.7978845608028654f * (x + 0.044715f * x * x * x))); }

#ifndef PROBE_BAR
#define PROBE_BAR 0
#endif
DI void gsync(GBar& g) { gsync1(g); if (PROBE_BAR) { gsync1(g); gsync1(g); } }
DI float fast_gelu(float x) {
  const float u = 0.7978845608028654f * (x + 0.044715f * x * x * x);
  const float th = 1.f - 2.f * __builtin_amdgcn_rcpf(1.f + __expf(2.f * u));
  return 0.5f * x * (1.f + th);
}

DI void lru_gate_item(const Params& p, int l, int mt, int n, char* lds) {
  const int tid = otid(), lane = tid & 63, wave = tid >> 6, r = lane & 31, h = lane >> 5;
  float* XC = (float*)lds;
  bf16_t* Axc = (bf16_t*)(lds + 32768);
  const int m0 = mt * 128;
  const int L = (m0 < NPROMPT) ? 256 : 1024;
  const int tb = (m0 < NPROMPT) ? (m0 & 255) : ((m0 - NPROMPT) & 1023);
  const float* pbuf = (const float*)(p.ws + OFF_PBUF);
  float2* ab = (float2*)(p.ws + OFF_UBF);
  {
    const int ch = tid & 63, tq = tid >> 6, gch = n * 64 + ch;
    float cw[4];
#pragma unroll
    for (int k = 0; k < 4; ++k) cw[k] = p.in[14][(l * 4 + k) * 256 + gch];
    const float cb = p.in[15][l * 256 + gch];
    float x[35];
#pragma unroll
    for (int i = 0; i < 35; ++i) {
      const int ts = tb + tq * 32 + i - 2;
      x[i] = (ts >= 0 && ts < L) ? pbuf[(size_t)(m0 - tb + ts) * 1280 + gch] : 0.f;
    }
#pragma unroll
    for (int e = 0; e < 32; ++e) {
      const float xv = cb + cw[0] * x[e] + cw[1] * x[e + 1] + cw[2] * x[e + 2] + cw[3] * x[e + 3];
      XC[(tq * 32 + e) * 64 + ch] = xv;
      Axc[(tq * 32 + e) * 72 + ch] = f2bf(xv);
    }
  }
  __syncthreads();
  {
    const int dir = wave & 1, half = wave >> 1;
    bf16x8 wf[2][2][4];
    float gb[2][2], sp[2];
#pragma unroll
    for (int g = 0; g < 2; ++g) {
      const float* W = p.in[16] + ((size_t)((l * 2 + dir) * 2 + g) * 4 + n) * 4096;
#pragma unroll
      for (int ct = 0; ct < 2; ++ct) {
        const int j = r + 32 * ct;
        gb[g][ct] = p.in[17][((l * 2 + dir) * 2 + g) * 256 + n * 64 + j];
#pragma unroll
        for (int st = 0; st < 4; ++st) {
          const int i0 = 16 * st + 8 * h;
          union { unsigned u[4]; bf16x8 v; } f;
#pragma unroll
          for (int jj = 0; jj < 4; ++jj) f.u[jj] = pack2(W[(i0 + 2 * jj) * 64 + j], W[(i0 + 2 * jj + 1) * 64 + j]);
          wf[g][ct][st] = f.v;
        }
      }
    }
#pragma unroll
    for (int ct = 0; ct < 2; ++ct) sp[ct] = log1pf(expf(-p.in[18][(l * 2 + dir) * 256 + n * 64 + r + 32 * ct]));
#pragma unroll 1
    for (int rt = 0; rt < 2; ++rt) {
      f32x16 acc[2][2];
#pragma unroll
      for (int e = 0; e < 16; ++e) { acc[0][0][e] = 0.f; acc[0][1][e] = 0.f; acc[1][0][e] = 0.f; acc[1][1][e] = 0.f; }
#pragma unroll
      for (int st = 0; st < 4; ++st) {
        const bf16x8 af = *(const bf16x8*)(Axc + (half * 64 + rt * 32 + r) * 72 + 16 * st + 8 * h);
        acc[0][0] = MFMA32(af, wf[0][0][st], acc[0][0]);
        acc[0][1] = MFMA32(af, wf[0][1][st], acc[0][1]);
        acc[1][0] = MFMA32(af, wf[1][0][st], acc[1][0]);
        acc[1][1] = MFMA32(af, wf[1][1][st], acc[1][1]);
      }
#pragma unroll
      for (int ct = 0; ct < 2; ++ct)
#pragma unroll
        for (int reg = 0; reg < 16; ++reg) {
          const int tok = half * 64 + rt * 32 + (reg & 3) + 8 * (reg >> 2) + 4 * h;
          const int j = r + 32 * ct;
          const float rr = fast_sigmoid(acc[0][ct][reg] + gb[0][ct]);
          const float ii = fast_sigmoid(acc[1][ct][reg] + gb[1][ct]);
          const float xv = XC[tok * 64 + j];
          const float a = __expf(-8.f * rr * sp[ct]);
          const float bb = __builtin_sqrtf(fmaxf(fmaf(-a, a, 1.f), 0.f)) * (ii * xv);
          ab[((size_t)dir * NTOK + m0 + tok) * 256 + n * 64 + j] = make_float2(a, bb);
        }
    }
  }
  __syncthreads();
}

template <int CGS>
DI void lru_scan_item(const Params& p, int l, int bidx, int cbase, char* lds) {
  constexpr int NSEG = 256 / CGS;
  const int tid = otid();
  const bool lat = bidx >= 32;
  const int L = lat ? 1024 : 256;
  const int tok0 = lat ? NPROMPT + (bidx - 32) * 1024 : bidx * 256;
  const int ch = tid % CGS, sg = tid / CGS, gch = cbase + ch;
  const int SEGL = L / NSEG;
  float2* SEG = (float2*)lds;
  const float2* ab = (const float2*)(p.ws + OFF_UBF);
  float* hfbuf = (float*)(p.ws + OFF_UBF + 41943040);
  const float* pbuf = (const float*)(p.ws + OFF_PBUF);
  bf16_t* mix = (bf16_t*)(p.ws + OFF_MIX);
  const float2* abf = ab + ((size_t)0 * NTOK + tok0 + sg * SEGL) * 256 + gch;
  const float2* abb = ab + ((size_t)1 * NTOK + tok0 + sg * SEGL) * 256 + gch;
  {
    float A = 1.f, B = 0.f;
#pragma unroll 16
    for (int i = 0; i < SEGL; ++i) { const float2 v = abf[(size_t)i * 256]; B = v.x * B + v.y; A *= v.x; }
    SEG[(0 * NSEG + sg) * CGS + ch] = make_float2(A, B);
    A = 1.f; B = 0.f;
#pragma unroll 16
    for (int i = SEGL - 1; i >= 0; --i) { const float2 v = abb[(size_t)i * 256]; B = v.x * B + v.y; A *= v.x; }
    SEG[(1 * NSEG + sg) * CGS + ch] = make_float2(A, B);
  }
  __syncthreads();
  float hf = lat ? p.in[4][(((bidx - 32) * 4 + l) * 2 + 0) * 256 + gch] : 0.f;
  float hb = lat ? p.in[4][(((bidx - 32) * 4 + l) * 2 + 1) * 256 + gch] : 0.f;
  for (int q = 0; q < sg; ++q) { const float2 v = SEG[(0 * NSEG + q) * CGS + ch]; hf = v.x * hf + v.y; }
  for (int q = NSEG - 1; q > sg; --q) { const float2 v = SEG[(1 * NSEG + q) * CGS + ch]; hb = v.x * hb + v.y; }
  if (!lat) {
    if (sg == NSEG - 1) { const float2 v = SEG[(0 * NSEG + NSEG - 1) * CGS + ch]; p.out[OUT_ST + ((size_t)(bidx * 4 + l) * 2 + 0) * 256 + gch] = v.x * hf + v.y; }
    if (sg == 0) { const float2 v = SEG[(1 * NSEG + 0) * CGS + ch]; p.out[OUT_ST + ((size_t)(bidx * 4 + l) * 2 + 1) * 256 + gch] = v.x * hb + v.y; }
  }
  float* hfp = hfbuf + (size_t)(tok0 + sg * SEGL) * 256 + gch;
  for (int i0 = 0; i0 < SEGL; i0 += 16) {
    float2 v[16];
#pragma unroll
    for (int j = 0; j < 16; ++j) v[j] = abf[(size_t)(i0 + j) * 256];
#pragma unroll
    for (int j = 0; j < 16; ++j) { hf = v[j].x * hf + v[j].y; hfp[(size_t)(i0 + j) * 256] = hf; }
  }
  const float* lg = pbuf + (size_t)(tok0 + sg * SEGL) * 1280 + 256 + gch;
  bf16_t* mp = mix + blk(tok0 + sg * SEGL, 512 + gch, 16);
  for (int i0 = SEGL - 16; i0 >= 0; i0 -= 16) {
    float2 v[16];
    float gv[16], fv[16];
#pragma unroll
    for (int j = 0; j < 16; ++j) {
      v[j] = abb[(size_t)(i0 + j) * 256];
      gv[j] = lg[(size_t)(i0 + j) * 1280];
      fv[j] = hfp[(size_t)(i0 + j) * 256];
    }
#pragma unroll
    for (int j = 15; j >= 0; --j) {
      hb = v[j].x * hb + v[j].y;
      mp[(size_t)(i0 + j) * 64] = f2bf(fast_gelu(gv[j]) * (fv[j] + hb));
    }
  }
  __syncthreads();
}

DI bf16x8 ld16u(const bf16_t* p) { bf16x8 v; __builtin_memcpy(&v, p, 16); return v; }
typedef unsigned u32x4v __attribute__((ext_vector_type(4)));
DI bf16x8 ld16_shift(const bf16_t* p8, int ds2, int ds1, unsigned hb) {
  const u32x4v c0 = *(const u32x4v*)p8, c1 = *(const u32x4v*)(p8 + 8);
  unsigned t0 = ds2 ? c0[2] : c0[0], t1 = ds2 ? c0[3] : c0[1], t2 = ds2 ? c1[0] : c0[2], t3 = ds2 ? c1[1] : c0[3], t4 = ds2 ? c1[2] : c1[0], t5 = ds2 ? c1[3] : c1[1];
  unsigned u0 = ds1 ? t1 : t0, u1 = ds1 ? t2 : t1, u2 = ds1 ? t3 : t2, u3 = ds1 ? t4 : t3, u4 = ds1 ? t5 : t4;
  union { unsigned u[4]; bf16x8 v; } r;
  r.u[0] = __builtin_amdgcn_alignbyte(u1, u0, hb); r.u[1] = __builtin_amdgcn_alignbyte(u2, u1, hb);
  r.u[2] = __builtin_amdgcn_alignbyte(u3, u2, hb); r.u[3] = __builtin_amdgcn_alignbyte(u4, u3, hb);
  return r.v;
}
DI float bf2f(bf16_t v) { return __uint_as_float((unsigned)v << 16); }
DI float conv3_at(const float* __restrict__ pb, int t, int L, float w0, float w1, float w2) {
  float v = w1 * pb[(size_t)t * 1280];
  if (t > 0) v += w0 * pb[(size_t)(t - 1) * 1280];
  if (t < L - 1) v += w2 * pb[(size_t)(t + 1) * 1280];
  return v;
}

template <int L>
DI void hy_item(const Params& p, int l, int tokbase, int c0, char* lds) {
  constexpr int NB = L / 32, NQ = 32 / NB, PADLEN = (3 * NB - 2) * 32;
  const int tid = otid(), lane = tid & 63, wave = tid >> 6, h = lane >> 5;
  bf16_t* UP = (bf16_t*)lds;
  float* X1 = (float*)(lds + 24576);
  float* X2 = (float*)(lds + 24576 + 16384);
  const float* phy = (const float*)(p.ws + OFF_PHY) + (size_t)(c0 >> 2) * NTOK * 12;
  const float* hcw = p.in[19] + l * 3 * 768 + c0;
  for (int idx = tid; idx < 4 * NQ * 2 * (NB - 1) * 32; idx += 256) {
    const int e = idx % ((NB - 1) * 32), s2 = (idx / ((NB - 1) * 32)) & 1, sq = idx / (2 * (NB - 1) * 32);
    UP[sq * PADLEN + (s2 ? (2 * NB - 1) * 32 : 0) + e] = 0;
  }
  {
    float4 w[3][3];
#pragma unroll
    for (int k = 0; k < 3; ++k)
#pragma unroll
      for (int sidx = 0; sidx < 3; ++sidx) w[k][sidx] = *(const float4*)(hcw + k * 768 + sidx * 256);
    for (int pr = tid; pr < NQ * L; pr += 256) {
      const int q = pr / L, t = pr % L;
      const float* row = phy + (size_t)(tokbase + q * L + t) * 12;
      float4 o[3];
#pragma unroll
      for (int sidx = 0; sidx < 3; ++sidx) {
        const float4 m = *(const float4*)(row + sidx * 4);
        o[sidx] = make_float4(w[1][sidx].x * m.x, w[1][sidx].y * m.y, w[1][sidx].z * m.z, w[1][sidx].w * m.w);
        if (t > 0) {
          const float4 a = *(const float4*)(row - 12 + sidx * 4);
          o[sidx].x += w[0][sidx].x * a.x; o[sidx].y += w[0][sidx].y * a.y; o[sidx].z += w[0][sidx].z * a.z; o[sidx].w += w[0][sidx].w * a.w;
        }
        if (t < L - 1) {
          const float4 c = *(const float4*)(row + 12 + sidx * 4);
          o[sidx].x += w[2][sidx].x * c.x; o[sidx].y += w[2][sidx].y * c.y; o[sidx].z += w[2][sidx].z * c.z; o[sidx].w += w[2][sidx].w * c.w;
        }
      }
      const int ui = q * PADLEN + (NB - 1) * 32 + t;
      UP[(0 * NQ) * PADLEN + ui] = f2bf(o[0].x); UP[(1 * NQ) * PADLEN + ui] = f2bf(o[0].y);
      UP[(2 * NQ) * PADLEN + ui] = f2bf(o[0].z); UP[(3 * NQ) * PADLEN + ui] = f2bf(o[0].w);
      X1[0 * NQ * L + pr] = o[1].x; X1[1 * NQ * L + pr] = o[1].y; X1[2 * NQ * L + pr] = o[1].z; X1[3 * NQ * L + pr] = o[1].w;
      X2[0 * NQ * L + pr] = o[2].x; X2[1 * NQ * L + pr] = o[2].y; X2[2 * NQ * L + pr] = o[2].z; X2[3 * NQ * L + pr] = o[2].w;
    }
  }
  __syncthreads();
  {
    const int c = c0 + wave;
    const int col = lane & 31, q = col / NB, T = col % NB;
    bf16_t* U = UP + wave * NQ * PADLEN;
    const bf16_t* rv0 = ((L == 256) ? (const bf16_t*)(p.ws + OFF_TAP256) + (size_t)l * 2 * 256 * 512
                                    : (const bf16_t*)(p.ws + OFF_TAP1024) + (size_t)l * 2 * 256 * 2048) + (size_t)c * 2 * L;
    const bf16_t* rv1 = rv0 + (size_t)256 * 2 * L;
    const int aoff_u = L - 1 - (lane & 31) + 8 * h;
    const int ash = aoff_u & 7, aoff = aoff_u - ash;
    const int ds2 = (ash >> 2) & 1, ds1 = (ash >> 1) & 1; const unsigned hb = (ash & 1) * 2;
    const int boff = q * PADLEN + 32 * (T + NB - 1) + 8 * h;
    const int uo = q * PADLEN + (NB - 1) * 32 + 32 * T + 4 * h;
    const int xo = wave * NQ * L + q * L + 32 * T + 4 * h;
    const float skip0 = p.in[26][(l * 2 + 0) * 256 + c], skip1 = p.in[26][(l * 2 + 1) * 256 + c];
    f32x16 acc;
#pragma unroll
    for (int e = 0; e < 16; ++e) acc[e] = 0.f;
    f32x16 accB;
#pragma unroll
    for (int e = 0; e < 16; ++e) accB[e] = 0.f;
#pragma unroll 5
    for (int D = -(NB - 1); D <= NB - 1; ++D) {
      const int off = -32 * D;
      const bf16x8 a0 = ld16_shift(rv0 + aoff + off, ds2, ds1, hb), a1 = ld16_shift(rv0 + aoff + off + 16, ds2, ds1, hb);
      const bf16x8 b0 = *(const bf16x8*)(U + boff + off), b1 = *(const bf16x8*)(U + boff + off + 16);
      acc = MFMA32(a0, b0, acc);
      accB = MFMA32(a1, b1, accB);
    }
#pragma unroll
    for (int e = 0; e < 16; ++e) acc[e] += accB[e];
    float z[16];
#pragma unroll
    for (int g = 0; g < 4; ++g) {
      const uint2 vv = *(const uint2*)(U + uo + 8 * g);
      const float4 x1 = *(const float4*)(X1 + xo + 8 * g);
      z[4 * g + 0] = x1.x * (acc[4 * g + 0] + skip0 * __uint_as_float(vv.x << 16));
      z[4 * g + 1] = x1.y * (acc[4 * g + 1] + skip0 * __uint_as_float(vv.x & 0xffff0000u));
      z[4 * g + 2] = x1.z * (acc[4 * g + 2] + skip0 * __uint_as_float(vv.y << 16));
      z[4 * g + 3] = x1.w * (acc[4 * g + 3] + skip0 * __uint_as_float(vv.y & 0xffff0000u));
    }
    __builtin_amdgcn_wave_barrier();
#pragma unroll
    for (int g = 0; g < 4; ++g)
      *(uint2*)(U + uo + 8 * g) = make_uint2(pack2(z[4 * g], z[4 * g + 1]), pack2(z[4 * g + 2], z[4 * g + 3]));
    __builtin_amdgcn_wave_barrier();
#pragma unroll
    for (int e = 0; e < 16; ++e) acc[e] = 0.f;
#pragma unroll
    for (int e = 0; e < 16; ++e) accB[e] = 0.f;
#pragma unroll 5
    for (int D = -(NB - 1); D <= NB - 1; ++D) {
      const int off = -32 * D;
      const bf16x8 a0 = ld16_shift(rv1 + aoff + off, ds2, ds1, hb), a1 = ld16_shift(rv1 + aoff + off + 16, ds2, ds1, hb);
      const bf16x8 b0 = *(const bf16x8*)(U + boff + off), b1 = *(const bf16x8*)(U + boff + off + 16);
      acc = MFMA32(a0, b0, acc);
      accB = MFMA32(a1, b1, accB);
    }
#pragma unroll
    for (int e = 0; e < 16; ++e) acc[e] += accB[e];
    bf16_t* OUT = (bf16_t*)(lds + 57344) + (size_t)(q * L + 32 * T + 4 * h) * 4 + wave;
#pragma unroll
    for (int g = 0; g < 4; ++g) {
      const float4 x2 = *(const float4*)(X2 + xo + 8 * g);
      OUT[(8 * g + 0) * 4] = f2bf(x2.x * (acc[4 * g + 0] + skip1 * z[4 * g + 0]));
      OUT[(8 * g + 1) * 4] = f2bf(x2.y * (acc[4 * g + 1] + skip1 * z[4 * g + 1]));
      OUT[(8 * g + 2) * 4] = f2bf(x2.z * (acc[4 * g + 2] + skip1 * z[4 * g + 2]));
      OUT[(8 * g + 3) * 4] = f2bf(x2.w * (acc[4 * g + 3] + skip1 * z[4 * g + 3]));
    }
  }
  __syncthreads();
  {
    const uint2* OUTv = (const uint2*)(lds + 57344);
    bf16_t* mix = (bf16_t*)(p.ws + OFF_MIX);
    for (int idx = tid; idx < NQ * L; idx += 256) *(uint2*)(mix + blk(tokbase + idx, 768 + c0, 16)) = OUTv[idx];
  }
  __syncthreads();
}

DI void mixer_phase(const Params& p, int l, int sub, char* lds, int* s_item, int rep = 0) {
  const int tid = otid(), wave = tid >> 6;
  int* ctr = (int*)(p.ws + OFF_CTR) + l * 2 + sub + rep * 8;
  bf16_t* mix = (bf16_t*)(p.ws + OFF_MIX);
  const bf16_t* qbf = (const bf16_t*)(p.ws + OFF_QBF);
  const int nitems = sub ? 672 : 1088;
  for (;;) {
    if (tid == 0) *s_item = atomicAdd(ctr, 1);
    __syncthreads();
    const int it = *s_item;
    __syncthreads();
    if (it >= nitems) break;
    if (sub == 0) {
      if (it < 128) {
        const int j = it;
        hy_item<1024>(p, l, NPROMPT + (j >> 6) * 1024, (j & 63) * 4, lds);
      } else if (it < 256) {
        const int j = it - 128, b2 = j >> 6, head = (j >> 3) & 7, qb = j & 7, kvh = head >> 2;
        const int qtok = NPROMPT + b2 * 1024 + qb * 128 + wave * 32;
        attn_wave(qbf + (size_t)qtok * 512 + head * 64,
                  (const bf16_t*)(p.ws + OFF_KCAT) + (size_t)((l * 2 + b2) * 2 + kvh) * (1280 * 64),
                  (const bf16_t*)(p.ws + OFF_VTL) + (size_t)((l * 2 + b2) * 2 + kvh) * (1280 * 64), 1280,
                  mix, qtok, head);
      } else if (it < 576) {
        const int j = it - 256;
        lru_gate_item(p, l, j >> 2, j & 3, lds);
      } else {
        const int j = it - 576;
        hy_item<256>(p, l, (j >> 6) * 1024, (j & 63) * 4, lds);
      }
    } else {
      if (it < 32) {
        lru_scan_item<16>(p, l, 32 + (it >> 4), (it & 15) * 16, lds);
      } else if (it < 160) {
        const int j = it - 32;
        lru_scan_item<64>(p, l, j >> 2, (j & 3) * 64, lds);
      } else {
        const int j = it - 160, b = j >> 4, head = (j >> 1) & 7, qb = j & 1, kvh = head >> 2;
        const int qtok = b * 256 + qb * 128 + wave * 32;
        attn_wave(qbf + (size_t)qtok * 512 + head * 64,
                  (const bf16_t*)(p.ws + OFF_KBF) + (size_t)(b * 2 + kvh) * (256 * 64),
                  (const bf16_t*)(p.ws + OFF_VTP) + (size_t)(b * 2 + kvh) * (256 * 64), 256,
                  mix, qtok, head);
      }
    }
  }
}

#ifndef PROBE_P0
#define PROBE_P0 0
#endif
#ifndef PROBE_DG
#define PROBE_DG 0
#endif
#ifndef PROBE_MIX
#define PROBE_MIX 0
#endif
#ifndef PROBE_DUP
#define PROBE_DUP 0
#endif
#ifndef PHASE_SEL
#define PHASE_SEL -1
#endif
#define PSEL(k) (PHASE_SEL < 0 || PHASE_SEL == (k))
#ifndef STOP_P
#define STOP_P -1
#endif
#ifndef STOP_L
#define STOP_L 0
#endif
#define STOPAT(k) if (STOP_P == (k) && l == STOP_L) return;
__global__ void __launch_bounds__(256, 2) fwd_megakernel(Params p) {
  cg::grid_group grid = cg::this_grid();
  __shared__ __attribute__((aligned(16))) char lds[LDS_BYTES];
  __shared__ int s_item;
  GBar gbar;
  gbar.w = (unsigned*)(p.ws + OFF_CTR);
  gbar.x = (unsigned)__builtin_amdgcn_s_getreg((3 << 11) | 20) & 0xFu;
  gbar.epoch = 0; gbar.nloc = 1; gbar.nx = 1;
  if (threadIdx.x == 0) (void)gb_add(&gbar.w[CW_CNT(gbar.x)], 1u);
  if (p.ws == nullptr) grid.sync();
  gbar.nloc = 0;
  if (PSEL(0)) phase0(p, lds, &s_item);
  gsync(gbar);
#if PROBE_P0
#endif
  const bf16_t* hbf = (const bf16_t*)(p.ws + OFF_HBF);
  for (int l = 0; l < 4; ++l) {
    if (PSEL(1)) norm_phase(p, l, 0);
    gsync(gbar);
    STOPAT(1)
    if (PSEL(2)) gemm_phase<EPI_IN>(p, l, hbf, 1024, (const bf16_t*)(p.ws + OFF_WTIN) + (size_t)l * 2048 * 1024, 1024, 1024, 16, 0, lds);
    gsync(gbar);
#if PROBE_DUP
    gemm_phase<EPI_IN>(p, l, hbf, 1024, (const bf16_t*)(p.ws + OFF_WTIN) + (size_t)l * 2048 * 1024, 1024, 1024, 16, 0, lds);
    gsync(gbar);
#endif
    STOPAT(2)
    if (PSEL(3)) mixer_phase(p, l, 0, lds, &s_item);
    gsync(gbar);
    if (PSEL(3)) mixer_phase(p, l, 1, lds, &s_item);
    gsync(gbar);
#if PROBE_MIX
    mixer_phase(p, l, 0, lds, &s_item, 1);
    gsync(gbar);
    mixer_phase(p, l, 1, lds, &s_item, 1);
    gsync(gbar);
#endif
    STOPAT(3)
    if (PSEL(4)) gemm_phase<EPI_RES>(p, l, (const bf16_t*)(p.ws + OFF_MIX), 1024, (const bf16_t*)(p.ws + OFF_WTOUT) + (size_t)l * 1024 * 1024, 1024, 1024, 8, 2, lds, 1.f, 1, true);
    gsync(gbar);
#if PROBE_DG
    gemm_phase<EPI_RES>(p, l, (const bf16_t*)(p.ws + OFF_MIX), 1024, (const bf16_t*)(p.ws + OFF_WTOUT) + (size_t)l * 1024 * 1024, 1024, 1024, 8, 2, lds, 0.f);
    gsync(gbar);
#endif
    STOPAT(4)
    if (PSEL(1)) norm_phase(p, l, 1);
    gsync(gbar);
    STOPAT(5)
    if (PSEL(5)) gemm_phase<EPI_FFN>(p, l, hbf, 1024, (const bf16_t*)(p.ws + OFF_WT13) + (size_t)l * 5632 * 1024, 1024, 1024, 44, 0, lds);
    gsync(gbar);
#if PROBE_DUP
    gemm_phase<EPI_FFN>(p, l, hbf, 1024, (const bf16_t*)(p.ws + OFF_WT13) + (size_t)l * 5632 * 1024, 1024, 1024, 44, 0, lds);
    gsync(gbar);
#endif
    STOPAT(6)
    if (PSEL(4)) gemm_phase<EPI_RES>(p, l, (const bf16_t*)(p.ws + OFF_UBF), DFF, (const bf16_t*)(p.ws + OFF_WT2) + (size_t)l * 1024 * DFF, DFF, DFF, 8, 5, lds, 1.f, 1, true);
    if (l < 3) gsync(gbar);
#if PROBE_DG
    gemm_phase<EPI_RES>(p, l, (const bf16_t*)(p.ws + OFF_UBF), DFF, (const bf16_t*)(p.ws + OFF_WT2) + (size_t)l * 1024 * DFF, DFF, DFF, 8, 5, lds, 0.f);
    gsync(gbar);
#endif
    STOPAT(7)
  }
}

#ifndef MULTI_LAUNCH
#define MULTI_LAUNCH 0
#endif
__global__ void __launch_bounds__(256, 2) phase_kernel(Params p, int phase, int l) {
  __shared__ __attribute__((aligned(16))) char lds[LDS_BYTES];
  __shared__ int s_item;
  const bf16_t* hbf = (const bf16_t*)(p.ws + OFF_HBF);
  switch (phase) {
    case 0: phase0(p, lds, &s_item); break;
    case 1: norm_phase(p, l, 0); break;
    case 2: gemm_phase<EPI_IN>(p, l, hbf, 1024, (const bf16_t*)(p.ws + OFF_WTIN) + (size_t)l * 2048 * 1024, 1024, 1024, 16, 0, lds); break;
    case 3: mixer_phase(p, l, 0, lds, &s_item); break;
    case 8: mixer_phase(p, l, 1, lds, &s_item); break;
    case 4: gemm_phase<EPI_RES>(p, l, (const bf16_t*)(p.ws + OFF_MIX), 1024, (const bf16_t*)(p.ws + OFF_WTOUT) + (size_t)l * 1024 * 1024, 1024, 1024, 8, 2, lds); break;
    case 5: norm_phase(p, l, 1); break;
    case 6: gemm_phase<EPI_FFN>(p, l, hbf, 1024, (const bf16_t*)(p.ws + OFF_WT13) + (size_t)l * 5632 * 1024, 1024, 1024, 44, 0, lds); break;
    default: gemm_phase<EPI_RES>(p, l, (const bf16_t*)(p.ws + OFF_UBF), DFF, (const bf16_t*)(p.ws + OFF_WT2) + (size_t)l * 1024 * DFF, DFF, DFF, 8, 5, lds); break;
  }
}

extern "C" void kernel_launch(void* const* d_in, const int* in_sizes, int n_in, void* d_out, int out_size, void* d_ws, size_t ws_size,
                              hipStream_t stream) {
  static int grid_blocks = 0;
  if (!grid_blocks) {
    int dev = 0, cus = 0, per_cu = 0;
    hipGetDevice(&dev);
    hipDeviceGetAttribute(&cus, hipDeviceAttributeMultiprocessorCount, dev);
    hipOccupancyMaxActiveBlocksPerMultiprocessor(&per_cu, fwd_megakernel, 256, 0);
    if (per_cu > 2) per_cu = 2;
    if (per_cu < 1) per_cu = 1;
    grid_blocks = cus * per_cu;
  }
  Params p{};
  for (int i = 0; i < 31; ++i) p.in[i] = (const float*)d_in[i];
  p.out = (float*)d_out;
  p.ws = (char*)d_ws;
  (void)hipMemsetAsync((char*)d_ws + OFF_CTR, 0, CTL_BYTES, stream);
#if MULTI_LAUNCH
  hipLaunchKernelGGL(phase_kernel, dim3(512), dim3(256), 0, stream, p, 0, 0);
  for (int l = 0; l < 4; ++l)
    for (int ph = 1; ph <= 7; ++ph) hipLaunchKernelGGL(phase_kernel, dim3(512), dim3(256), 0, stream, p, ph, l);
  return;
#endif
  void* args[] = {&p};
  hipError_t e = hipLaunchCooperativeKernel((void*)fwd_megakernel, dim3(grid_blocks), dim3(256), args, 0, stream);
  if (e != hipSuccess) fprintf(stderr, "cooperative launch failed: %s (grid %d)\n", hipGetErrorString(e), grid_blocks);
}
```
